# Optimizing an MI355X kernel written in HIP

```python
import jax
import jax.numpy as jnp
from jax import lax
import numpy as np


D_MODEL = 1024
BATCH = 1
SEQ = 16384
DEPTH = 1
DEC_BATCH = 32
DEC_SEQ = 32
PAST_LEN = 2048

CHUNK = 64
BAND_CHUNKS = 8
BAND_PAST = BAND_CHUNKS * CHUNK
BAND = BAND_PAST + CHUNK
N_HEADS_A = 8
HEAD_DIM_A = 64
D_A = N_HEADS_A * HEAD_DIM_A
REL_CLIP = 128
N_HEADS_B = 4
DK_HEAD_B = 128
DV_HEAD_B = 256
DK_B = N_HEADS_B * DK_HEAD_B
DV_B = N_HEADS_B * DV_HEAD_B
GATE_RANK = 16
GATE_TEMP = 16.0
D_FF = ((8 * D_MODEL // 3 + 255) // 256) * 256
EPS = 1e-6
SPLIT_WIDTHS = (D_A, D_A, D_A, DK_B, DK_B, DV_B, DV_B, GATE_RANK, D_MODEL, D_MODEL)
D_IN = sum(SPLIT_WIDTHS)

kernel_name = 'streaming_hybrid_bandattn_gla_step'


def _rmsnorm(x, g):
    xf = x.astype(jnp.float32)
    xf = xf * lax.rsqrt(jnp.mean(xf * xf, axis=-1, keepdims=True) + EPS)
    return (xf * g.astype(jnp.float32)).astype(x.dtype)


def _rel_bias(table, dist):
    return table[:, jnp.clip(dist, -REL_CLIP, REL_CLIP) + REL_CLIP]


def _band_attention_prompt(q, k, v, rel_table):
    B, L, H, dh = q.shape
    nc = L // CHUNK
    qc = q.reshape(B, nc, CHUNK, H, dh)
    pad = jnp.zeros((B, BAND_CHUNKS, CHUNK, H, dh), k.dtype)
    kc = jnp.concatenate([pad, k.reshape(B, nc, CHUNK, H, dh)], axis=1)
    vc = jnp.concatenate([pad, v.reshape(B, nc, CHUNK, H, dh)], axis=1)
    k_band = jnp.concatenate([kc[:, o:o + nc] for o in range(BAND_CHUNKS + 1)], axis=2)
    v_band = jnp.concatenate([vc[:, o:o + nc] for o in range(BAND_CHUNKS + 1)], axis=2)
    s = jnp.einsum('bcqhd,bckhd->bchqk', qc, k_band).astype(jnp.float32) * (HEAD_DIM_A ** -0.5)
    qi = jnp.arange(CHUNK)[:, None]
    kk = jnp.arange(BAND)[None, :]
    bias = _rel_bias(rel_table, qi + BAND_PAST - kk).astype(jnp.float32)
    valid = kk[None] >= (BAND_PAST - jnp.arange(nc) * CHUNK)[:, None, None]
    s = jnp.where(valid[None, :, None], s + bias[None, None], -jnp.inf)
    p = jax.nn.softmax(s, axis=-1).astype(v.dtype)
    o = jnp.einsum('bchqk,bckhd->bcqhd', p, v_band)
    return o.reshape(B, L, H * dh)


def _band_attention_sample(q, k_new, v_new, k_cache, v_cache, rel_table):
    Bd, S, H, dh = q.shape
    W = k_cache.shape[1]
    k_all = jnp.concatenate([k_cache, k_new], axis=1)
    v_all = jnp.concatenate([v_cache, v_new], axis=1)
    s = jnp.einsum('bqhd,bkhd->bhqk', q, k_all).astype(jnp.float32) * (HEAD_DIM_A ** -0.5)
    dist = jnp.arange(S)[:, None] + W - jnp.arange(W + S)[None, :]
    s = s + _rel_bias(rel_table, dist).astype(jnp.float32)[None]
    p = jax.nn.softmax(s, axis=-1).astype(v_all.dtype)
    o = jnp.einsum('bhqk,bkhd->bqhd', p, v_all)
    return o.reshape(Bd, S, H * dh)


def _gla(q, k, v, log_a, state0, chunk):
    B, L, H, dk = q.shape
    dv = v.shape[-1]
    nc = L // chunk

    def to_chunks(t):
        return jnp.moveaxis(t.astype(jnp.float32).reshape(B, nc, chunk, H, t.shape[-1]), 1, 0)

    causal = jnp.tril(jnp.ones((chunk, chunk), bool))[None, :, :, None, None]

    def step(S, inp):
        qc, kc, vc, lac = inp
        b = jnp.cumsum(lac, axis=1)
        decay = jnp.exp(jnp.where(causal, b[:, :, None] - b[:, None, :], -jnp.inf))
        attn = jnp.einsum('bthd,bshd,btshd->bhts', qc, kc, decay)
        o = (jnp.einsum('bhts,bshv->bthv', attn, vc)
             + jnp.einsum('bthd,bhdv->bthv', qc * jnp.exp(b), S))
        b_last = b[:, -1]
        S = (jnp.exp(b_last)[..., None] * S
             + jnp.einsum('bshd,bshv->bhdv', kc * jnp.exp(b_last[:, None] - b), vc))
        return S, o

    S, o = lax.scan(step, state0.astype(jnp.float32),
                    (to_chunks(q), to_chunks(k), to_chunks(v), to_chunks(log_a)))
    o = jnp.moveaxis(o, 0, 1).reshape(B, L, H, dv)
    return o, S


def _layer(x, gla_state0, cache_k, cache_v, norm_mix_pre, norm_mix_post, norm_ffn_pre, norm_ffn_post,
           w_in, w_decay_up, b_decay, rel_bias, gla_norm, w_proj_a, w_proj_b, w_out,
           w_ffn_gate, w_ffn_up, w_ffn_down):
    B, L, _ = x.shape
    h = _rmsnorm(x, norm_mix_pre)
    proj = h @ w_in
    split_points = np.cumsum(SPLIT_WIDTHS)[:-1].tolist()
    qa, ka, va, qb, kb, vb, rb, dlr, ga, gb = jnp.split(proj, split_points, axis=-1)
    qa = qa.reshape(B, L, N_HEADS_A, HEAD_DIM_A)
    ka = ka.reshape(B, L, N_HEADS_A, HEAD_DIM_A)
    va = va.reshape(B, L, N_HEADS_A, HEAD_DIM_A)
    if cache_k is None:
        oa = _band_attention_prompt(qa, ka, va, rel_bias)
        keep = min(BAND_PAST, L)
        k_rows, v_rows = ka[:, L - keep:], va[:, L - keep:]
    else:
        oa = _band_attention_sample(qa, ka, va, cache_k, cache_v, rel_bias)
        k_rows, v_rows = ka, va
    log_a = jax.nn.log_sigmoid((dlr @ w_decay_up + b_decay).astype(jnp.float32)) / GATE_TEMP
    chunk = CHUNK if L % CHUNK == 0 else L
    ob, S = _gla((qb * (DK_HEAD_B ** -0.5)).reshape(B, L, N_HEADS_B, DK_HEAD_B),
                 kb.reshape(B, L, N_HEADS_B, DK_HEAD_B),
                 vb.reshape(B, L, N_HEADS_B, DV_HEAD_B),
                 log_a.reshape(B, L, N_HEADS_B, DK_HEAD_B),
                 gla_state0, chunk)
    ob = _rmsnorm(ob, gla_norm).astype(x.dtype).reshape(B, L, DV_B) * jax.nn.silu(rb)
    mix = jax.nn.sigmoid(ga) * (oa @ w_proj_a) + jax.nn.sigmoid(gb) * (ob @ w_proj_b)
    x = x + _rmsnorm(mix @ w_out, norm_mix_post)
    h = _rmsnorm(x, norm_ffn_pre)
    f = (jax.nn.silu(h @ w_ffn_gate) * (h @ w_ffn_up)) @ w_ffn_down
    x = x + _rmsnorm(f, norm_ffn_post)
    return x, k_rows, v_rows, S


def setup_inputs(seed: int = 0) -> dict:
    key = jax.random.key(seed)
    ks = jax.random.split(key, 24)
    f32 = jnp.float32
    past_win = min(BAND_PAST, PAST_LEN)

    def nrm(k, shape, scale):
        return scale * jax.random.normal(k, shape, f32)

    return {
        'x_prompt': nrm(ks[0], (BATCH, SEQ, D_MODEL), 1.0),
        'x_sample': nrm(ks[1], (DEC_BATCH, DEC_SEQ, D_MODEL), 1.0),
        'cache_attn_k': nrm(ks[2], (DEPTH, DEC_BATCH, past_win, N_HEADS_A, HEAD_DIM_A), 1.0),
        'cache_attn_v': nrm(ks[3], (DEPTH, DEC_BATCH, past_win, N_HEADS_A, HEAD_DIM_A), 1.0),
        'state_gla': nrm(ks[4], (DEPTH, DEC_BATCH, N_HEADS_B, DK_HEAD_B, DV_HEAD_B), 0.5),
        'norm_mix_pre': 1.0 + nrm(ks[5], (DEPTH, D_MODEL), 0.05),
        'norm_mix_post': 1.0 + nrm(ks[6], (DEPTH, D_MODEL), 0.05),
        'norm_ffn_pre': 1.0 + nrm(ks[7], (DEPTH, D_MODEL), 0.05),
        'norm_ffn_post': 1.0 + nrm(ks[8], (DEPTH, D_MODEL), 0.05),
        'w_in': nrm(ks[9], (DEPTH, D_MODEL, D_IN), D_MODEL ** -0.5),
        'w_decay_up': nrm(ks[10], (DEPTH, GATE_RANK, DK_B), GATE_RANK ** -0.5),
        'b_decay': nrm(ks[11], (DEPTH, DK_B), 0.1),
        'rel_bias': nrm(ks[12], (DEPTH, N_HEADS_A, 2 * REL_CLIP + 1), 0.1),
        'gla_norm': 1.0 + nrm(ks[13], (DEPTH, DV_HEAD_B), 0.05),
        'w_proj_a': nrm(ks[14], (DEPTH, D_A, D_MODEL), D_A ** -0.5),
        'w_proj_b': nrm(ks[15], (DEPTH, DV_B, D_MODEL), DV_B ** -0.5),
        'w_out': nrm(ks[16], (DEPTH, D_MODEL, D_MODEL), D_MODEL ** -0.5),
        'w_ffn_gate': nrm(ks[17], (DEPTH, D_MODEL, D_FF), D_MODEL ** -0.5),
        'w_ffn_up': nrm(ks[18], (DEPTH, D_MODEL, D_FF), D_MODEL ** -0.5),
        'w_ffn_down': nrm(ks[19], (DEPTH, D_FF, D_MODEL), D_FF ** -0.5),
    }


def reference(x_prompt, x_sample, cache_attn_k, cache_attn_v, state_gla,
              norm_mix_pre, norm_mix_post, norm_ffn_pre, norm_ffn_post,
              w_in, w_decay_up, b_decay, rel_bias, gla_norm, w_proj_a, w_proj_b, w_out,
              w_ffn_gate, w_ffn_up, w_ffn_down):
    yp, ys = x_prompt, x_sample
    kp_l, vp_l, sp_l, ks_l, vs_l, ss_l = [], [], [], [], [], []
    for l in range(DEPTH):
        w = (norm_mix_pre[l], norm_mix_post[l], norm_ffn_pre[l], norm_ffn_post[l],
             w_in[l], w_decay_up[l], b_decay[l], rel_bias[l], gla_norm[l],
             w_proj_a[l], w_proj_b[l], w_out[l], w_ffn_gate[l], w_ffn_up[l], w_ffn_down[l])
        s0 = jnp.zeros((yp.shape[0], N_HEADS_B, DK_HEAD_B, DV_HEAD_B), jnp.float32)
        yp, kp, vp, sp = _layer(yp, s0, None, None, *w)
        ys, kn, vn, sn = _layer(ys, state_gla[l], cache_attn_k[l], cache_attn_v[l], *w)
        kp_l.append(kp)
        vp_l.append(vp)
        sp_l.append(sp.astype(x_prompt.dtype))
        ks_l.append(kn)
        vs_l.append(vn)
        ss_l.append(sn.astype(state_gla.dtype))
    return (yp, ys, jnp.stack(kp_l), jnp.stack(vp_l), jnp.stack(sp_l),
            jnp.stack(ks_l), jnp.stack(vs_l), jnp.stack(ss_l))
```

```cpp
#include <hip/hip_runtime.h>
#include <hip/hip_cooperative_groups.h>
#include <cstdio>
namespace cg = cooperative_groups;

#define LAS __attribute__((address_space(3)))
typedef unsigned short bf16_t;
typedef short bf16x8 __attribute__((ext_vector_type(8)));
typedef float f32x4 __attribute__((ext_vector_type(4)));
typedef float f32x2 __attribute__((ext_vector_type(2)));
typedef unsigned u32x4 __attribute__((ext_vector_type(4)));
typedef unsigned u32x2 __attribute__((ext_vector_type(2)));

constexpr int MP = 16384, MS = 1024, MT = MP + MS, DM = 1024, DIN = 6672, NIN = 6656, DFF = 2816, NGU = 2 * DFF;
constexpr float EPS = 1e-6f;
constexpr size_t O_Y = 0, O_KP = 17825792, O_VP = 18087936, O_SP = 18350080, O_KS = 18481152, O_VS = 19005440, O_SS = 19529728;
constexpr size_t WS_WIN = 0, WS_WPA = 13631488, WS_WPB = 14680064, WS_WOUT = 16777216, WS_WGU = 18874368, WS_WDN = 30408704, WS_RSS1 = 36175872, WS_RSS2 = WS_RSS1 + 69632;
constexpr size_t WS_ACT = 36700160;
constexpr size_t A_QA = WS_ACT, A_KA = A_QA + 17825792, A_VA = A_KA + 17825792, A_QB = A_VA + 17825792, A_KB = A_QB + 17825792, A_VB = A_KB + 17825792,
                 A_RB = A_VB + 35651584, A_GA = A_RB + 35651584, A_GB = A_GA + 35651584, A_END = A_GB + 35651584, A_HID = A_QA;
static_assert(A_END == 268435456, "ws map");
constexpr size_t Y_H = 0, Y_US = 0, Y_DLR = 67108864, Y_DEC = Y_DLR + 1114112;
static_assert(Y_DEC + 524288 <= 71303168, "y scratch");

typedef __bf16 bf16x2_t __attribute__((ext_vector_type(2)));
__device__ __forceinline__ unsigned cvt_pk_bf16(float lo, float hi) { f32x2 v = {lo, hi}; bf16x2_t b = __builtin_convertvector(v, bf16x2_t); return __builtin_bit_cast(unsigned, b); }
__device__ __forceinline__ float bf_lo(unsigned u) { return __uint_as_float(u << 16); }
__device__ __forceinline__ float bf_hi(unsigned u) { return __uint_as_float(u & 0xffff0000u); }
__device__ __forceinline__ float bf2f(bf16_t b) { return __uint_as_float(((unsigned)b) << 16); }
__device__ __forceinline__ bf16_t f2bf(float f) { return (bf16_t)(cvt_pk_bf16(f, 0.f) & 0xffffu); }
__device__ __forceinline__ float wave_sum(float v) { for (int o = 32; o >= 1; o >>= 1) v += __shfl_xor(v, o); return v; }
__device__ __forceinline__ void wave_lds_sync() { asm volatile("s_waitcnt lgkmcnt(0)" ::: "memory"); __builtin_amdgcn_wave_barrier(); }
__device__ __forceinline__ float fast_sigmoid(float x) { return __builtin_amdgcn_rcpf(1.0f + __expf(-x)); }
__device__ __forceinline__ bf16x8 mk8(u32x2 a, u32x2 b) { u32x4 w; w.x = a.x; w.y = a.y; w.z = b.x; w.w = b.y; return __builtin_bit_cast(bf16x8, w); }
__device__ __forceinline__ bf16x8 pk8(f32x4 a, f32x4 b) { u32x4 w; w.x = cvt_pk_bf16(a[0], a[1]); w.y = cvt_pk_bf16(a[2], a[3]); w.z = cvt_pk_bf16(b[0], b[1]); w.w = cvt_pk_bf16(b[2], b[3]); return __builtin_bit_cast(bf16x8, w); }
#define MFMA16(a, b, c) __builtin_amdgcn_mfma_f32_16x16x32_bf16((a), (b), (c), 0, 0, 0)

namespace pg8 {
#define PG8_LAS __attribute__((address_space(3)))
constexpr int BM = 256, BK = 64, HALF = 128, HTB = HALF * BK * 2, STAGE_BYTES = 8 * HTB, NXCD = 8, WGM = 8;
__host__ __device__ __forceinline__ int lds_byte(int r, int c) { const int st = (r >> 4) * 2 + (c >> 5), rr = r & 15, cc = c & 31, ob = rr * 64 + cc * 2; return st * 1024 + (ob ^ (((ob >> 9) & 1) << 5)); }
__host__ __device__ __forceinline__ void stage_rc(int b, int& R, int& C) { const int st = b / 1024, sb = b % 1024, swz = sb ^ (((sb >> 9) & 1) << 5); R = (st >> 1) * 16 + swz / 64; C = (st & 1) * 32 + (swz % 64) / 2; }
__host__ __device__ __forceinline__ int perm32(int rho) { const int n = rho >> 4, i = rho & 15; return 8 * (i >> 2) + 4 * n + (i & 3); }
struct Unit { int pm, pn; };
struct Gemm { const bf16_t* A; const bf16_t* Bt; int M, N, K; };
struct StaticOrder {
    int nM, nN, nwg, G, c;
    __host__ __device__ void init(int M, int N, int G_, int c_) { nM = M / BM; nN = N / BM; nwg = nM * nN; G = G_; c = c_; }
    __host__ __device__ bool next(int i, Unit& u) const {
        const long L = (long)i * G + c; if (L >= nwg) return false;
        int wgid = (int)L; { const int q = nwg / NXCD, r = nwg % NXCD, xcd = wgid % NXCD, off = wgid / NXCD; wgid = (xcd < r ? xcd * (q + 1) : r * (q + 1) + (xcd - r) * q) + off; }
        const int nig = WGM * nN, gid = wgid / nig, fm = gid * WGM, gsz = (nM - fm) < WGM ? (nM - fm) : WGM;
        u.pm = fm + ((wgid % nig) % gsz); u.pn = (wgid % nig) / gsz; return true;
    }
    __device__ __forceinline__ void a_ready(const Unit&) const {}
    __device__ __forceinline__ void done(const Unit&) const {}
};
template <class Epi, class Sched, bool ALIGN_EPI = false, bool SP2 = false>
__device__ __forceinline__ void gemm_phase(PG8_LAS unsigned char* lds, const Gemm g, const Sched& S, const Epi& E) {
    const int tid = threadIdx.x, wid = __builtin_amdgcn_readfirstlane(tid >> 6), lane = tid & 63, wr = wid >> 2, wc = wid & 3, fr = lane & 15, fq = lane >> 4;
    const int K = g.K, nt = K / BK;
    unsigned voffA[2], voffB[2];
#pragma unroll
    for (int i = 0; i < 2; ++i) { int R, C; stage_rc(tid * 16 + i * 8192, R, C); const int Rb = Epi::PERM ? ((R & ~31) + perm32(R & 31)) : R;
        voffA[i] = (unsigned)(R * K + C) * 2u; voffB[i] = (unsigned)(Rb * K + C) * 2u; }
    const size_t kstep = (size_t)(BK * 2);
    const size_t hstep = (size_t)HALF * K * 2;
    const size_t tstep = 2 * hstep;
    const unsigned ldsw = (unsigned)wid * 1024u;
    const int aoff = lds_byte(wr * 64 + fr, fq * 8), boff = lds_byte(wc * 32 + fr, fq * 8);
#define PG8_SA(b, h) (((b) * 2 + (h)) * HTB)
#define PG8_SB(b, h) ((4 + (b) * 2 + (h)) * HTB)
#define PG8_STAGE(bufoff, gbase, voff) do { _Pragma("unroll") for (int _i = 0; _i < 2; ++_i) \
        __builtin_amdgcn_global_load_lds((const unsigned*)((const char*)(gbase) + (voff)[_i]), (PG8_LAS unsigned*)(lds + (bufoff) + ldsw + _i * 8192), 16, 0, 0); } while (0)
#define PG8_LDA(dst, b, h) do { _Pragma("unroll") for (int m = 0; m < 4; ++m) _Pragma("unroll") for (int k = 0; k < 2; ++k) dst[m][k] = *(const PG8_LAS bf16x8*)(lds + PG8_SA(b, h) + aoff + m * 2048 + k * 1024); } while (0)
#define PG8_LDB(dst, b, h) do { _Pragma("unroll") for (int n = 0; n < 2; ++n) _Pragma("unroll") for (int k = 0; k < 2; ++k) dst[n][k] = *(const PG8_LAS bf16x8*)(lds + PG8_SB(b, h) + boff + n * 2048 + k * 1024); } while (0)
#define PG8_MMA(ai, bj, At, Bt) do { __builtin_amdgcn_s_setprio(1); _Pragma("unroll") for (int m = 0; m < 4; ++m) _Pragma("unroll") for (int n = 0; n < 2; ++n) _Pragma("unroll") for (int k = 0; k < 2; ++k) \
        acc[ai][bj][m][n] = __builtin_amdgcn_mfma_f32_16x16x32_bf16(Bt[n][k], At[m][k], acc[ai][bj][m][n], 0, 0, 0); __builtin_amdgcn_s_setprio(0); } while (0)
#define PG8_WAIT_V(n) asm volatile("s_waitcnt vmcnt(" #n ")" ::: "memory")
#define PG8_WAIT_L(n) asm volatile("s_waitcnt lgkmcnt(" #n ")" ::: "memory")
#define PG8_BAR __builtin_amdgcn_s_barrier()
#define PG8_SCHED __builtin_amdgcn_sched_barrier(0)
    Unit cur, nxt; int ui = 0;
    if (!S.next(0, cur)) return;
    f32x4 acc[2][2][4][2];
#pragma unroll
    for (int a = 0; a < 2; ++a)
#pragma unroll
        for (int b = 0; b < 2; ++b)
#pragma unroll
            for (int m = 0; m < 4; ++m)
#pragma unroll
                for (int n = 0; n < 2; ++n) acc[a][b][m][n] = (f32x4){0.f, 0.f, 0.f, 0.f};
    bf16x8 At[4][2], B0[2][2], B1[2][2];
    const char* cA = (const char*)g.A + (size_t)cur.pm * tstep; const char* cB = (const char*)g.Bt + (size_t)cur.pn * tstep;
    S.a_ready(cur);
    if constexpr (SP2) {
        PG8_STAGE(PG8_SB(0, 0), cB, voffB); PG8_STAGE(PG8_SB(0, 1), cB + hstep, voffB); PG8_STAGE(PG8_SA(0, 0), cA, voffA); PG8_STAGE(PG8_SA(0, 1), cA + hstep, voffA);
        if (wr == 1) PG8_BAR;
        PG8_WAIT_V(2); PG8_BAR;
        PG8_STAGE(PG8_SB(1, 0), cB + kstep, voffB); PG8_STAGE(PG8_SA(1, 0), cA + kstep, voffA); PG8_STAGE(PG8_SB(1, 1), cB + hstep + kstep, voffB);
        PG8_WAIT_V(6); PG8_BAR;
    } else {
        PG8_STAGE(PG8_SB(0, 0), cB, voffB); PG8_STAGE(PG8_SA(0, 0), cA, voffA); PG8_STAGE(PG8_SB(0, 1), cB + hstep, voffB); PG8_STAGE(PG8_SA(0, 1), cA + hstep, voffA);
        if (wr == 1) PG8_BAR;
        PG8_WAIT_V(4); PG8_BAR;
        PG8_STAGE(PG8_SB(1, 0), cB + kstep, voffB); PG8_STAGE(PG8_SA(1, 0), cA + kstep, voffA); PG8_STAGE(PG8_SB(1, 1), cB + hstep + kstep, voffB);
        PG8_WAIT_V(6); PG8_BAR;
    }
    for (;;) {
        const bool has_next = S.next(ui + 1, nxt);
        const char* nA = has_next ? (const char*)g.A + (size_t)nxt.pm * tstep : cA; const char* nB = has_next ? (const char*)g.Bt + (size_t)nxt.pn * tstep : cB;
        for (int t = 0; t < nt; t += 2) {
            const bool last = (t == nt - 2);
            const char* a1 = cA + (size_t)(t + 1) * kstep;
            const char* a2 = last ? nA : cA + (size_t)(t + 2) * kstep; const char* b2 = last ? nB : cB + (size_t)(t + 2) * kstep;
            const char* a3 = a2 + kstep; const char* b3 = b2 + kstep;
            if (last && has_next) S.a_ready(nxt);
            if constexpr (SP2) {
            PG8_LDB(B0, 0, 0); PG8_LDB(B1, 0, 1); PG8_SCHED; PG8_LDA(At, 0, 0); PG8_STAGE(PG8_SA(1, 1), a1 + hstep, voffA);
            PG8_WAIT_V(8); PG8_WAIT_L(0); PG8_BAR; PG8_MMA(0, 0, At, B0); PG8_MMA(0, 1, At, B1); PG8_BAR; PG8_SCHED;
            PG8_LDA(At, 0, 1); PG8_STAGE(PG8_SB(0, 0), b2, voffB); PG8_STAGE(PG8_SB(0, 1), b2 + hstep, voffB); PG8_STAGE(PG8_SA(0, 0), a2, voffA);
            PG8_WAIT_V(8); PG8_WAIT_L(0); PG8_BAR; PG8_MMA(1, 0, At, B0); PG8_MMA(1, 1, At, B1); PG8_BAR; PG8_SCHED;
            PG8_LDB(B0, 1, 0); PG8_LDB(B1, 1, 1); PG8_SCHED; PG8_LDA(At, 1, 0); PG8_STAGE(PG8_SA(0, 1), a2 + hstep, voffA);
            PG8_WAIT_V(8); PG8_WAIT_L(0); PG8_BAR; PG8_MMA(0, 0, At, B0); PG8_MMA(0, 1, At, B1); PG8_BAR; PG8_SCHED;
            PG8_LDA(At, 1, 1); PG8_STAGE(PG8_SB(1, 0), b3, voffB); PG8_STAGE(PG8_SB(1, 1), b3 + hstep, voffB); PG8_STAGE(PG8_SA(1, 0), a3, voffA);
            PG8_WAIT_V(8); PG8_WAIT_L(0); PG8_BAR; PG8_MMA(1, 0, At, B0); PG8_MMA(1, 1, At, B1); PG8_BAR; PG8_SCHED;
            } else {
            PG8_LDB(B0, 0, 0); PG8_SCHED; PG8_LDA(At, 0, 0); PG8_STAGE(PG8_SA(1, 1), a1 + hstep, voffA);
            PG8_WAIT_L(8); PG8_BAR; PG8_WAIT_L(0); PG8_MMA(0, 0, At, B0); PG8_BAR; PG8_SCHED;
            PG8_LDB(B1, 0, 1); PG8_STAGE(PG8_SB(0, 0), b2, voffB);
            PG8_BAR; PG8_WAIT_L(0); PG8_MMA(0, 1, At, B1); PG8_BAR;
            PG8_LDA(At, 0, 1); PG8_STAGE(PG8_SA(0, 0), a2, voffA);
            PG8_BAR; PG8_WAIT_L(0); PG8_MMA(1, 0, At, B0); PG8_BAR; PG8_SCHED;
            PG8_STAGE(PG8_SB(0, 1), b2 + hstep, voffB);
            PG8_WAIT_V(6); PG8_BAR; PG8_MMA(1, 1, At, B1); PG8_BAR;
            PG8_LDB(B0, 1, 0); PG8_SCHED; PG8_LDA(At, 1, 0); PG8_STAGE(PG8_SA(0, 1), a2 + hstep, voffA);
            PG8_WAIT_L(8); PG8_BAR; PG8_WAIT_L(0); PG8_MMA(0, 0, At, B0); PG8_BAR; PG8_SCHED;
            PG8_LDB(B1, 1, 1); PG8_STAGE(PG8_SB(1, 0), b3, voffB);
            PG8_BAR; PG8_WAIT_L(0); PG8_MMA(0, 1, At, B1); PG8_BAR;
            PG8_LDA(At, 1, 1); PG8_STAGE(PG8_SA(1, 0), a3, voffA);
            PG8_BAR; PG8_WAIT_L(0); PG8_MMA(1, 0, At, B0); PG8_BAR; PG8_SCHED;
            PG8_STAGE(PG8_SB(1, 1), b3 + hstep, voffB);
            PG8_WAIT_V(6); PG8_BAR; PG8_MMA(1, 1, At, B1); PG8_BAR;
            }
        }
        if constexpr (ALIGN_EPI) { if (wr == 0) PG8_BAR; }
        if constexpr (!Epi::AFTER_DRAIN) { E(acc, cur, wr, wc, fr, fq); S.done(cur); }
        if (!has_next) break;
#pragma unroll
        for (int a = 0; a < 2; ++a)
#pragma unroll
            for (int b = 0; b < 2; ++b)
#pragma unroll
                for (int m = 0; m < 4; ++m)
#pragma unroll
                    for (int n = 0; n < 2; ++n) acc[a][b][m][n] = (f32x4){0.f, 0.f, 0.f, 0.f};
        cur = nxt; cA = nA; cB = nB; ++ui;
        if constexpr (ALIGN_EPI) { if (wr == 1) PG8_BAR; }
    }
    PG8_WAIT_V(0);
    if constexpr (!ALIGN_EPI) { if (wr == 0) PG8_BAR; }
    PG8_BAR;
    if constexpr (Epi::AFTER_DRAIN) { E.fused(acc, cur, wr, wc, fr, fq, lds, wid, lane); S.done(cur); }
#undef PG8_SA
#undef PG8_SB
#undef PG8_STAGE
#undef PG8_LDA
#undef PG8_LDB
#undef PG8_MMA
#undef PG8_WAIT_V
#undef PG8_WAIT_L
#undef PG8_BAR
#undef PG8_SCHED
}
}

typedef f32x4 AccT[2][2][4][2];
__device__ __forceinline__ u32x2 pk4(f32x4 v) { u32x2 w; w.x = cvt_pk_bf16(v[0], v[1]); w.y = cvt_pk_bf16(v[2], v[3]); return w; }
__device__ __forceinline__ f32x4 up4(u32x2 w) { return (f32x4){bf_lo(w.x), bf_hi(w.x), bf_lo(w.y), bf_hi(w.y)}; }

struct EpiIn {
    static constexpr bool PERM = true, AFTER_DRAIN = false;
    unsigned char* ws; float* out;
    __device__ __forceinline__ void operator()(const AccT& acc, const pg8::Unit& u, int wr, int wc, int fr, int fq) const {
        const int pn = u.pn; size_t off; int ldc = 512, cb, mode = 0, kv = 0; float scale = 1.f;
        if (pn < 2) { off = A_QA; cb = pn; mode = 1; scale = 0.125f * 1.4426950408889634f; }
        else if (pn < 4) { off = A_KA; cb = pn - 2; kv = 1; }
        else if (pn < 6) { off = A_VA; cb = pn - 4; kv = 2; }
        else if (pn < 8) { off = A_QB; cb = pn - 6; mode = 1; scale = 0.08838834764831845f; }
        else if (pn < 10) { off = A_KB; cb = pn - 8; }
        else if (pn < 14) { off = A_VB; cb = pn - 10; ldc = 1024; }
        else if (pn < 18) { off = A_RB; cb = pn - 14; ldc = 1024; mode = 2; }
        else if (pn < 22) { off = A_GA; cb = pn - 18; ldc = 1024; mode = 3; }
        else { off = A_GB; cb = pn - 22; ldc = 1024; mode = 3; }
        bf16_t* dst = (bf16_t*)(ws + off);
        const int col0 = cb * 256 + wc * 32 + 8 * fq, row0 = u.pm * 256 + wr * 64 + fr;
        const bool f32out = (kv != 0) && (u.pm >= 62);
        float* ob = nullptr;
        if (f32out) ob = (u.pm < 64) ? out + (kv == 1 ? O_KP : O_VP) - (size_t)15872 * 512 : out + (kv == 1 ? O_KS : O_VS) - (size_t)16384 * 512;
#pragma unroll
        for (int ai = 0; ai < 2; ++ai)
#pragma unroll
            for (int m = 0; m < 4; ++m) { const int row = row0 + ai * 128 + m * 16;
#pragma unroll
                for (int bj = 0; bj < 2; ++bj) { f32x4 v0 = acc[ai][bj][m][0], v1 = acc[ai][bj][m][1]; const int col = col0 + bj * 128;
                    if (f32out) { float* o = ob + (size_t)row * 512 + col; *(f32x4*)o = v0; *(f32x4*)(o + 4) = v1; }
                    if (mode == 1) { v0 = v0 * scale; v1 = v1 * scale; }
                    else if (mode == 2) { for (int j = 0; j < 4; ++j) { v0[j] = v0[j] * fast_sigmoid(v0[j]); v1[j] = v1[j] * fast_sigmoid(v1[j]); } }
                    else if (mode == 3) { for (int j = 0; j < 4; ++j) { v0[j] = fast_sigmoid(v0[j]); v1[j] = fast_sigmoid(v1[j]); } }
                    *(bf16x8*)(dst + (size_t)row * ldc + col) = pk8(v0, v1); }
                asm volatile("" ::: "memory"); }
    }
};
template <int MODE, bool DRYE = false> struct EpiN1024 {
    static constexpr bool PERM = false, AFTER_DRAIN = false;
    bf16_t* io; const bf16_t* g2; float* rowss; int row_base;
    __device__ __forceinline__ void operator()(const AccT& acc, const pg8::Unit& u, int wr, int wc, int fr, int fq) const {
        const int col0 = u.pn * 256 + wc * 32 + 4 * fq, row0 = row_base + u.pm * 256 + wr * 64 + fr;
#pragma unroll
        for (int ai = 0; ai < 2; ++ai)
#pragma unroll
            for (int m = 0; m < 4; ++m) { const int row = row0 + ai * 128 + m * 16; float ss = 0.f;
#pragma unroll
                for (int bj = 0; bj < 2; ++bj)
#pragma unroll
                    for (int n = 0; n < 2; ++n) { f32x4 v = acc[ai][bj][m][n]; const size_t idx = (size_t)row * 1024 + col0 + bj * 128 + n * 16;
                        if (MODE == 0) v = v * up4(*(const u32x2*)(io + idx));
                        else if (MODE == 1) v = up4(*(const u32x2*)(io + idx)) + up4(*(const u32x2*)(g2 + idx)) * v;
                        else ss += (v[0] * v[0] + v[1] * v[1]) + (v[2] * v[2] + v[3] * v[3]);
                        if (!DRYE || v[0] == 123.456f) *(u32x2*)(io + idx) = pk4(v); }
                if (MODE == 2 && !DRYE) { ss += __shfl_xor(ss, 16); ss += __shfl_xor(ss, 32); if (fq == 0) atomicAdd(rowss + row, ss); } }
    }
};
template <int MODE> using EpiN1024D = EpiN1024<MODE, true>;
struct EpiSwiglu {
    static constexpr bool PERM = true, AFTER_DRAIN = false;
    bf16_t* hid;
    __device__ __forceinline__ void operator()(const AccT& acc, const pg8::Unit& u, int wr, int wc, int fr, int fq) const {
        const int col0 = u.pn * 128 + wc * 32 + 8 * fq, row0 = u.pm * 256 + wr * 64 + fr;
#pragma unroll
        for (int ai = 0; ai < 2; ++ai)
#pragma unroll
            for (int m = 0; m < 4; ++m) { const int row = row0 + ai * 128 + m * 16; f32x4 v0, v1;
#pragma unroll
                for (int j = 0; j < 4; ++j) { const float g0 = acc[ai][0][m][0][j], g1 = acc[ai][0][m][1][j];
                    v0[j] = g0 * fast_sigmoid(g0) * acc[ai][1][m][0][j]; v1[j] = g1 * fast_sigmoid(g1) * acc[ai][1][m][1][j]; }
                *(bf16x8*)(hid + (size_t)row * DFF + col0) = pk8(v0, v1); }
    }
};

struct Args { const float* in[20]; float* out; unsigned char* ws; int ph_lo, ph_hi; };
enum { I_XP = 0, I_XS, I_CK, I_CV, I_ST, I_NMPRE, I_NMPOST, I_NFPRE, I_NFPOST, I_WIN, I_WUP, I_BDEC, I_RELB, I_GNORM, I_WPA, I_WPB, I_WOUT, I_WG, I_WU, I_WD };
constexpr int LDS_BYTES = 147456;

__device__ __forceinline__ void p0_convert(const Args& a, LAS float* scr, int gw, int NGW, int lane) {
    constexpr int I_IN = 104 * 16, I_PA = 16 * 8, I_PB = 16 * 16, I_OUT = 16 * 16, I_GU = 88 * 16, I_DN = 16 * 44, TOTAL = I_IN + I_PA + I_PB + I_OUT + I_GU + I_DN;
    for (int it = gw; it < TOTAL; it += NGW) {
        int r = it, kind, K; size_t dsto;
        if (r < I_IN) { kind = 0; K = 1024; dsto = WS_WIN; }
        else if ((r -= I_IN) < I_PA) { kind = 1; K = 512; dsto = WS_WPA; }
        else if ((r -= I_PA) < I_PB) { kind = 2; K = 1024; dsto = WS_WPB; }
        else if ((r -= I_PB) < I_OUT) { kind = 3; K = 1024; dsto = WS_WOUT; }
        else if ((r -= I_OUT) < I_GU) { kind = 4; K = 1024; dsto = WS_WGU; }
        else { r -= I_GU; kind = 5; K = 2816; dsto = WS_WDN; }
        const int ktiles = K >> 6, n0 = (r / ktiles) * 64, k0 = (r % ktiles) * 64, n = n0 + lane;
        const float* sp; int srcN;
        if (kind == 0) { sp = a.in[I_WIN] + (n < 4608 ? n : n + 16); srcN = DIN; }
        else if (kind == 1) { sp = a.in[I_WPA] + n; srcN = 1024; }
        else if (kind == 2) { sp = a.in[I_WPB] + n; srcN = 1024; }
        else if (kind == 3) { sp = a.in[I_WOUT] + n; srcN = 1024; }
        else if (kind == 4) { const int pn = n >> 8, rr = n & 255; sp = ((rr < 128) ? a.in[I_WG] : a.in[I_WU]) + 128 * pn + (rr & 127); srcN = DFF; }
        else { sp = a.in[I_WD] + n; srcN = 1024; }
        sp += (size_t)k0 * srcN;
        float tmp[64];
#pragma unroll
        for (int i = 0; i < 64; ++i) tmp[i] = sp[(size_t)i * srcN];
#pragma unroll
        for (int i = 0; i < 64; ++i) scr[lane * 65 + i] = tmp[i];
        wave_lds_sync();
        unsigned* dst = (unsigned*)(a.ws + dsto) + ((size_t)n0 * K + k0) / 2 + (lane & 31);
#pragma unroll 8
        for (int j = 0; j < 32; ++j) { const int row = 2 * j + (lane >> 5), kk = (lane & 31) * 2; dst[(size_t)row * (K / 2)] = cvt_pk_bf16(scr[row * 65 + kk], scr[row * 65 + kk + 1]); }
        wave_lds_sync();
    }
}
__device__ __forceinline__ const float* xrow_ptr(const Args& a, int row) { return row < MP ? a.in[I_XP] + (size_t)row * DM : a.in[I_XS] + (size_t)(row - MP) * DM; }
__device__ __forceinline__ void p0_rows(const Args& a, LAS unsigned char* lds, int gw, int NGW, int wave, int lane, int tid) {
    LAS float* WdL = (LAS float*)lds;
    LAS float* hrow = (LAS float*)(lds + 4 * 4112 * 4) + wave * 1056;
    for (int idx = tid; idx < 1024 * 16; idx += 512) { const int k = idx >> 4, j = idx & 15; WdL[(k >> 8) * 4112 + (k & 255) * 16 + j] = a.in[I_WIN][(size_t)k * DIN + 4608 + j]; }
    __syncthreads();
    bf16_t* H = (bf16_t*)((unsigned char*)a.out + Y_H); float* DLR = (float*)((unsigned char*)a.out + Y_DLR);
    const f32x4* gp = (const f32x4*)a.in[I_NMPRE] + lane; f32x4 g[4];
#pragma unroll
    for (int j = 0; j < 4; ++j) g[j] = gp[64 * j];
    for (int row = gw; row < MT; row += NGW) {
        const f32x4* xr = (const f32x4*)xrow_ptr(a, row) + lane; f32x4 v[4]; float s = 0.f;
#pragma unroll
        for (int j = 0; j < 4; ++j) { v[j] = xr[64 * j]; s += (v[j][0] * v[j][0] + v[j][1] * v[j][1]) + (v[j][2] * v[j][2] + v[j][3] * v[j][3]); }
        const float rstd = rsqrtf(wave_sum(s) * (1.f / DM) + EPS);
        u32x2* ho = (u32x2*)(H + (size_t)row * DM) + lane;
#pragma unroll
        for (int j = 0; j < 4; ++j) { v[j] = v[j] * rstd * g[j]; ho[64 * j] = pk4(v[j]); *(LAS f32x4*)(hrow + j * 264 + 4 * lane) = v[j]; }
        wave_lds_sync();
        const int jj = lane & 15, p = lane >> 4; float acc = 0.f;
        const LAS float* hp = hrow + p * 264; const LAS float* wp = WdL + p * 4112 + jj;
#pragma unroll 8
        for (int kk = 0; kk < 256; ++kk) acc += hp[kk] * wp[kk * 16];
        acc += __shfl_xor(acc, 16); acc += __shfl_xor(acc, 32);
        if (lane < 16) DLR[(size_t)row * 16 + jj] = acc;
        wave_lds_sync();
    }
}

__device__ __forceinline__ void row_pass1(const Args& a, int row_lo, int row_hi, int gw, int NGW, int lane) {
    const bf16_t* Y = (const bf16_t*)(a.ws + A_GB); bf16_t* A2 = (bf16_t*)(a.ws + A_RB); const float* rss = (const float*)(a.ws + WS_RSS1); float* XO = a.out + O_Y;
    f32x4 gp[4], gq[4];
#pragma unroll
    for (int j = 0; j < 4; ++j) { gp[j] = ((const f32x4*)a.in[I_NMPOST])[lane + 64 * j]; gq[j] = ((const f32x4*)a.in[I_NFPRE])[lane + 64 * j]; }
    for (int r0 = row_lo + 2 * gw; r0 < row_hi; r0 += 2 * NGW) {
        f32x4 xv[2][4]; u32x2 yv[2][4]; float rs[2];
#pragma unroll
        for (int r = 0; r < 2; ++r) { const int row = (r0 + r < row_hi) ? r0 + r : r0; rs[r] = rss[row];
            const f32x4* xr = (const f32x4*)xrow_ptr(a, row) + lane; const u32x2* yr = (const u32x2*)(Y + (size_t)row * DM) + lane;
#pragma unroll
            for (int j = 0; j < 4; ++j) { xv[r][j] = xr[64 * j]; yv[r][j] = yr[64 * j]; } }
#pragma unroll
        for (int r = 0; r < 2; ++r) { const int row = r0 + r; if (row >= row_hi) break;
            const float rstd = rsqrtf(rs[r] * (1.f / DM) + EPS); f32x4 v[4]; float s = 0.f;
#pragma unroll
            for (int j = 0; j < 4; ++j) { v[j] = xv[r][j] + up4(yv[r][j]) * rstd * gp[j]; s += (v[j][0] * v[j][0] + v[j][1] * v[j][1]) + (v[j][2] * v[j][2] + v[j][3] * v[j][3]); }
            const float rstd2 = rsqrtf(wave_sum(s) * (1.f / DM) + EPS);
            f32x4* xo = (f32x4*)(XO + (size_t)row * DM) + lane; u32x2* ao = (u32x2*)(A2 + (size_t)row * DM) + lane;
#pragma unroll
            for (int j = 0; j < 4; ++j) { xo[64 * j] = v[j]; ao[64 * j] = pk4(v[j] * rstd2 * gq[j]); } }
    }
}
template <bool DRYR = false>
__device__ __forceinline__ void row_pass2(const Args& a, int row_lo, int row_hi, int gw, int NGW, int lane) {
    const bf16_t* F = (const bf16_t*)(a.ws + A_GA); const float* rss = (const float*)(a.ws + WS_RSS2); float* XO = a.out + O_Y;
    f32x4 gp[4];
#pragma unroll
    for (int j = 0; j < 4; ++j) gp[j] = ((const f32x4*)a.in[I_NFPOST])[lane + 64 * j];
    for (int r0 = row_lo + 2 * gw; r0 < row_hi; r0 += 2 * NGW) {
        f32x4 xv[2][4]; u32x2 fv[2][4]; float rs[2];
#pragma unroll
        for (int r = 0; r < 2; ++r) { const int row = (r0 + r < row_hi) ? r0 + r : r0; rs[r] = rss[row];
            const f32x4* xo = (const f32x4*)(XO + (size_t)row * DM) + lane; const u32x2* fr = (const u32x2*)(F + (size_t)row * DM) + lane;
#pragma unroll
            for (int j = 0; j < 4; ++j) { xv[r][j] = xo[64 * j]; fv[r][j] = fr[64 * j]; } }
#pragma unroll
        for (int r = 0; r < 2; ++r) { const int row = r0 + r; if (row >= row_hi) break;
            const float rstd = rsqrtf(rs[r] * (1.f / DM) + EPS); f32x4* xo = (f32x4*)(XO + (size_t)row * DM) + lane;
#pragma unroll
            for (int j = 0; j < 4; ++j) { const f32x4 o = xv[r][j] + up4(fv[r][j]) * rstd * gp[j]; if (!DRYR || o[0] == 123.456f) xo[64 * j] = o; } }
    }
}

constexpr int VT_PITCH = 72;
__device__ __forceinline__ bf16x8 ld8_f32(const float* p) { const f32x4 a = *(const f32x4*)p, b = *(const f32x4*)(p + 4); return pk8(a, b); }
template <bool SAMPLE>
__device__ __forceinline__ void attn_load(const Args& a, int idx, int h, int kt, int lane, bf16x8 (&ka)[4][2], bf16x8 (&vv)[8]) {
    const int fr = lane & 15, kq = lane >> 4;
    if (SAMPLE && kt < 8) {
        const size_t base = ((size_t)(idx * 512 + 64 * kt)) * 512 + h * 64; const float* ck = a.in[I_CK] + base; const float* cv = a.in[I_CV] + base;
#pragma unroll
        for (int mt = 0; mt < 4; ++mt)
#pragma unroll
            for (int ks = 0; ks < 2; ++ks) ka[mt][ks] = ld8_f32(ck + (size_t)(16 * mt + fr) * 512 + 32 * ks + 8 * kq);
#pragma unroll
        for (int g = 0; g < 8; ++g) vv[g] = ld8_f32(cv + (size_t)(8 * g + (lane >> 3)) * 512 + 8 * (lane & 7));
    } else {
        const bf16_t* KA = (const bf16_t*)(a.ws + A_KA); const bf16_t* VA = (const bf16_t*)(a.ws + A_VA);
        const int krow0 = SAMPLE ? MP + idx * 32 : (idx - 8 + kt) * 64, nvalid = SAMPLE ? 32 : 64;
#pragma unroll
        for (int mt = 0; mt < 4; ++mt) { int key = 16 * mt + fr; if (key >= nvalid) key = nvalid - 1;
#pragma unroll
            for (int ks = 0; ks < 2; ++ks) ka[mt][ks] = *(const bf16x8*)(KA + (size_t)(krow0 + key) * 512 + h * 64 + 32 * ks + 8 * kq); }
#pragma unroll
        for (int g = 0; g < 8; ++g) { int key = 8 * g + (lane >> 3); if (key >= nvalid) key = nvalid - 1;
            vv[g] = *(const bf16x8*)(VA + (size_t)(krow0 + key) * 512 + h * 64 + 8 * (lane & 7)); }
    }
}
__device__ __forceinline__ void attn_load_kraw(const Args& a, int idx, int h, int kt, int half, int lane, f32x4 (&kr)[8]) {
    const int fr = lane & 15, kq = lane >> 4; const float* ck = a.in[I_CK] + ((size_t)(idx * 512 + 64 * kt)) * 512 + h * 64;
#pragma unroll
    for (int m = 0; m < 2; ++m)
#pragma unroll
        for (int ks = 0; ks < 2; ++ks) { const float* p = ck + (size_t)(16 * (2 * half + m) + fr) * 512 + 32 * ks + 8 * kq; kr[(m * 2 + ks) * 2] = *(const f32x4*)p; kr[(m * 2 + ks) * 2 + 1] = *(const f32x4*)(p + 4); }
}
__device__ __forceinline__ void attn_load_vraw(const Args& a, int idx, int h, int kt, int half, int lane, f32x4 (&vr)[8]) {
    const float* cv = a.in[I_CV] + ((size_t)(idx * 512 + 64 * kt)) * 512 + h * 64;
#pragma unroll
    for (int g = 0; g < 4; ++g) { const float* p = cv + (size_t)(8 * (4 * half + g) + (lane >> 3)) * 512 + 8 * (lane & 7); vr[2 * g] = *(const f32x4*)p; vr[2 * g + 1] = *(const f32x4*)(p + 4); }
}
#define PIN8(x) asm volatile("" : "+v"(x[0]), "+v"(x[1]), "+v"(x[2]), "+v"(x[3]), "+v"(x[4]), "+v"(x[5]), "+v"(x[6]), "+v"(x[7]))
typedef short v4i16_t __attribute__((ext_vector_type(4)));
__device__ __forceinline__ void attn_put_v(LAS bf16_t* vR, const bf16x8 (&vv)[8], int lane) {
#pragma unroll
    for (int g = 0; g < 8; ++g) *(LAS bf16x8*)(vR + (8 * g + (lane >> 3)) * VT_PITCH + 8 * (lane & 7)) = vv[g];
}
__device__ __forceinline__ u32x2 tr_read(const LAS bf16_t* p) { return __builtin_bit_cast(u32x2, __builtin_amdgcn_ds_read_tr16_b64_v4i16((LAS v4i16_t*)p)); }
template <int NQ, bool SAMPLE, bool dry = false>
__device__ __forceinline__ void attn_unit(const Args& a, int idx, int h, int qoff, LAS bf16_t* vT, const LAS float* biasL, int lane) {
    const int fr = lane & 15, kq = lane >> 4;
    bf16_t* QA = (bf16_t*)(a.ws + A_QA);
    const int qrow0 = SAMPLE ? MP + idx * 32 : idx * 64 + qoff;
    bf16x8 bq[NQ][2];
#pragma unroll
    for (int nt = 0; nt < NQ; ++nt)
#pragma unroll
        for (int ks = 0; ks < 2; ++ks) bq[nt][ks] = *(const bf16x8*)(QA + (size_t)(qrow0 + 16 * nt + fr) * 512 + h * 64 + 32 * ks + 8 * kq);
    f32x4 o[4][NQ]; float mrun[NQ], lrun[NQ];
#pragma unroll
    for (int nt = 0; nt < NQ; ++nt) { mrun[nt] = -1e30f; lrun[nt] = 0.f;
#pragma unroll
        for (int dt = 0; dt < 4; ++dt) o[dt][nt] = (f32x4){0.f, 0.f, 0.f, 0.f}; }
    const float bias_far = biasL[256];
    int kt = SAMPLE ? 0 : (idx < 8 ? 8 - idx : 0);
    bf16x8 ka[4][2];
    if (!SAMPLE) { bf16x8 vv[8]; attn_load<SAMPLE>(a, idx, h, kt, lane, ka, vv); attn_put_v(vT, vv, lane); }
#pragma unroll 1
    for (; kt < 9; ++kt) {
        bf16x8 vvN[8]; f32x4 vr[8];
        if (SAMPLE) {
            if (kt < 8) {
#pragma unroll
                for (int hf = 0; hf < 2; ++hf) { f32x4 kr[8]; attn_load_kraw(a, idx, h, kt, hf, lane, kr); PIN8(kr);
#pragma unroll
                    for (int j = 0; j < 4; ++j) ka[2 * hf + (j >> 1)][j & 1] = pk8(kr[2 * j], kr[2 * j + 1]); } }
            else attn_load<true>(a, idx, h, 8, lane, ka, vvN);
        }
        const int nvalid = (SAMPLE && kt == 8) ? 32 : 64;
        f32x4 s[4][NQ];
#pragma unroll
        for (int mt = 0; mt < 4; ++mt)
#pragma unroll
            for (int nt = 0; nt < NQ; ++nt) { f32x4 z = (f32x4){0.f, 0.f, 0.f, 0.f}; z = MFMA16(ka[mt][0], bq[nt][0], z); s[mt][nt] = MFMA16(ka[mt][1], bq[nt][1], z); }
        if (!SAMPLE && kt < 8) attn_load<false>(a, idx, h, kt + 1, lane, ka, vvN);
        if (SAMPLE && kt < 8) attn_load_vraw(a, idx, h, kt, 0, lane, vr);
        const int dbase = 64 * (8 - kt);
#pragma unroll
        for (int mt = 0; mt < 4; ++mt)
#pragma unroll
            for (int nt = 0; nt < NQ; ++nt)
#pragma unroll
                for (int i = 0; i < 4; ++i) { const int key = 16 * mt + 4 * kq + i, q = qoff + 16 * nt + fr; float bv = bias_far;
                    if (kt >= 6) { int d = q - key + dbase; d = d < -128 ? -128 : (d > 128 ? 128 : d); bv = biasL[d + 128]; }
                    float sv = s[mt][nt][i] + bv; if (SAMPLE && key >= nvalid) sv = -1e30f; s[mt][nt][i] = sv; }
        bf16x8 pb[NQ][2];
#pragma unroll
        for (int nt = 0; nt < NQ; ++nt) {
            float mx = -1e30f;
#pragma unroll
            for (int mt = 0; mt < 4; ++mt) mx = fmaxf(mx, fmaxf(fmaxf(s[mt][nt][0], s[mt][nt][1]), fmaxf(s[mt][nt][2], s[mt][nt][3])));
            mx = fmaxf(mx, __shfl_xor(mx, 16)); mx = fmaxf(mx, __shfl_xor(mx, 32));
            const float mnew = fmaxf(mrun[nt], mx), sc = __builtin_amdgcn_exp2f(mrun[nt] - mnew); mrun[nt] = mnew; lrun[nt] *= sc;
#pragma unroll
            for (int dt = 0; dt < 4; ++dt) o[dt][nt] = o[dt][nt] * sc;
            const float mcur = mnew; float ls = 0.f;
#pragma unroll
            for (int mt = 0; mt < 4; ++mt)
#pragma unroll
                for (int i = 0; i < 4; ++i) { const float p = __builtin_amdgcn_exp2f(s[mt][nt][i] - mcur); s[mt][nt][i] = p; ls += p; }
            lrun[nt] += ls;
            pb[nt][0] = pk8(s[0][nt], s[1][nt]); pb[nt][1] = pk8(s[2][nt], s[3][nt]);
        }
        if (SAMPLE) {
            if (kt < 8) { PIN8(vr);
#pragma unroll
                for (int g = 0; g < 4; ++g) *(LAS bf16x8*)(vT + (8 * g + (lane >> 3)) * VT_PITCH + 8 * (lane & 7)) = pk8(vr[2 * g], vr[2 * g + 1]);
                attn_load_vraw(a, idx, h, kt, 1, lane, vr); PIN8(vr);
#pragma unroll
                for (int g = 0; g < 4; ++g) *(LAS bf16x8*)(vT + (8 * (4 + g) + (lane >> 3)) * VT_PITCH + 8 * (lane & 7)) = pk8(vr[2 * g], vr[2 * g + 1]); }
            else attn_put_v(vT, vvN, lane); }
        wave_lds_sync();
#pragma unroll
        for (int ks = 0; ks < 2; ++ks)
#pragma unroll
            for (int dt = 0; dt < 4; ++dt) { const LAS bf16_t* vp = vT + (32 * ks + 4 * kq + (fr >> 2)) * VT_PITCH + 16 * dt + 4 * (fr & 3);
                const bf16x8 va = mk8(tr_read(vp), tr_read(vp + 16 * VT_PITCH));
#pragma unroll
                for (int nt = 0; nt < NQ; ++nt) o[dt][nt] = MFMA16(va, pb[nt][ks], o[dt][nt]);
                if (dt & 1) asm volatile("" ::: "memory"); }
        wave_lds_sync();
        if (!SAMPLE && kt < 8) attn_put_v(vT, vvN, lane);
    }
#pragma unroll
    for (int nt = 0; nt < NQ; ++nt) { float l = lrun[nt]; l += __shfl_xor(l, 16); l += __shfl_xor(l, 32); const float inv = 1.f / l;
        bf16_t* op = QA + (size_t)(qrow0 + 16 * nt + fr) * 512 + h * 64 + 4 * kq;
#pragma unroll
        for (int dt = 0; dt < 4; ++dt) if (!dry) *(u32x2*)(op + 16 * dt) = pk4(o[dt][nt] * inv); }
}

constexpr int QE_P = 136, TT_P = 72;
constexpr int G_QE = 0, G_KE = G_QE + 64 * QE_P * 2, G_KLT = G_KE + 64 * QE_P * 2, G_VT = G_KLT + 128 * TT_P * 2, G_ATT = G_VT + 256 * TT_P * 2,
              G_PSUM = G_ATT + 64 * TT_P * 2, G_BLAST = G_PSUM + 2048, G_DVEC = G_BLAST + 512, G_RED = G_DVEC + 512, G_END = G_RED + 2048;
static_assert(G_END <= 131072, "gla lds");
template <int MODE, bool dry = false>
__device__ __forceinline__ void gla_unit(const Args& a, LAS unsigned char* lds, int idx, int h, int tid) {
    constexpr int C = (MODE == 2) ? 32 : 64, TPT = C / 4, NTL = C / 16, KS_T = C / 32;
    const int lane = tid & 63, wave = __builtin_amdgcn_readfirstlane(tid >> 6), fr = lane & 15, kq = lane >> 4;
    LAS bf16_t* qe = (LAS bf16_t*)(lds + G_QE); LAS bf16_t* ke = (LAS bf16_t*)(lds + G_KE); LAS bf16_t* klT = (LAS bf16_t*)(lds + G_KLT);
    LAS bf16_t* vT = (LAS bf16_t*)(lds + G_VT); LAS bf16_t* att = (LAS bf16_t*)(lds + G_ATT);
    LAS float* psum = (LAS float*)(lds + G_PSUM); LAS float* blast = (LAS float*)(lds + G_BLAST); LAS float* dvec = (LAS float*)(lds + G_DVEC); LAS float* red = (LAS float*)(lds + G_RED);
    const int row0 = (MODE == 2) ? MP + idx * 32 : idx * 64;
    const bf16_t* QB = (const bf16_t*)(a.ws + A_QB); const bf16_t* KB = (const bf16_t*)(a.ws + A_KB); bf16_t* VB = (bf16_t*)(a.ws + A_VB); const bf16_t* RB = (const bf16_t*)(a.ws + A_RB);
    const float* DLR = (const float*)((const unsigned char*)a.out + Y_DLR);
    bf16_t* US = (bf16_t*)((unsigned char*)a.out + Y_US) + (size_t)(idx * 4 + h) * 32768;
    bf16x8 vraw[C / 16];
    { const int t = tid & (C - 1), g0 = tid / C;
#pragma unroll
        for (int gi = 0; gi < C / 16; ++gi) vraw[gi] = *(const bf16x8*)(VB + (size_t)(row0 + t) * 1024 + h * 256 + 8 * (g0 * (C / 16) + gi)); }
    bf16x8 sraw[4][2];
    if (MODE == 1) {
#pragma unroll
        for (int ks = 0; ks < 4; ++ks)
#pragma unroll
            for (int m = 0; m < 2; ++m) sraw[ks][m] = *(const bf16x8*)(US + (size_t)(32 * wave + 16 * m + fr) * 128 + 32 * ks + 8 * kq); }
    {
        const int dk = tid & 127, tq = wave >> 1, col = h * 128 + dk;
        float wu[16];
#pragma unroll
        for (int j = 0; j < 16; ++j) wu[j] = a.in[I_WUP][j * 512 + col];
        const float bd = a.in[I_BDEC][col];
        bf16_t kraw[TPT], qraw[TPT];
#pragma unroll
        for (int i = 0; i < TPT; ++i) { const size_t gi = (size_t)(row0 + tq * TPT + i) * 512 + col; kraw[i] = KB[gi]; qraw[i] = (MODE != 0) ? QB[gi] : (bf16_t)0; }
        float bl[TPT]; float run = 0.f;
#pragma unroll
        for (int i = 0; i < TPT; ++i) { const f32x4* dp = (const f32x4*)(DLR + (size_t)(row0 + tq * TPT + i) * 16); float z = bd;
#pragma unroll
            for (int j4 = 0; j4 < 4; ++j4) { const f32x4 d = dp[j4]; z += d[0] * wu[4 * j4] + d[1] * wu[4 * j4 + 1] + d[2] * wu[4 * j4 + 2] + d[3] * wu[4 * j4 + 3]; }
            const float la = (fminf(z, 0.f) - __logf(1.f + __expf(-fabsf(z)))) * (1.f / 16.f);
            run += la; bl[i] = run; }
        psum[tq * 128 + dk] = run;
        __syncthreads();
        float off = 0.f, tot = 0.f;
#pragma unroll
        for (int p = 0; p < 4; ++p) { const float v = psum[p * 128 + dk]; tot += v; if (p < tq) off += v; }
        if (tq == 0) { dvec[dk] = __expf(tot); if (MODE == 0) ((float*)((unsigned char*)a.out + Y_DEC))[(size_t)(idx * 4 + h) * 128 + dk] = __expf(tot); }
#pragma unroll
        for (int i = 0; i < TPT; ++i) { const int t = tq * TPT + i; const float b = bl[i] + off;
            const float kv = bf2f(kraw[i]);
            if (MODE != 0) { const float qv = bf2f(qraw[i]); qe[t * QE_P + dk] = f2bf(qv * __expf(b)); ke[t * QE_P + dk] = f2bf(kv * __expf(-b)); }
            if (MODE != 1) klT[dk * TT_P + t] = f2bf(kv * __expf(tot - b)); }
    }
    {
        const int t = tid & (C - 1), g0 = tid / C;
#pragma unroll
        for (int gi = 0; gi < C / 16; ++gi) { const int g = g0 * (C / 16) + gi; const bf16x8 vv = vraw[gi];
#pragma unroll
            for (int j = 0; j < 8; ++j) vT[(8 * g + j) * TT_P + t] = (bf16_t)vv[j]; }
    }
    __syncthreads();
    if (MODE != 0) {
        for (int id = wave; id < NTL * NTL; id += 8) { const int ms = id / NTL, nt = id % NTL; f32x4 acc = (f32x4){0.f, 0.f, 0.f, 0.f};
#pragma unroll
            for (int ks = 0; ks < 4; ++ks) acc = MFMA16(*(const LAS bf16x8*)(ke + (16 * ms + fr) * QE_P + 32 * ks + 8 * kq), *(const LAS bf16x8*)(qe + (16 * nt + fr) * QE_P + 32 * ks + 8 * kq), acc);
            const int t = 16 * nt + fr;
#pragma unroll
            for (int i = 0; i < 4; ++i) if (16 * ms + 4 * kq + i > t) acc[i] = 0.f;
            *(LAS u32x2*)(att + t * TT_P + 16 * ms + 4 * kq) = pk4(acc); }
    }
    if (MODE != 1) {
        f32x4 u[8][2];
#pragma unroll
        for (int mt = 0; mt < 8; ++mt)
#pragma unroll
            for (int n = 0; n < 2; ++n) u[mt][n] = (f32x4){0.f, 0.f, 0.f, 0.f};
#pragma unroll
        for (int ks = 0; ks < KS_T; ++ks) { bf16x8 bv[2];
#pragma unroll
            for (int n = 0; n < 2; ++n) bv[n] = *(const LAS bf16x8*)(vT + (32 * wave + 16 * n + fr) * TT_P + 32 * ks + 8 * kq);
#pragma unroll
            for (int mt = 0; mt < 8; ++mt) { const bf16x8 av = *(const LAS bf16x8*)(klT + (16 * mt + fr) * TT_P + 32 * ks + 8 * kq);
#pragma unroll
                for (int n = 0; n < 2; ++n) u[mt][n] = MFMA16(av, bv[n], u[mt][n]); } }
        if (MODE == 0) {
#pragma unroll
            for (int mt = 0; mt < 8; ++mt)
#pragma unroll
                for (int n = 0; n < 2; ++n) *(u32x2*)(US + (size_t)(32 * wave + 16 * n + fr) * 128 + 16 * mt + 4 * kq) = pk4(u[mt][n]);
        } else {
            const float* S0 = a.in[I_ST] + (size_t)(idx * 4 + h) * 32768; float* S1 = a.out + O_SS + (size_t)(idx * 4 + h) * 32768;
#pragma unroll
            for (int mt = 0; mt < 8; ++mt)
#pragma unroll
                for (int n = 0; n < 2; ++n)
#pragma unroll
                    for (int i = 0; i < 4; ++i) { const int dk = 16 * mt + 4 * kq + i, dv = 32 * wave + 16 * n + fr; S1[dk * 256 + dv] = dvec[dk] * S0[dk * 256 + dv] + u[mt][n][i]; }
        }
    }
    if (MODE != 0) {
        __syncthreads();
        f32x4 o[2][NTL];
#pragma unroll
        for (int m = 0; m < 2; ++m)
#pragma unroll
            for (int nt = 0; nt < NTL; ++nt) o[m][nt] = (f32x4){0.f, 0.f, 0.f, 0.f};
#pragma unroll
        for (int ks = 0; ks < KS_T; ++ks) { bf16x8 av[2];
#pragma unroll
            for (int m = 0; m < 2; ++m) av[m] = *(const LAS bf16x8*)(vT + (32 * wave + 16 * m + fr) * TT_P + 32 * ks + 8 * kq);
#pragma unroll
            for (int nt = 0; nt < NTL; ++nt) { const bf16x8 bv = *(const LAS bf16x8*)(att + (16 * nt + fr) * TT_P + 32 * ks + 8 * kq);
#pragma unroll
                for (int m = 0; m < 2; ++m) o[m][nt] = MFMA16(av[m], bv, o[m][nt]); } }
#pragma unroll
        for (int ks = 0; ks < 4; ++ks) { bf16x8 av[2];
#pragma unroll
            for (int m = 0; m < 2; ++m) { const int dv = 32 * wave + 16 * m + fr;
                if (MODE == 1) av[m] = sraw[ks][m];
                else { const float* sp = a.in[I_ST] + (size_t)(idx * 4 + h) * 32768 + (size_t)(32 * ks + 8 * kq) * 256 + dv; f32x4 x0, x1;
#pragma unroll
                    for (int j = 0; j < 4; ++j) { x0[j] = sp[j * 256]; x1[j] = sp[(j + 4) * 256]; }
                    av[m] = pk8(x0, x1); } }
#pragma unroll
            for (int nt = 0; nt < NTL; ++nt) { const bf16x8 bv = *(const LAS bf16x8*)(qe + (16 * nt + fr) * QE_P + 32 * ks + 8 * kq);
#pragma unroll
                for (int m = 0; m < 2; ++m) o[m][nt] = MFMA16(av[m], bv, o[m][nt]); } }
#pragma unroll
        for (int nt = 0; nt < NTL; ++nt) { float ss = 0.f;
#pragma unroll
            for (int m = 0; m < 2; ++m) ss += (o[m][nt][0] * o[m][nt][0] + o[m][nt][1] * o[m][nt][1]) + (o[m][nt][2] * o[m][nt][2] + o[m][nt][3] * o[m][nt][3]);
            ss += __shfl_xor(ss, 16); ss += __shfl_xor(ss, 32);
            if (kq == 0) red[wave * 64 + 16 * nt + fr] = ss; }
        __syncthreads();
#pragma unroll
        for (int nt = 0; nt < NTL; ++nt) { const int t = 16 * nt + fr; float tot = 0.f;
#pragma unroll
            for (int w = 0; w < 8; ++w) tot += red[w * 64 + t];
            const float rstd = rsqrtf(tot * (1.f / 256.f) + EPS);
#pragma unroll
            for (int m = 0; m < 2; ++m) { const int dv = 32 * wave + 16 * m + 4 * kq; const size_t gi = (size_t)(row0 + t) * 1024 + h * 256 + dv;
                const f32x4 gn = *(const f32x4*)(a.in[I_GNORM] + dv); const f32x4 rb = up4(*(const u32x2*)(RB + gi));
                if (!dry) *(u32x2*)(VB + gi) = pk4(o[m][nt] * rstd * gn * rb); } }
    }
    __syncthreads();
}

template <bool DRYS = false>
__device__ __forceinline__ void scan_phase(const Args& a, int tid, int nthr, int blk, int nblk) {
    u32x2* US64 = (u32x2*)((unsigned char*)a.out + Y_US); const f32x4* DEC = (const f32x4*)((const unsigned char*)a.out + Y_DEC);
    const int per = (32768 + nblk - 1) / nblk;
    if (tid >= nthr) return;
    for (int q = tid; q < per; q += nthr) {
    const int p = blk * per + q; if (p >= 32768) break;
    const int hh = p >> 13, dv = (p >> 5) & 255, dq = p & 31; f32x4 st = (f32x4){0.f, 0.f, 0.f, 0.f};
    u32x2* up = US64 + (size_t)hh * 8192 + dv * 32 + dq; const f32x4* dp = DEC + hh * 32 + dq;
    for (int c0 = 0; c0 < 256; c0 += 8) { u32x2 u[8]; f32x4 d[8];
#pragma unroll
        for (int j = 0; j < 8; ++j) { u[j] = up[(size_t)(c0 + j) * 32768]; d[j] = dp[(c0 + j) * 128]; }
#pragma unroll
        for (int j = 0; j < 8; ++j) { if (!DRYS || st[0] == 123.456f) up[(size_t)(c0 + j) * 32768] = pk4(st); st = d[j] * st + up4(u[j]); } }
    float* so = a.out + O_SP + (size_t)(hh * 128 + 4 * dq) * 256 + dv;
    if (!DRYS || st[0] == 123.456f) { so[0] = st[0]; so[256] = st[1]; so[512] = st[2]; so[768] = st[3]; }
    }
}

#define XB_TMO      128
#define XB_XCNT(j)  (256  + 64 * (j))
#define XB_XSUB(j)  (1280 + 64 * (j))
#define XB_XGEN(j)  (2304 + 64 * (j))
#define XB_TOP      3328
#define XB_TOPGEN   3392
#define XCD_BAR_WORDS 3456
#define XB_SPIN_CAP (1u << 18)

__device__ __forceinline__ unsigned xb_ld(unsigned* p)              { return __hip_atomic_load(p, __ATOMIC_RELAXED, __HIP_MEMORY_SCOPE_AGENT); }
__device__ __forceinline__ unsigned xb_add(unsigned* p, unsigned v) { return __hip_atomic_fetch_add(p, v, __ATOMIC_RELAXED, __HIP_MEMORY_SCOPE_AGENT); }
__device__ __forceinline__ unsigned xb_xcc_id() { return (unsigned)__builtin_amdgcn_s_getreg((3 << 11) | 20) & 0xFu; }
#define XB_SPIN(cond, bar) do { unsigned _sp = 0; while (cond) { __builtin_amdgcn_s_sleep(1); \
    if ((++_sp & 255u) == 0u) { if (xb_ld(&(bar)[XB_TMO])) break; if (_sp > XB_SPIN_CAP) { atomicAdd(&(bar)[XB_TMO], 1u); break; } } } } while (0)

struct XcdBarrier {
    unsigned* bar; unsigned x;
    volatile LAS unsigned* st;
};

__device__ __forceinline__ XcdBarrier xcd_barrier_post(unsigned* bar, volatile LAS unsigned* st) {
    XcdBarrier b; b.bar = bar; b.x = xb_xcc_id(); b.st = st;
    if (threadIdx.x == 0) (void)xb_add(&bar[XB_XCNT(b.x)], 1u);
    return b;
}
__device__ __forceinline__ void xcd_barrier_complete(unsigned* bar, unsigned x, unsigned& nloc, unsigned& nx) {
    const unsigned G = gridDim.x * gridDim.y * gridDim.z;
    unsigned sum, cnt, mine, sp = 0u;
    for (;;) {
        sum = 0u; cnt = 0u; mine = 0u;
#pragma unroll
        for (unsigned j = 0; j < 16; ++j) { const unsigned c = xb_ld(&bar[XB_XCNT(j)]); sum += c; cnt += (c > 0u) ? 1u : 0u; mine = (j == x) ? c : mine; }
        if (sum == G) break;
        __builtin_amdgcn_s_sleep(1);
        if ((++sp & 255u) == 0u) { if (xb_ld(&bar[XB_TMO])) break; if (sp > XB_SPIN_CAP) { atomicAdd(&bar[XB_TMO], 1u); break; } }
    }
    nloc = mine > 0u ? mine : 1u; nx = cnt > 0u ? cnt : 1u;
}

__device__ __forceinline__ void xcd_barrier(const XcdBarrier& b) {
    asm volatile("s_waitcnt vmcnt(0)" ::: "memory");
    __syncthreads();
    if (threadIdx.x == 0) {
        unsigned* bar = b.bar;
        __builtin_amdgcn_s_waitcnt(0);
        unsigned nloc = b.st[0], nx = b.st[1];
        if (nloc == 0u) { xcd_barrier_complete(bar, b.x, nloc, nx); b.st[0] = nloc; b.st[1] = nx; }
        const unsigned old = xb_add(&bar[XB_XSUB(b.x)], 1u);
        const unsigned gen = old / nloc;
        if (old + 1u == (gen + 1u) * nloc) {
            __builtin_amdgcn_fence(__ATOMIC_RELEASE, "agent");
            asm volatile("s_waitcnt vmcnt(0)" ::: "memory");
            const unsigned og = xb_add(&bar[XB_TOP], 1u);
            const unsigned tg = og / nx;
            if (og + 1u == (tg + 1u) * nx) xb_add(&bar[XB_TOPGEN], 1u);
            else XB_SPIN(xb_ld(&bar[XB_TOPGEN]) == tg, bar);
            __builtin_amdgcn_fence(__ATOMIC_ACQUIRE, "agent");
            xb_add(&bar[XB_XGEN(b.x)], 1u);
            asm volatile("s_waitcnt vmcnt(0)" ::: "memory");
        } else {
            XB_SPIN(xb_ld(&bar[XB_XGEN(b.x)]) == gen, bar);
            __builtin_amdgcn_fence(__ATOMIC_ACQUIRE, "agent");
            asm volatile("s_waitcnt vmcnt(0)" ::: "memory");
        }
    }
    __syncthreads();
}


constexpr size_t WS_BAR = 36315136;
constexpr int NPH = 14;
__global__ void __launch_bounds__(512) fwd_kernel(Args a) {
    extern __shared__ __attribute__((aligned(16))) unsigned char lds_raw[];
    LAS unsigned char* lds = (LAS unsigned char*)lds_raw;
    const int tid = threadIdx.x, lane = tid & 63, wave = __builtin_amdgcn_readfirstlane(tid >> 6);
    const int G = gridDim.x, gw = blockIdx.x * 8 + wave, NGW = G * 8;
    cg::grid_group grid = cg::this_grid();
    volatile LAS unsigned* xst = (volatile LAS unsigned*)(lds + LDS_BYTES - 16);
    if (tid < 4) xst[tid] = 0u;
    __syncthreads();
    if (a.ph_lo == 0 && blockIdx.x == 0) for (int i = tid; i < XCD_BAR_WORDS; i += 512) ((unsigned*)(a.ws + WS_BAR))[i] = 0u;
#define SEAM(k) do { if ((k) == 1) { grid.sync(); (void)xcd_barrier_post((unsigned*)(a.ws + WS_BAR), xst); } else { XcdBarrier xb_; xb_.bar = (unsigned*)(a.ws + WS_BAR); xb_.x = xb_xcc_id(); xb_.st = (volatile LAS unsigned*)(lds + LDS_BYTES - 16); xcd_barrier(xb_); } } while (0)
#define PH(k) if (a.ph_lo <= (k) && (k) < a.ph_hi) { if ((k) > a.ph_lo && (k) != 6) SEAM(k);
#define PHEND }
#define GEMM_N1024(EPI, Aoff, Woff, Mrows, Kdim, rowbase, Gn, cid, ...) do { pg8::Gemm g{(const bf16_t*)(a.ws + (Aoff)) + (size_t)(rowbase) * (Kdim), (const bf16_t*)(a.ws + (Woff)), (Mrows), 1024, (Kdim)}; \
        pg8::StaticOrder S; S.init((Mrows), 1024, (Gn), (cid)); EPI E{__VA_ARGS__, (rowbase)}; pg8::gemm_phase<EPI, pg8::StaticOrder, false, true>(lds, g, S, E); } while (0)
    const int bx = (int)blockIdx.x;
    PH(0) {
        float* rss = (float*)(a.ws + WS_RSS1);
        for (int i = bx * 512 + tid; i < 2 * MT; i += G * 512) rss[i] = 0.f;
        p0_convert(a, (LAS float*)lds + wave * (64 * 65), gw, NGW, lane);
        __syncthreads();
        p0_rows(a, lds, gw, NGW, wave, lane, tid);
    } PHEND
    PH(1) {
        pg8::Gemm g{(const bf16_t*)((const unsigned char*)a.out + Y_H), (const bf16_t*)(a.ws + WS_WIN), MT, NIN, 1024}; pg8::StaticOrder S; S.init(MT, NIN, G, bx);
        EpiIn E{a.ws, a.out}; pg8::gemm_phase<EpiIn, pg8::StaticOrder, true, true>(lds, g, S, E);
    } PHEND
    PH(2) {
        LAS float* biasL = (LAS float*)(lds + 8 * 64 * VT_PITCH * 2);
        for (int i = tid; i < 8 * 257; i += 512) biasL[i] = a.in[I_RELB][i] * 1.4426950408889634f;
        __syncthreads();
        LAS bf16_t* vT = (LAS bf16_t*)lds + wave * (64 * VT_PITCH);
        for (int u = gw; u < 256; u += NGW) attn_unit<2, true>(a, u >> 3, u & 7, 0, vT, biasL + (u & 7) * 257, lane);
        __syncthreads();
        const bool few = (G == 256) && bx < 32;
        for (int u = (G != 256) ? bx : (few ? bx : 64 + bx - 32); u < (few ? 64 : 1024 + 128); u += (G != 256) ? G : (few ? 32 : 224)) {
            if (u < 1024) gla_unit<0>(a, lds, u >> 2, u & 3, tid);
            else gla_unit<2>(a, lds, (u - 1024) >> 2, u & 3, tid); }
    } PHEND
    PH(3) {
        if (bx < 16) {
            GEMM_N1024(EpiN1024<0>, A_QA, WS_WPA, MS, 512, MP, 16, bx, (bf16_t*)(a.ws + A_GA), nullptr, nullptr);
            GEMM_N1024(EpiN1024<1>, A_VB, WS_WPB, MS, 1024, MP, 16, bx, (bf16_t*)(a.ws + A_GA), (const bf16_t*)(a.ws + A_GB), nullptr);
        } else {
            LAS float* biasL = (LAS float*)(lds + 8 * 64 * VT_PITCH * 2);
            for (int i = tid; i < 8 * 257; i += 512) biasL[i] = a.in[I_RELB][i] * 1.4426950408889634f;
            __syncthreads();
            if (wave >= 3) { LAS bf16_t* vT = (LAS bf16_t*)lds + wave * (64 * VT_PITCH);
                for (int u = (bx - 16) * 5 + (wave - 3); u < 4096; u += (G - 16) * 5) attn_unit<2, false>(a, u >> 4, u & 7, ((u >> 3) & 1) * 32, vT, biasL + (u & 7) * 257, lane); }
            else scan_phase(a, tid, 192, bx - 16, G - 16);
        }
    } PHEND
    PH(4) { for (int u = bx; u < 1024; u += G) gla_unit<1>(a, lds, u >> 2, u & 3, tid); } PHEND
    PH(5) {
        GEMM_N1024(EpiN1024<0>, A_QA, WS_WPA, MP, 512, 0, G, bx, (bf16_t*)(a.ws + A_GA), nullptr, nullptr);
        GEMM_N1024(EpiN1024<1>, A_VB, WS_WPB, MP, 1024, 0, G, bx, (bf16_t*)(a.ws + A_GA), (const bf16_t*)(a.ws + A_GB), nullptr);
    } PHEND
    PH(6) { } PHEND
    PH(7) { GEMM_N1024(EpiN1024<2>, A_GA, WS_WOUT, MP, 1024, 0, G, bx, (bf16_t*)(a.ws + A_GB), nullptr, (float*)(a.ws + WS_RSS1)); } PHEND
    PH(8) {
        if (G >= 32 && bx < 16) GEMM_N1024(EpiN1024<2>, A_GA, WS_WOUT, MS, 1024, MP, 16, bx, (bf16_t*)(a.ws + A_GB), nullptr, (float*)(a.ws + WS_RSS1));
        else if (G >= 32) row_pass1(a, 0, MP, gw - 128, NGW - 128, lane);
        else { row_pass1(a, 0, MP, gw, NGW, lane); GEMM_N1024(EpiN1024<2>, A_GA, WS_WOUT, MS, 1024, MP, G, bx, (bf16_t*)(a.ws + A_GB), nullptr, (float*)(a.ws + WS_RSS1)); }
    } PHEND
    PH(9) { row_pass1(a, MP, MT, gw, NGW, lane); } PHEND
    PH(10) {
        pg8::Gemm g{(const bf16_t*)(a.ws + A_RB), (const bf16_t*)(a.ws + WS_WGU), MT, NGU, 1024}; pg8::StaticOrder S; S.init(MT, NGU, G, bx);
        EpiSwiglu E{(bf16_t*)(a.ws + A_HID)}; pg8::gemm_phase<EpiSwiglu, pg8::StaticOrder, true, true>(lds, g, S, E);
    } PHEND
    PH(11) { GEMM_N1024(EpiN1024<2>, A_HID, WS_WDN, MP, DFF, 0, G, bx, (bf16_t*)(a.ws + A_GA), nullptr, (float*)(a.ws + WS_RSS2)); } PHEND
    PH(12) {
        if (G >= 32 && bx < 16) GEMM_N1024(EpiN1024<2>, A_HID, WS_WDN, MS, DFF, MP, 16, bx, (bf16_t*)(a.ws + A_GA), nullptr, (float*)(a.ws + WS_RSS2));
        else if (G >= 32) row_pass2(a, 0, MP, gw - 128, NGW - 128, lane);
        else { row_pass2(a, 0, MP, gw, NGW, lane); GEMM_N1024(EpiN1024<2>, A_HID, WS_WDN, MS, DFF, MP, G, bx, (bf16_t*)(a.ws + A_GA), nullptr, (float*)(a.ws + WS_RSS2)); }
    } PHEND
    PH(13) { row_pass2(a, MP, MT, gw, NGW, lane); } PHEND
}

#ifndef ONE_LAUNCH
#define ONE_LAUNCH 1
#endif
extern "C" void kernel_launch(void* const* d_in, const int* in_sizes, int n_in, void* d_out, int out_size, void* d_ws, size_t ws_size, hipStream_t stream) {
    static int grid = 0;
    if (grid == 0) {
        if (n_in != 20 || ws_size < A_END || out_size != 23724032) { fprintf(stderr, "kernel_launch: unexpected sizes n_in %d ws %zu out %d\n", n_in, ws_size, out_size); }
        int dev = 0, cus = 0, per_cu = 0;
        hipGetDevice(&dev); hipDeviceGetAttribute(&cus, hipDeviceAttributeMultiprocessorCount, dev);
        hipFuncSetAttribute((const void*)fwd_kernel, hipFuncAttributeMaxDynamicSharedMemorySize, LDS_BYTES);
        hipOccupancyMaxActiveBlocksPerMultiprocessor(&per_cu, (const void*)fwd_kernel, 512, LDS_BYTES);
        if (per_cu < 1) { fprintf(stderr, "kernel_launch: occupancy query says %d blocks per CU\n", per_cu); per_cu = 1; }
        grid = cus * 1;
        (void)hipGetLastError();
    }
    Args a{};
    for (int i = 0; i < 20; ++i) a.in[i] = (const float*)d_in[i];
    a.out = (float*)d_out; a.ws = (unsigned char*)d_ws;
#if ONE_LAUNCH
    a.ph_lo = 0; a.ph_hi = NPH;
    void* args[] = {&a};
    hipError_t e = hipLaunchCooperativeKernel((const void*)fwd_kernel, dim3(grid), dim3(512), args, LDS_BYTES, stream);
    if (e != hipSuccess) fprintf(stderr, "cooperative launch failed: %s (grid %d)\n", hipGetErrorString(e), grid);
#else
    for (int ph = 0; ph < NPH; ++ph) { a.ph_lo = ph; a.ph_hi = ph + 1; hipLaunchKernelGGL(fwd_kernel, dim3(grid), dim3(512), LDS_BYTES, stream, a); }
#endif
}
```

```cpp
#include <hip/hip_runtime.h>
#include <hip/hip_cooperative_groups.h>
#include <cstdio>
namespace cg = cooperative_groups;

#define LAS __attribute__((address_space(3)))
typedef unsigned short bf16_t;
typedef short bf16x8 __attribute__((ext_vector_type(8)));
typedef float f32x4 __attribute__((ext_vector_type(4)));
typedef float f32x2 __attribute__((ext_vector_type(2)));
typedef unsigned u32x4 __attribute__((ext_vector_type(4)));
typedef unsigned u32x2 __attribute__((ext_vector_type(2)));

constexpr int MP = 16384, MS = 1024, MT = MP + MS, DM = 1024, DIN = 6672, NIN = 6656, DFF = 2816, NGU = 2 * DFF;
constexpr float EPS = 1e-6f;
constexpr size_t O_Y = 0, O_KP = 17825792, O_VP = 18087936, O_SP = 18350080, O_KS = 18481152, O_VS = 19005440, O_SS = 19529728;
constexpr size_t WS_WIN = 0, WS_WPA = 13631488, WS_WPB = 14680064, WS_WOUT = 16777216, WS_WGU = 18874368, WS_WDN = 30408704, WS_RSS1 = 36175872, WS_RSS2 = WS_RSS1 + 69632;
constexpr size_t WS_ACT = 36700160;
constexpr size_t A_QA = WS_ACT, A_KA = A_QA + 17825792, A_VA = A_KA + 17825792, A_QB = A_VA + 17825792, A_KB = A_QB + 17825792, A_VB = A_KB + 17825792,
                 A_RB = A_VB + 35651584, A_GA = A_RB + 35651584, A_GB = A_GA + 35651584, A_END = A_GB + 35651584, A_HID = A_QA;
static_assert(A_END == 268435456, "ws map");
constexpr size_t Y_H = 0, Y_US = 0, Y_DLR = 67108864, Y_DEC = Y_DLR + 1114112;
static_assert(Y_DEC + 524288 <= 71303168, "y scratch");

typedef __bf16 bf16x2_t __attribute__((ext_vector_type(2)));
__device__ __forceinline__ unsigned cvt_pk_bf16(float lo, float hi) { f32x2 v = {lo, hi}; bf16x2_t b = __builtin_convertvector(v, bf16x2_t); return __builtin_bit_cast(unsigned, b); }
__device__ __forceinline__ float bf_lo(unsigned u) { return __uint_as_float(u << 16); }
__device__ __forceinline__ float bf_hi(unsigned u) { return __uint_as_float(u & 0xffff0000u); }
__device__ __forceinline__ float bf2f(bf16_t b) { return __uint_as_float(((unsigned)b) << 16); }
__device__ __forceinline__ bf16_t f2bf(float f) { return (bf16_t)(cvt_pk_bf16(f, 0.f) & 0xffffu); }
__device__ __forceinline__ float wave_sum(float v) { for (int o = 32; o >= 1; o >>= 1) v += __shfl_xor(v, o); return v; }
__device__ __forceinline__ void wave_lds_sync() { asm volatile("s_waitcnt lgkmcnt(0)" ::: "memory"); __builtin_amdgcn_wave_barrier(); }
__device__ __forceinline__ float fast_sigmoid(float x) { return __builtin_amdgcn_rcpf(1.0f + __expf(-x)); }
__device__ __forceinline__ bf16x8 mk8(u32x2 a, u32x2 b) { u32x4 w; w.x = a.x; w.y = a.y; w.z = b.x; w.w = b.y; return __builtin_bit_cast(bf16x8, w); }
__device__ __forceinline__ bf16x8 pk8(f32x4 a, f32x4 b) { u32x4 w; w.x = cvt_pk_bf16(a[0], a[1]); w.y = cvt_pk_bf16(a[2], a[3]); w.z = cvt_pk_bf16(b[0], b[1]); w.w = cvt_pk_bf16(b[2], b[3]); return __builtin_bit_cast(bf16x8, w); }
#define MFMA16(a, b, c) __builtin_amdgcn_mfma_f32_16x16x32_bf16((a), (b), (c), 0, 0, 0)

namespace pg8 {
#define PG8_LAS __attribute__((address_space(3)))
constexpr int BM = 256, BK = 64, HALF = 128, HTB = HALF * BK * 2, STAGE_BYTES = 8 * HTB, NXCD = 8, WGM = 8;
__host__ __device__ __forceinline__ int lds_byte(int r, int c) { const int st = (r >> 4) * 2 + (c >> 5), rr = r & 15, cc = c & 31, ob = rr * 64 + cc * 2; return st * 1024 + (ob ^ (((ob >> 9) & 1) << 5)); }
__host__ __device__ __forceinline__ void stage_rc(int b, int& R, int& C) { const int st = b / 1024, sb = b % 1024, swz = sb ^ (((sb >> 9) & 1) << 5); R = (st >> 1) * 16 + swz / 64; C = (st & 1) * 32 + (swz % 64) / 2; }
__host__ __device__ __forceinline__ int perm32(int rho) { const int n = rho >> 4, i = rho & 15; return 8 * (i >> 2) + 4 * n + (i & 3); }
struct Unit { int pm, pn; };
struct Gemm { const bf16_t* A; const bf16_t* Bt; int M, N, K; };
struct StaticOrder {
    int nM, nN, nwg, G, c;
    __host__ __device__ void init(int M, int N, int G_, int c_) { nM = M / BM; nN = N / BM; nwg = nM * nN; G = G_; c = c_; }
    __host__ __device__ bool next(int i, Unit& u) const {
        const long L = (long)i * G + c; if (L >= nwg) return false;
        int wgid = (int)L; { const int q = nwg / NXCD, r = nwg % NXCD, xcd = wgid % NXCD, off = wgid / NXCD; wgid = (xcd < r ? xcd * (q + 1) : r * (q + 1) + (xcd - r) * q) + off; }
        const int nig = WGM * nN, gid = wgid / nig, fm = gid * WGM, gsz = (nM - fm) < WGM ? (nM - fm) : WGM;
        u.pm = fm + ((wgid % nig) % gsz); u.pn = (wgid % nig) / gsz; return true;
    }
    __device__ __forceinline__ void a_ready(const Unit&) const {}
    __device__ __forceinline__ void done(const Unit&) const {}
};
template <class Epi, class Sched, bool ALIGN_EPI = false, bool SP2 = false>
__device__ __forceinline__ void gemm_phase(PG8_LAS unsigned char* lds, const Gemm g, const Sched& S, const Epi& E) {
    const int tid = threadIdx.x, wid = __builtin_amdgcn_readfirstlane(tid >> 6), lane = tid & 63, wr = wid >> 2, wc = wid & 3, fr = lane & 15, fq = lane >> 4;
    const int K = g.K, nt = K / BK;
    unsigned voffA[2], voffB[2];
#pragma unroll
    for (int i = 0; i < 2; ++i) { int R, C; stage_rc(tid * 16 + i * 8192, R, C); const int Rb = Epi::PERM ? ((R & ~31) + perm32(R & 31)) : R;
        voffA[i] = (unsigned)(R * K + C) * 2u; voffB[i] = (unsigned)(Rb * K + C) * 2u; }
    const size_t kstep = (size_t)(BK * 2);
    const size_t hstep = (size_t)HALF * K * 2;
    const size_t tstep = 2 * hstep;
    const unsigned ldsw = (unsigned)wid * 1024u;
    const int aoff = lds_byte(wr * 64 + fr, fq * 8), boff = lds_byte(wc * 32 + fr, fq * 8);
#define PG8_SA(b, h) (((b) * 2 + (h)) * HTB)
#define PG8_SB(b, h) ((4 + (b) * 2 + (h)) * HTB)
#define PG8_STAGE(bufoff, gbase, voff) do { _Pragma("unroll") for (int _i = 0; _i < 2; ++_i) \
        __builtin_amdgcn_global_load_lds((const unsigned*)((const char*)(gbase) + (voff)[_i]), (PG8_LAS unsigned*)(lds + (bufoff) + ldsw + _i * 8192), 16, 0, 0); } while (0)
#define PG8_LDA(dst, b, h) do { _Pragma("unroll") for (int m = 0; m < 4; ++m) _Pragma("unroll") for (int k = 0; k < 2; ++k) dst[m][k] = *(const PG8_LAS bf16x8*)(lds + PG8_SA(b, h) + aoff + m * 2048 + k * 1024); } while (0)
#define PG8_LDB(dst, b, h) do { _Pragma("unroll") for (int n = 0; n < 2; ++n) _Pragma("unroll") for (int k = 0; k < 2; ++k) dst[n][k] = *(const PG8_LAS bf16x8*)(lds + PG8_SB(b, h) + boff + n * 2048 + k * 1024); } while (0)
#define PG8_MMA(ai, bj, At, Bt) do { __builtin_amdgcn_s_setprio(1); _Pragma("unroll") for (int m = 0; m < 4; ++m) _Pragma("unroll") for (int n = 0; n < 2; ++n) _Pragma("unroll") for (int k = 0; k < 2; ++k) \
        acc[ai][bj][m][n] = __builtin_amdgcn_mfma_f32_16x16x32_bf16(Bt[n][k], At[m][k], acc[ai][bj][m][n], 0, 0, 0); __builtin_amdgcn_s_setprio(0); } while (0)
#define PG8_WAIT_V(n) asm volatile("s_waitcnt vmcnt(" #n ")" ::: "memory")
#define PG8_WAIT_L(n) asm volatile("s_waitcnt lgkmcnt(" #n ")" ::: "memory")
#define PG8_BAR __builtin_amdgcn_s_barrier()
#define PG8_SCHED __builtin_amdgcn_sched_barrier(0)
    Unit cur, nxt; int ui = 0;
    if (!S.next(0, cur)) return;
    f32x4 acc[2][2][4][2];
#pragma unroll
    for (int a = 0; a < 2; ++a)
#pragma unroll
        for (int b = 0; b < 2; ++b)
#pragma unroll
            for (int m = 0; m < 4; ++m)
#pragma unroll
                for (int n = 0; n < 2; ++n) acc[a][b][m][n] = (f32x4){0.f, 0.f, 0.f, 0.f};
    bf16x8 At[4][2], B0[2][2], B1[2][2];
    const char* cA = (const char*)g.A + (size_t)cur.pm * tstep; const char* cB = (const char*)g.Bt + (size_t)cur.pn * tstep;
    S.a_ready(cur);
    if constexpr (SP2) {
        PG8_STAGE(PG8_SB(0, 0), cB, voffB); PG8_STAGE(PG8_SB(0, 1), cB + hstep, voffB); PG8_STAGE(PG8_SA(0, 0), cA, voffA); PG8_STAGE(PG8_SA(0, 1), cA + hstep, voffA);
        if (wr == 1) PG8_BAR;
        PG8_WAIT_V(2); PG8_BAR;
        PG8_STAGE(PG8_SB(1, 0), cB + kstep, voffB); PG8_STAGE(PG8_SA(1, 0), cA + kstep, voffA); PG8_STAGE(PG8_SB(1, 1), cB + hstep + kstep, voffB);
        PG8_WAIT_V(6); PG8_BAR;
    } else {
        PG8_STAGE(PG8_SB(0, 0), cB, voffB); PG8_STAGE(PG8_SA(0, 0), cA, voffA); PG8_STAGE(PG8_SB(0, 1), cB + hstep, voffB); PG8_STAGE(PG8_SA(0, 1), cA + hstep, voffA);
        if (wr == 1) PG8_BAR;
        PG8_WAIT_V(4); PG8_BAR;
        PG8_STAGE(PG8_SB(1, 0), cB + kstep, voffB); PG8_STAGE(PG8_SA(1, 0), cA + kstep, voffA); PG8_STAGE(PG8_SB(1, 1), cB + hstep + kstep, voffB);
        PG8_WAIT_V(6); PG8_BAR;
    }
    for (;;) {
        const bool has_next = S.next(ui + 1, nxt);
        const char* nA = has_next ? (const char*)g.A + (size_t)nxt.pm * tstep : cA; const char* nB = has_next ? (const char*)g.Bt + (size_t)nxt.pn * tstep : cB;
        for (int t = 0; t < nt; t += 2) {
            const bool last = (t == nt - 2);
            const char* a1 = cA + (size_t)(t + 1) * kstep;
            const char* a2 = last ? nA : cA + (size_t)(t + 2) * kstep; const char* b2 = last ? nB : cB + (size_t)(t + 2) * kstep;
            const char* a3 = a2 + kstep; const char* b3 = b2 + kstep;
            if (last && has_next) S.a_ready(nxt);
            if constexpr (SP2) {
            PG8_LDB(B0, 0, 0); PG8_LDB(B1, 0, 1); PG8_SCHED; PG8_LDA(At, 0, 0); PG8_STAGE(PG8_SA(1, 1), a1 + hstep, voffA);
            PG8_WAIT_V(8); PG8_WAIT_L(0); PG8_BAR; PG8_MMA(0, 0, At, B0); PG8_MMA(0, 1, At, B1); PG8_BAR; PG8_SCHED;
            PG8_LDA(At, 0, 1); PG8_STAGE(PG8_SB(0, 0), b2, voffB); PG8_STAGE(PG8_SB(0, 1), b2 + hstep, voffB); PG8_STAGE(PG8_SA(0, 0), a2, voffA);
            PG8_WAIT_V(8); PG8_WAIT_L(0); PG8_BAR; PG8_MMA(1, 0, At, B0); PG8_MMA(1, 1, At, B1); PG8_BAR; PG8_SCHED;
            PG8_LDB(B0, 1, 0); PG8_LDB(B1, 1, 1); PG8_SCHED; PG8_LDA(At, 1, 0); PG8_STAGE(PG8_SA(0, 1), a2 + hstep, voffA);
            PG8_WAIT_V(8); PG8_WAIT_L(0); PG8_BAR; PG8_MMA(0, 0, At, B0); PG8_MMA(0, 1, At, B1); PG8_BAR; PG8_SCHED;
            PG8_LDA(At, 1, 1); PG8_STAGE(PG8_SB(1, 0), b3, voffB); PG8_STAGE(PG8_SB(1, 1), b3 + hstep, voffB); PG8_STAGE(PG8_SA(1, 0), a3, voffA);
            PG8_WAIT_V(8); PG8_WAIT_L(0); PG8_BAR; PG8_MMA(1, 0, At, B0); PG8_MMA(1, 1, At, B1); PG8_BAR; PG8_SCHED;
            } else {
            PG8_LDB(B0, 0, 0); PG8_SCHED; PG8_LDA(At, 0, 0); PG8_STAGE(PG8_SA(1, 1), a1 + hstep, voffA);
            PG8_WAIT_L(8); PG8_BAR; PG8_WAIT_L(0); PG8_MMA(0, 0, At, B0); PG8_BAR; PG8_SCHED;
            PG8_LDB(B1, 0, 1); PG8_STAGE(PG8_SB(0, 0), b2, voffB);
            PG8_BAR; PG8_WAIT_L(0); PG8_MMA(0, 1, At, B1); PG8_BAR;
            PG8_LDA(At, 0, 1); PG8_STAGE(PG8_SA(0, 0), a2, voffA);
            PG8_BAR; PG8_WAIT_L(0); PG8_MMA(1, 0, At, B0); PG8_BAR; PG8_SCHED;
            PG8_STAGE(PG8_SB(0, 1), b2 + hstep, voffB);
            PG8_WAIT_V(6); PG8_BAR; PG8_MMA(1, 1, At, B1); PG8_BAR;
            PG8_LDB(B0, 1, 0); PG8_SCHED; PG8_LDA(At, 1, 0); PG8_STAGE(PG8_SA(0, 1), a2 + hstep, voffA);
            PG8_WAIT_L(8); PG8_BAR; PG8_WAIT_L(0); PG8_MMA(0, 0, At, B0); PG8_BAR; PG8_SCHED;
            PG8_LDB(B1, 1, 1); PG8_STAGE(PG8_SB(1, 0), b3, voffB);
            PG8_BAR; PG8_WAIT_L(0); PG8_MMA(0, 1, At, B1); PG8_BAR;
            PG8_LDA(At, 1, 1); PG8_STAGE(PG8_SA(1, 0), a3, voffA);
            PG8_BAR; PG8_WAIT_L(0); PG8_MMA(1, 0, At, B0); PG8_BAR; PG8_SCHED;
            PG8_STAGE(PG8_SB(1, 1), b3 + hstep, voffB);
            PG8_WAIT_V(6); PG8_BAR; PG8_MMA(1, 1, At, B1); PG8_BAR;
            }
        }
        if constexpr (ALIGN_EPI) { if (wr == 0) PG8_BAR; }
        if constexpr (!Epi::AFTER_DRAIN) { E(acc, cur, wr, wc, fr, fq); S.done(cur); }
        if (!has_next) break;
#pragma unroll
        for (int a = 0; a < 2; ++a)
#pragma unroll
            for (int b = 0; b < 2; ++b)
#pragma unroll
                for (int m = 0; m < 4; ++m)
#pragma unroll
                    for (int n = 0; n < 2; ++n) acc[a][b][m][n] = (f32x4){0.f, 0.f, 0.f, 0.f};
        cur = nxt; cA = nA; cB = nB; ++ui;
        if constexpr (ALIGN_EPI) { if (wr == 1) PG8_BAR; }
    }
    PG8_WAIT_V(0);
    if constexpr (!ALIGN_EPI) { if (wr == 0) PG8_BAR; }
    PG8_BAR;
    if constexpr (Epi::AFTER_DRAIN) { E.fused(acc, cur, wr, wc, fr, fq, lds, wid, lane); S.done(cur); }
#undef PG8_SA
#undef PG8_SB
#undef PG8_STAGE
#undef PG8_LDA
#undef PG8_LDB
#undef PG8_MMA
#undef PG8_WAIT_V
#undef PG8_WAIT_L
#undef PG8_BAR
#undef PG8_SCHED
}
}

typedef f32x4 AccT[2][2][4][2];
__device__ __forceinline__ u32x2 pk4(f32x4 v) { u32x2 w; w.x = cvt_pk_bf16(v[0], v[1]); w.y = cvt_pk_bf16(v[2], v[3]); return w; }
__device__ __forceinline__ f32x4 up4(u32x2 w) { return (f32x4){bf_lo(w.x), bf_hi(w.x), bf_lo(w.y), bf_hi(w.y)}; }

struct EpiIn {
    static constexpr bool PERM = true, AFTER_DRAIN = false;
    unsigned char* ws; float* out;
    __device__ __forceinline__ void operator()(const AccT& acc, const pg8::Unit& u, int wr, int wc, int fr, int fq) const {
        const int pn = u.pn; size_t off; int ldc = 512, cb, mode = 0, kv = 0; float scale = 1.f;
        if (pn < 2) { off = A_QA; cb = pn; mode = 1; scale = 0.125f * 1.4426950408889634f; }
        else if (pn < 4) { off = A_KA; cb = pn - 2; kv = 1; }
        else if (pn < 6) { off = A_VA; cb = pn - 4; kv = 2; }
        else if (pn < 8) { off = A_QB; cb = pn - 6; mode = 1; scale = 0.08838834764831845f; }
        else if (pn < 10) { off = A_KB; cb = pn - 8; }
        else if (pn < 14) { off = A_VB; cb = pn - 10; ldc = 1024; }
        else if (pn < 18) { off = A_RB; cb = pn - 14; ldc = 1024; mode = 2; }
        else if (pn < 22) { off = A_GA; cb = pn - 18; ldc = 1024; mode = 3; }
        else { off = A_GB; cb = pn - 22; ldc = 1024; mode = 3; }
        bf16_t* dst = (bf16_t*)(ws + off);
        const int col0 = cb * 256 + wc * 32 + 8 * fq, row0 = u.pm * 256 + wr * 64 + fr;
        const bool f32out = (kv != 0) && (u.pm >= 62);
        float* ob = nullptr;
        if (f32out) ob = (u.pm < 64) ? out + (kv == 1 ? O_KP : O_VP) - (size_t)15872 * 512 : out + (kv == 1 ? O_KS : O_VS) - (size_t)16384 * 512;
#pragma unroll
        for (int ai = 0; ai < 2; ++ai)
#pragma unroll
            for (int m = 0; m < 4; ++m) { const int row = row0 + ai * 128 + m * 16;
#pragma unroll
                for (int bj = 0; bj < 2; ++bj) { f32x4 v0 = acc[ai][bj][m][0], v1 = acc[ai][bj][m][1]; const int col = col0 + bj * 128;
                    if (f32out) { float* o = ob + (size_t)row * 512 + col; *(f32x4*)o = v0; *(f32x4*)(o + 4) = v1; }
                    if (mode == 1) { v0 = v0 * scale; v1 = v1 * scale; }
                    else if (mode == 2) { for (int j = 0; j < 4; ++j) { v0[j] = v0[j] * fast_sigmoid(v0[j]); v1[j] = v1[j] * fast_sigmoid(v1[j]); } }
                    else if (mode == 3) { for (int j = 0; j < 4; ++j) { v0[j] = fast_sigmoid(v0[j]); v1[j] = fast_sigmoid(v1[j]); } }
                    *(bf16x8*)(dst + (size_t)row * ldc + col) = pk8(v0, v1); }
                asm volatile("" ::: "memory"); }
    }
};
template <int MODE, bool DRYE = false> struct EpiN1024 {
    static constexpr bool PERM = false, AFTER_DRAIN = false;
    bf16_t* io; const bf16_t* g2; float* rowss; int row_base;
    __device__ __forceinline__ void operator()(const AccT& acc, const pg8::Unit& u, int wr, int wc, int fr, int fq) const {
        const int col0 = u.pn * 256 + wc * 32 + 4 * fq, row0 = row_base + u.pm * 256 + wr * 64 + fr;
#pragma unroll
        for (int ai = 0; ai < 2; ++ai)
#pragma unroll
            for (int m = 0; m < 4; ++m) { const int row = row0 + ai * 128 + m * 16; float ss = 0.f;
#pragma unroll
                for (int bj = 0; bj < 2; ++bj)
#pragma unroll
                    for (int n = 0; n < 2; ++n) { f32x4 v = acc[ai][bj][m][n]; const size_t idx = (size_t)row * 1024 + col0 + bj * 128 + n * 16;
                        if (MODE == 0) v = v * up4(*(const u32x2*)(io + idx));
                        else if (MODE == 1) v = up4(*(const u32x2*)(io + idx)) + up4(*(const u32x2*)(g2 + idx)) * v;
                        else ss += (v[0] * v[0] + v[1] * v[1]) + (v[2] * v[2] + v[3] * v[3]);
                        if (!DRYE || v[0] == 123.456f) *(u32x2*)(io + idx) = pk4(v); }
                if (MODE == 2 && !DRYE) { ss += __shfl_xor(ss, 16); ss += __shfl_xor(ss, 32); if (fq == 0) atomicAdd(rowss + row, ss); } }
    }
};
template <int MODE> using EpiN1024D = EpiN1024<MODE, true>;
struct EpiSwiglu {
    static constexpr bool PERM = true, AFTER_DRAIN = false;
    bf16_t* hid;
    __device__ __forceinline__ void operator()(const AccT& acc, const pg8::Unit& u, int wr, int wc, int fr, int fq) const {
        const int col0 = u.pn * 128 + wc * 32 + 8 * fq, row0 = u.pm * 256 + wr * 64 + fr;
#pragma unroll
        for (int ai = 0; ai < 2; ++ai)
#pragma unroll
            for (int m = 0; m < 4; ++m) { const int row = row0 + ai * 128 + m * 16; f32x4 v0, v1;
#pragma unroll
                for (int j = 0; j < 4; ++j) { const float g0 = acc[ai][0][m][0][j], g1 = acc[ai][0][m][1][j];
                    v0[j] = g0 * fast_sigmoid(g0) * acc[ai][1][m][0][j]; v1[j] = g1 * fast_sigmoid(g1) * acc[ai][1][m][1][j]; }
                *(bf16x8*)(hid + (size_t)row * DFF + col0) = pk8(v0, v1); }
    }
};

struct Args { const float* in[20]; float* out; unsigned char* ws; int ph_lo, ph_hi; };
enum { I_XP = 0, I_XS, I_CK, I_CV, I_ST, I_NMPRE, I_NMPOST, I_NFPRE, I_NFPOST, I_WIN, I_WUP, I_BDEC, I_RELB, I_GNORM, I_WPA, I_WPB, I_WOUT, I_WG, I_WU, I_WD };
constexpr int LDS_BYTES = 147456;

__device__ __forceinline__ void p0_convert(const Args& a, LAS float* scr, int gw, int NGW, int lane) {
    constexpr int I_IN = 104 * 16, I_PA = 16 * 8, I_PB = 16 * 16, I_OUT = 16 * 16, I_GU = 88 * 16, I_DN = 16 * 44, TOTAL = I_IN + I_PA + I_PB + I_OUT + I_GU + I_DN;
    for (int it = gw; it < TOTAL; it += NGW) {
        int r = it, kind, K; size_t dsto;
        if (r < I_IN) { kind = 0; K = 1024; dsto = WS_WIN; }
        else if ((r -= I_IN) < I_PA) { kind = 1; K = 512; dsto = WS_WPA; }
        else if ((r -= I_PA) < I_PB) { kind = 2; K = 1024; dsto = WS_WPB; }
        else if ((r -= I_PB) < I_OUT) { kind = 3; K = 1024; dsto = WS_WOUT; }
        else if ((r -= I_OUT) < I_GU) { kind = 4; K = 1024; dsto = WS_WGU; }
        else { r -= I_GU; kind = 5; K = 2816; dsto = WS_WDN; }
        const int ktiles = K >> 6, n0 = (r / ktiles) * 64, k0 = (r % ktiles) * 64, n = n0 + lane;
        const float* sp; int srcN;
        if (kind == 0) { sp = a.in[I_WIN] + (n < 4608 ? n : n + 16); srcN = DIN; }
        else if (kind == 1) { sp = a.in[I_WPA] + n; srcN = 1024; }
        else if (kind == 2) { sp = a.in[I_WPB] + n; srcN = 1024; }
        else if (kind == 3) { sp = a.in[I_WOUT] + n; srcN = 1024; }
        else if (kind == 4) { const int pn = n >> 8, rr = n & 255; sp = ((rr < 128) ? a.in[I_WG] : a.in[I_WU]) + 128 * pn + (rr & 127); srcN = DFF; }
        else { sp = a.in[I_WD] + n; srcN = 1024; }
        sp += (size_t)k0 * srcN;
        float tmp[64];
#pragma unroll
        for (int i = 0; i < 64; ++i) tmp[i] = sp[(size_t)i * srcN];
#pragma unroll
        for (int i = 0; i < 64; ++i) scr[lane * 65 + i] = tmp[i];
        wave_lds_sync();
        unsigned* dst = (unsigned*)(a.ws + dsto) + ((size_t)n0 * K + k0) / 2 + (lane & 31);
#pragma unroll 8
        for (int j = 0; j < 32; ++j) { const int row = 2 * j + (lane >> 5), kk = (lane & 31) * 2; dst[(size_t)row * (K / 2)] = cvt_pk_bf16(scr[row * 65 + kk], scr[row * 65 + kk + 1]); }
        wave_lds_sync();
    }
}
__device__ __forceinline__ const float* xrow_ptr(const Args& a, int row) { return row < MP ? a.in[I_XP] + (size_t)row * DM : a.in[I_XS] + (size_t)(row - MP) * DM; }
__device__ __forceinline__ void p0_rows(const Args& a, LAS unsigned char* lds, int gw, int NGW, int wave, int lane, int tid) {
    LAS float* WdL = (LAS float*)lds;
    LAS float* hrow = (LAS float*)(lds + 4 * 4112 * 4) + wave * 1056;
    for (int idx = tid; idx < 1024 * 16; idx += 512) { const int k = idx >> 4, j = idx & 15; WdL[(k >> 8) * 4112 + (k & 255) * 16 + j] = a.in[I_WIN][(size_t)k * DIN + 4608 + j]; }
    __syncthreads();
    bf16_t* H = (bf16_t*)((unsigned char*)a.out + Y_H); float* DLR = (float*)((unsigned char*)a.out + Y_DLR);
    const f32x4* gp = (const f32x4*)a.in[I_NMPRE] + lane; f32x4 g[4];
#pragma unroll
    for (int j = 0; j < 4; ++j) g[j] = gp[64 * j];
    for (int row = gw; row < MT; row += NGW) {
        const f32x4* xr = (const f32x4*)xrow_ptr(a, row) + lane; f32x4 v[4]; float s = 0.f;
#pragma unroll
        for (int j = 0; j < 4; ++j) { v[j] = xr[64 * j]; s += (v[j][0] * v[j][0] + v[j][1] * v[j][1]) + (v[j][2] * v[j][2] + v[j][3] * v[j][3]); }
        const float rstd = rsqrtf(wave_sum(s) * (1.f / DM) + EPS);
        u32x2* ho = (u32x2*)(H + (size_t)row * DM) + lane;
#pragma unroll
        for (int j = 0; j < 4; ++j) { v[j] = v[j] * rstd * g[j]; ho[64 * j] = pk4(v[j]); *(LAS f32x4*)(hrow + j * 264 + 4 * lane) = v[j]; }
        wave_lds_sync();
        const int jj = lane & 15, p = lane >> 4; float acc = 0.f;
        const LAS float* hp = hrow + p * 264; const LAS float* wp = WdL + p * 4112 + jj;
#pragma unroll 8
        for (int kk = 0; kk < 256; ++kk) acc += hp[kk] * wp[kk * 16];
        acc += __shfl_xor(acc, 16); acc += __shfl_xor(acc, 32);
        if (lane < 16) DLR[(size_t)row * 16 + jj] = acc;
        wave_lds_sync();
    }
}

__device__ __forceinline__ void row_pass1(const Args& a, int row_lo, int row_hi, int gw, int NGW, int lane) {
    const bf16_t* Y = (const bf16_t*)(a.ws + A_GB); bf16_t* A2 = (bf16_t*)(a.ws + A_RB); const float* rss = (const float*)(a.ws + WS_RSS1); float* XO = a.out + O_Y;
    f32x4 gp[4], gq[4];
#pragma unroll
    for (int j = 0; j < 4; ++j) { gp[j] = ((const f32x4*)a.in[I_NMPOST])[lane + 64 * j]; gq[j] = ((const f32x4*)a.in[I_NFPRE])[lane + 64 * j]; }
    for (int r0 = row_lo + 2 * gw; r0 < row_hi; r0 += 2 * NGW) {
        f32x4 xv[2][4]; u32x2 yv[2][4]; float rs[2];
#pragma unroll
        for (int r = 0; r < 2; ++r) { const int row = (r0 + r < row_hi) ? r0 + r : r0; rs[r] = rss[row];
            const f32x4* xr = (const f32x4*)xrow_ptr(a, row) + lane; const u32x2* yr = (const u32x2*)(Y + (size_t)row * DM) + lane;
#pragma unroll
            for (int j = 0; j < 4; ++j) { xv[r][j] = xr[64 * j]; yv[r][j] = yr[64 * j]; } }
#pragma unroll
        for (int r = 0; r < 2; ++r) { const int row = r0 + r; if (row >= row_hi) break;
            const float rstd = rsqrtf(rs[r] * (1.f / DM) + EPS); f32x4 v[4]; float s = 0.f;
#pragma unroll
            for (int j = 0; j < 4; ++j) { v[j] = xv[r][j] + up4(yv[r][j]) * rstd * gp[j]; s += (v[j][0] * v[j][0] + v[j][1] * v[j][1]) + (v[j][2] * v[j][2] + v[j][3] * v[j][3]); }
            const float rstd2 = rsqrtf(wave_sum(s) * (1.f / DM) + EPS);
            f32x4* xo = (f32x4*)(XO + (size_t)row * DM) + lane; u32x2* ao = (u32x2*)(A2 + (size_t)row * DM) + lane;
#pragma unroll
            for (int j = 0; j < 4; ++j) { xo[64 * j] = v[j]; ao[64 * j] = pk4(v[j] * rstd2 * gq[j]); } }
    }
}
template <bool DRYR = false>
__device__ __forceinline__ void row_pass2(const Args& a, int row_lo, int row_hi, int gw, int NGW, int lane) {
    const bf16_t* F = (const bf16_t*)(a.ws + A_GA); const float* rss = (const float*)(a.ws + WS_RSS2); float* XO = a.out + O_Y;
    f32x4 gp[4];
#pragma unroll
    for (int j = 0; j < 4; ++j) gp[j] = ((const f32x4*)a.in[I_NFPOST])[lane + 64 * j];
    for (int r0 = row_lo + 2 * gw; r0 < row_hi; r0 += 2 * NGW) {
        f32x4 xv[2][4]; u32x2 fv[2][4]; float rs[2];
#pragma unroll
        for (int r = 0; r < 2; ++r) { const int row = (r0 + r < row_hi) ? r0 + r : r0; rs[r] = rss[row];
            const f32x4* xo = (const f32x4*)(XO + (size_t)row * DM) + lane; const u32x2* fr = (const u32x2*)(F + (size_t)row * DM) + lane;
#pragma unroll
            for (int j = 0; j < 4; ++j) { xv[r][j] = xo[64 * j]; fv[r][j] = fr[64 * j]; } }
#pragma unroll
        for (int r = 0; r < 2; ++r) { const int row = r0 + r; if (row >= row_hi) break;
            const float rstd = rsqrtf(rs[r] * (1.f / DM) + EPS); f32x4* xo = (f32x4*)(XO + (size_t)row * DM) + lane;
#pragma unroll
            for (int j = 0; j < 4; ++j) { const f32x4 o = xv[r][j] + up4(fv[r][j]) * rstd * gp[j]; if (!DRYR || o[0] == 123.456f) xo[64 * j] = o; } }
    }
}

constexpr int VT_PITCH = 72;
__device__ __forceinline__ bf16x8 ld8_f32(const float* p) { const f32x4 a = *(const f32x4*)p, b = *(const f32x4*)(p + 4); return pk8(a, b); }
template <bool SAMPLE>
__device__ __forceinline__ void attn_load(const Args& a, int idx, int h, int kt, int lane, bf16x8 (&ka)[4][2], bf16x8 (&vv)[8]) {
    const int fr = lane & 15, kq = lane >> 4;
    if (SAMPLE && kt < 8) {
        const size_t base = ((size_t)(idx * 512 + 64 * kt)) * 512 + h * 64; const float* ck = a.in[I_CK] + base; const float* cv = a.in[I_CV] + base;
#pragma unroll
        for (int mt = 0; mt < 4; ++mt)
#pragma unroll
            for (int ks = 0; ks < 2; ++ks) ka[mt][ks] = ld8_f32(ck + (size_t)(16 * mt + fr) * 512 + 32 * ks + 8 * kq);
#pragma unroll
        for (int g = 0; g < 8; ++g) vv[g] = ld8_f32(cv + (size_t)(8 * g + (lane >> 3)) * 512 + 8 * (lane & 7));
    } else {
        const bf16_t* KA = (const bf16_t*)(a.ws + A_KA); const bf16_t* VA = (const bf16_t*)(a.ws + A_VA);
        const int krow0 = SAMPLE ? MP + idx * 32 : (idx - 8 + kt) * 64, nvalid = SAMPLE ? 32 : 64;
#pragma unroll
        for (int mt = 0; mt < 4; ++mt) { int key = 16 * mt + fr; if (key >= nvalid) key = nvalid - 1;
#pragma unroll
            for (int ks = 0; ks < 2; ++ks) ka[mt][ks] = *(const bf16x8*)(KA + (size_t)(krow0 + key) * 512 + h * 64 + 32 * ks + 8 * kq); }
#pragma unroll
        for (int g = 0; g < 8; ++g) { int key = 8 * g + (lane >> 3); if (key >= nvalid) key = nvalid - 1;
            vv[g] = *(const bf16x8*)(VA + (size_t)(krow0 + key) * 512 + h * 64 + 8 * (lane & 7)); }
    }
}
__device__ __forceinline__ void attn_load_kraw(const Args& a, int idx, int h, int kt, int half, int lane, f32x4 (&kr)[8]) {
    const int fr = lane & 15, kq = lane >> 4; const float* ck = a.in[I_CK] + ((size_t)(idx * 512 + 64 * kt)) * 512 + h * 64;
#pragma unroll
    for (int m = 0; m < 2; ++m)
#pragma unroll
        for (int ks = 0; ks < 2; ++ks) { const float* p = ck + (size_t)(16 * (2 * half + m) + fr) * 512 + 32 * ks + 8 * kq; kr[(m * 2 + ks) * 2] = *(const f32x4*)p; kr[(m * 2 + ks) * 2 + 1] = *(const f32x4*)(p + 4); }
}
__device__ __forceinline__ void attn_load_vraw(const Args& a, int idx, int h, int kt, int half, int lane, f32x4 (&vr)[8]) {
    const float* cv = a.in[I_CV] + ((size_t)(idx * 512 + 64 * kt)) * 512 + h * 64;
#pragma unroll
    for (int g = 0; g < 4; ++g) { const float* p = cv + (size_t)(8 * (4 * half + g) + (lane >> 3)) * 512 + 8 * (lane & 7); vr[2 * g] = *(const f32x4*)p; vr[2 * g + 1] = *(const f32x4*)(p + 4); }
}
#define PIN8(x) asm volatile("" : "+v"(x[0]), "+v"(x[1]), "+v"(x[2]), "+v"(x[3]), "+v"(x[4]), "+v"(x[5]), "+v"(x[6]), "+v"(x[7]))
typedef short v4i16_t __attribute__((ext_vector_type(4)));
__device__ __forceinline__ void attn_put_v(LAS bf16_t* vR, const bf16x8 (&vv)[8], int lane) {
#pragma unroll
    for (int g = 0; g < 8; ++g) *(LAS bf16x8*)(vR + (8 * g + (lane >> 3)) * VT_PITCH + 8 * (lane & 7)) = vv[g];
}
__device__ __forceinline__ u32x2 tr_read(const LAS bf16_t* p) { return __builtin_bit_cast(u32x2, __builtin_amdgcn_ds_read_tr16_b64_v4i16((LAS v4i16_t*)p)); }
template <int NQ, bool SAMPLE, bool dry = false>
__device__ __forceinline__ void attn_unit(const Args& a, int idx, int h, int qoff, LAS bf16_t* vT, const LAS float* biasL, int lane) {
    const int fr = lane & 15, kq = lane >> 4;
    bf16_t* QA = (bf16_t*)(a.ws + A_QA);
    const int qrow0 = SAMPLE ? MP + idx * 32 : idx * 64 + qoff;
    bf16x8 bq[NQ][2];
#pragma unroll
    for (int nt = 0; nt < NQ; ++nt)
#pragma unroll
        for (int ks = 0; ks < 2; ++ks) bq[nt][ks] = *(const bf16x8*)(QA + (size_t)(qrow0 + 16 * nt + fr) * 512 + h * 64 + 32 * ks + 8 * kq);
    f32x4 o[4][NQ]; float mrun[NQ], lrun[NQ];
#pragma unroll
    for (int nt = 0; nt < NQ; ++nt) { mrun[nt] = -1e30f; lrun[nt] = 0.f;
#pragma unroll
        for (int dt = 0; dt < 4; ++dt) o[dt][nt] = (f32x4){0.f, 0.f, 0.f, 0.f}; }
    const float bias_far = biasL[256];
    int kt = SAMPLE ? 0 : (idx < 8 ? 8 - idx : 0);
    bf16x8 ka[4][2];
    if (!SAMPLE) { bf16x8 vv[8]; attn_load<SAMPLE>(a, idx, h, kt, lane, ka, vv); attn_put_v(vT, vv, lane); }
#pragma unroll 1
    for (; kt < 9; ++kt) {
        bf16x8 vvN[8]; f32x4 vr[8];
        if (SAMPLE) {
            if (kt < 8) {
#pragma unroll
                for (int hf = 0; hf < 2; ++hf) { f32x4 kr[8]; attn_load_kraw(a, idx, h, kt, hf, lane, kr); PIN8(kr);
#pragma unroll
                    for (int j = 0; j < 4; ++j) ka[2 * hf + (j >> 1)][j & 1] = pk8(kr[2 * j], kr[2 * j + 1]); } }
            else attn_load<true>(a, idx, h, 8, lane, ka, vvN);
        }
        const int nvalid = (SAMPLE && kt == 8) ? 32 : 64;
        f32x4 s[4][NQ];
#pragma unroll
        for (int mt = 0; mt < 4; ++mt)
#pragma unroll
            for (int nt = 0; nt < NQ; ++nt) { f32x4 z = (f32x4){0.f, 0.f, 0.f, 0.f}; z = MFMA16(ka[mt][0], bq[nt][0], z); s[mt][nt] = MFMA16(ka[mt][1], bq[nt][1], z); }
        if (!SAMPLE && kt < 8) attn_load<false>(a, idx, h, kt + 1, lane, ka, vvN);
        if (SAMPLE && kt < 8) attn_load_vraw(a, idx, h, kt, 0, lane, vr);
        const int dbase = 64 * (8 - kt);
#pragma unroll
        for (int mt = 0; mt < 4; ++mt)
#pragma unroll
            for (int nt = 0; nt < NQ; ++nt)
#pragma unroll
                for (int i = 0; i < 4; ++i) { const int key = 16 * mt + 4 * kq + i, q = qoff + 16 * nt + fr; float bv = bias_far;
                    if (kt >= 6) { int d = q - key + dbase; d = d < -128 ? -128 : (d > 128 ? 128 : d); bv = biasL[d + 128]; }
                    float sv = s[mt][nt][i] + bv; if (SAMPLE && key >= nvalid) sv = -1e30f; s[mt][nt][i] = sv; }
        bf16x8 pb[NQ][2];
#pragma unroll
        for (int nt = 0; nt < NQ; ++nt) {
            float mx = -1e30f;
#pragma unroll
            for (int mt = 0; mt < 4; ++mt) mx = fmaxf(mx, fmaxf(fmaxf(s[mt][nt][0], s[mt][nt][1]), fmaxf(s[mt][nt][2], s[mt][nt][3])));
            mx = fmaxf(mx, __shfl_xor(mx, 16)); mx = fmaxf(mx, __shfl_xor(mx, 32));
            const float mnew = fmaxf(mrun[nt], mx), sc = __builtin_amdgcn_exp2f(mrun[nt] - mnew); mrun[nt] = mnew; lrun[nt] *= sc;
#pragma unroll
            for (int dt = 0; dt < 4; ++dt) o[dt][nt] = o[dt][nt] * sc;
            const float mcur = mnew; float ls = 0.f;
#pragma unroll
            for (int mt = 0; mt < 4; ++mt)
#pragma unroll
                for (int i = 0; i < 4; ++i) { const float p = __builtin_amdgcn_exp2f(s[mt][nt][i] - mcur); s[mt][nt][i] = p; ls += p; }
            lrun[nt] += ls;
            pb[nt][0] = pk8(s[0][nt], s[1][nt]); pb[nt][1] = pk8(s[2][nt], s[3][nt]);
        }
        if (SAMPLE) {
            if (kt < 8) { PIN8(vr);
#pragma unroll
                for (int g = 0; g < 4; ++g) *(LAS bf16x8*)(vT + (8 * g + (lane >> 3)) * VT_PITCH + 8 * (lane & 7)) = pk8(vr[2 * g], vr[2 * g + 1]);
                attn_load_vraw(a, idx, h, kt, 1, lane, vr); PIN8(vr);
#pragma unroll
                for (int g = 0; g < 4; ++g) *(LAS bf16x8*)(vT + (8 * (4 + g) + (lane >> 3)) * VT_PITCH + 8 * (lane & 7)) = pk8(vr[2 * g], vr[2 * g + 1]); }
            else attn_put_v(vT, vvN, lane); }
        wave_lds_sync();
#pragma unroll
        for (int ks = 0; ks < 2; ++ks)
#pragma unroll
            for (int dt = 0; dt < 4; ++dt) { const LAS bf16_t* vp = vT + (32 * ks + 4 * kq + (fr >> 2)) * VT_PITCH + 16 * dt + 4 * (fr & 3);
                const bf16x8 va = mk8(tr_read(vp), tr_read(vp + 16 * VT_PITCH));
#pragma unroll
                for (int nt = 0; nt < NQ; ++nt) o[dt][nt] = MFMA16(va, pb[nt][ks], o[dt][nt]);
                if (dt & 1) asm volatile("" ::: "memory"); }
        wave_lds_sync();
        if (!SAMPLE && kt < 8) attn_put_v(vT, vvN, lane);
    }
#pragma unroll
    for (int nt = 0; nt < NQ; ++nt) { float l = lrun[nt]; l += __shfl_xor(l, 16); l += __shfl_xor(l, 32); const float inv = 1.f / l;
        bf16_t* op = QA + (size_t)(qrow0 + 16 * nt + fr) * 512 + h * 64 + 4 * kq;
#pragma unroll
        for (int dt = 0; dt < 4; ++dt) if (!dry) *(u32x2*)(op + 16 * dt) = pk4(o[dt][nt] * inv); }
}

constexpr int QE_P = 136, TT_P = 72;
constexpr int G_QE = 0, G_KE = G_QE + 64 * QE_P * 2, G_KLT = G_KE + 64 * QE_P * 2, G_VT = G_KLT + 128 * TT_P * 2, G_ATT = G_VT + 256 * TT_P * 2,
              G_PSUM = G_ATT + 64 * TT_P * 2, G_BLAST = G_PSUM + 2048, G_DVEC = G_BLAST + 512, G_RED = G_DVEC + 512, G_END = G_RED + 2048;
static_assert(G_END <= 131072, "gla lds");
template <int MODE, bool dry = false>
__device__ __forceinline__ void gla_unit(const Args& a, LAS unsigned char* lds, int idx, int h, int tid) {
    constexpr int C = (MODE == 2) ? 32 : 64, TPT = C / 4, NTL = C / 16, KS_T = C / 32;
    const int lane = tid & 63, wave = __builtin_amdgcn_readfirstlane(tid >> 6), fr = lane & 15, kq = lane >> 4;
    LAS bf16_t* qe = (LAS bf16_t*)(lds + G_QE); LAS bf16_t* ke = (LAS bf16_t*)(lds + G_KE); LAS bf16_t* klT = (LAS bf16_t*)(lds + G_KLT);
    LAS bf16_t* vT = (LAS bf16_t*)(lds + G_VT); LAS bf16_t* att = (LAS bf16_t*)(lds + G_ATT);
    LAS float* psum = (LAS float*)(lds + G_PSUM); LAS float* blast = (LAS float*)(lds + G_BLAST); LAS float* dvec = (LAS float*)(lds + G_DVEC); LAS float* red = (LAS float*)(lds + G_RED);
    const int row0 = (MODE == 2) ? MP + idx * 32 : idx * 64;
    const bf16_t* QB = (const bf16_t*)(a.ws + A_QB); const bf16_t* KB = (const bf16_t*)(a.ws + A_KB); bf16_t* VB = (bf16_t*)(a.ws + A_VB); const bf16_t* RB = (const bf16_t*)(a.ws + A_RB);
    const float* DLR = (const float*)((const unsigned char*)a.out + Y_DLR);
    bf16_t* US = (bf16_t*)((unsigned char*)a.out + Y_US) + (size_t)(idx * 4 + h) * 32768;
    bf16x8 vraw[C / 16];
    { const int t = tid & (C - 1), g0 = tid / C;
#pragma unroll
        for (int gi = 0; gi < C / 16; ++gi) vraw[gi] = *(const bf16x8*)(VB + (size_t)(row0 + t) * 1024 + h * 256 + 8 * (g0 * (C / 16) + gi)); }
    bf16x8 sraw[4][2];
    if (MODE == 1) {
#pragma unroll
        for (int ks = 0; ks < 4; ++ks)
#pragma unroll
            for (int m = 0; m < 2; ++m) sraw[ks][m] = *(const bf16x8*)(US + (size_t)(32 * wave + 16 * m + fr) * 128 + 32 * ks + 8 * kq); }
    {
        const int dk = tid & 127, tq = wave >> 1, col = h * 128 + dk;
        float wu[16];
#pragma unroll
        for (int j = 0; j < 16; ++j) wu[j] = a.in[I_WUP][j * 512 + col];
        const float bd = a.in[I_BDEC][col];
        bf16_t kraw[TPT], qraw[TPT];
#pragma unroll
        for (int i = 0; i < TPT; ++i) { const size_t gi = (size_t)(row0 + tq * TPT + i) * 512 + col; kraw[i] = KB[gi]; qraw[i] = (MODE != 0) ? QB[gi] : (bf16_t)0; }
        float bl[TPT]; float run = 0.f;
#pragma unroll
        for (int i = 0; i < TPT; ++i) { const f32x4* dp = (const f32x4*)(DLR + (size_t)(row0 + tq * TPT + i) * 16); float z = bd;
#pragma unroll
            for (int j4 = 0; j4 < 4; ++j4) { const f32x4 d = dp[j4]; z += d[0] * wu[4 * j4] + d[1] * wu[4 * j4 + 1] + d[2] * wu[4 * j4 + 2] + d[3] * wu[4 * j4 + 3]; }
            const float la = (fminf(z, 0.f) - __logf(1.f + __expf(-fabsf(z)))) * (1.f / 16.f);
            run += la; bl[i] = run; }
        psum[tq * 128 + dk] = run;
        __syncthreads();
        float off = 0.f, tot = 0.f;
#pragma unroll
        for (int p = 0; p < 4; ++p) { const float v = psum[p * 128 + dk]; tot += v; if (p < tq) off += v; }
        if (tq == 0) { dvec[dk] = __expf(tot); if (MODE == 0) ((float*)((unsigned char*)a.out + Y_DEC))[(size_t)(idx * 4 + h) * 128 + dk] = __expf(tot); }
#pragma unroll
        for (int i = 0; i < TPT; ++i) { const int t = tq * TPT + i; const float b = bl[i] + off;
            const float kv = bf2f(kraw[i]);
            if (MODE != 0) { const float qv = bf2f(qraw[i]); qe[t * QE_P + dk] = f2bf(qv * __expf(b)); ke[t * QE_P + dk] = f2bf(kv * __expf(-b)); }
            if (MODE != 1) klT[dk * TT_P + t] = f2bf(kv * __expf(tot - b)); }
    }
    {
        const int t = tid & (C - 1), g0 = tid / C;
#pragma unroll
        for (int gi = 0; gi < C / 16; ++gi) { const int g = g0 * (C / 16) + gi; const bf16x8 vv = vraw[gi];
#pragma unroll
            for (int j = 0; j < 8; ++j) vT[(8 * g + j) * TT_P + t] = (bf16_t)vv[j]; }
    }
    __syncthreads();
    if (MODE != 0) {
        for (int id = wave; id < NTL * NTL; id += 8) { const int ms = id / NTL, nt = id % NTL; f32x4 acc = (f32x4){0.f, 0.f, 0.f, 0.f};
#pragma unroll
            for (int ks = 0; ks < 4; ++ks) acc = MFMA16(*(const LAS bf16x8*)(ke + (16 * ms + fr) * QE_P + 32 * ks + 8 * kq), *(const LAS bf16x8*)(qe + (16 * nt + fr) * QE_P + 32 * ks + 8 * kq), acc);
            const int t = 16 * nt + fr;
#pragma unroll
            for (int i = 0; i < 4; ++i) if (16 * ms + 4 * kq + i > t) acc[i] = 0.f;
            *(LAS u32x2*)(att + t * TT_P + 16 * ms + 4 * kq) = pk4(acc); }
    }
    if (MODE != 1) {
        f32x4 u[8][2];
#pragma unroll
        for (int mt = 0; mt < 8; ++mt)
#pragma unroll
            for (int n = 0; n < 2; ++n) u[mt][n] = (f32x4){0.f, 0.f, 0.f, 0.f};
#pragma unroll
        for (int ks = 0; ks < KS_T; ++ks) { bf16x8 bv[2];
#pragma unroll
            for (int n = 0; n < 2; ++n) bv[n] = *(const LAS bf16x8*)(vT + (32 * wave + 16 * n + fr) * TT_P + 32 * ks + 8 * kq);
#pragma unroll
            for (int mt = 0; mt < 8; ++mt) { const bf16x8 av = *(const LAS bf16x8*)(klT + (16 * mt + fr) * TT_P + 32 * ks + 8 * kq);
#pragma unroll
                for (int n = 0; n < 2; ++n) u[mt][n] = MFMA16(av, bv[n], u[mt][n]); } }
        if (MODE == 0) {
#pragma unroll
            for (int mt = 0; mt < 8; ++mt)
#pragma unroll
                for (int n = 0; n < 2; ++n) *(u32x2*)(US + (size_t)(32 * wave + 16 * n + fr) * 128 + 16 * mt + 4 * kq) = pk4(u[mt][n]);
        } else {
            const float* S0 = a.in[I_ST] + (size_t)(idx * 4 + h) * 32768; float* S1 = a.out + O_SS + (size_t)(idx * 4 + h) * 32768;
#pragma unroll
            for (int mt = 0; mt < 8; ++mt)
#pragma unroll
                for (int n = 0; n < 2; ++n)
#pragma unroll
                    for (int i = 0; i < 4; ++i) { const int dk = 16 * mt + 4 * kq + i, dv = 32 * wave + 16 * n + fr; S1[dk * 256 + dv] = dvec[dk] * S0[dk * 256 + dv] + u[mt][n][i]; }
        }
    }
    if (MODE != 0) {
        __syncthreads();
        f32x4 o[2][NTL];
#pragma unroll
        for (int m = 0; m < 2; ++m)
#pragma unroll
            for (int nt = 0; nt < NTL; ++nt) o[m][nt] = (f32x4){0.f, 0.f, 0.f, 0.f};
#pragma unroll
        for (int ks = 0; ks < KS_T; ++ks) { bf16x8 av[2];
#pragma unroll
            for (int m = 0; m < 2; ++m) av[m] = *(const LAS bf16x8*)(vT + (32 * wave + 16 * m + fr) * TT_P + 32 * ks + 8 * kq);
#pragma unroll
            for (int nt = 0; nt < NTL; ++nt) { const bf16x8 bv = *(const LAS bf16x8*)(att + (16 * nt + fr) * TT_P + 32 * ks + 8 * kq);
#pragma unroll
                for (int m = 0; m < 2; ++m) o[m][nt] = MFMA16(av[m], bv, o[m][nt]); } }
#pragma unroll
        for (int ks = 0; ks < 4; ++ks) { bf16x8 av[2];
#pragma unroll
            for (int m = 0; m < 2; ++m) { const int dv = 32 * wave + 16 * m + fr;
                if (MODE == 1) av[m] = sraw[ks][m];
                else { const float* sp = a.in[I_ST] + (size_t)(idx * 4 + h) * 32768 + (size_t)(32 * ks + 8 * kq) * 256 + dv; f32x4 x0, x1;
#pragma unroll
                    for (int j = 0; j < 4; ++j) { x0[j] = sp[j * 256]; x1[j] = sp[(j + 4) * 256]; }
                    av[m] = pk8(x0, x1); } }
#pragma unroll
            for (int nt = 0; nt < NTL; ++nt) { const bf16x8 bv = *(const LAS bf16x8*)(qe + (16 * nt + fr) * QE_P + 32 * ks + 8 * kq);
#pragma unroll
                for (int m = 0; m < 2; ++m) o[m][nt] = MFMA16(av[m], bv, o[m][nt]); } }
#pragma unroll
        for (int nt = 0; nt < NTL; ++nt) { float ss = 0.f;
#pragma unroll
            for (int m = 0; m < 2; ++m) ss += (o[m][nt][0] * o[m][nt][0] + o[m][nt][1] * o[m][nt][1]) + (o[m][nt][2] * o[m][nt][2] + o[m][nt][3] * o[m][nt][3]);
            ss += __shfl_xor(ss, 16); ss += __shfl_xor(ss, 32);
            if (kq == 0) red[wave * 64 + 16 * nt + fr] = ss; }
        __syncthreads();
#pragma unroll
        for (int nt = 0; nt < NTL; ++nt) { const int t = 16 * nt + fr; float tot = 0.f;
#pragma unroll
            for (int w = 0; w < 8; ++w) tot += red[w * 64 + t];
            const float rstd = rsqrtf(tot * (1.f / 256.f) + EPS);
#pragma unroll
            for (int m = 0; m < 2; ++m) { const int dv = 32 * wave + 16 * m + 4 * kq; const size_t gi = (size_t)(row0 + t) * 1024 + h * 256 + dv;
                const f32x4 gn = *(const f32x4*)(a.in[I_GNORM] + dv); const f32x4 rb = up4(*(const u32x2*)(RB + gi));
                if (!dry) *(u32x2*)(VB + gi) = pk4(o[m][nt] * rstd * gn * rb); } }
    }
    __syncthreads();
}

template <bool DRYS = false>
__device__ __forceinline__ void scan_phase(const Args& a, int tid, int nthr, int blk, int nblk) {
    u32x2* US64 = (u32x2*)((unsigned char*)a.out + Y_US); const f32x4* DEC = (const f32x4*)((const unsigned char*)a.out + Y_DEC);
    const int per = (32768 + nblk - 1) / nblk;
    if (tid >= nthr) return;
    for (int q = tid; q < per; q += nthr) {
    const int p = blk * per + q; if (p >= 32768) break;
    const int hh = p >> 13, dv = (p >> 5) & 255, dq = p & 31; f32x4 st = (f32x4){0.f, 0.f, 0.f, 0.f};
    u32x2* up = US64 + (size_t)hh * 8192 + dv * 32 + dq; const f32x4* dp = DEC + hh * 32 + dq;
    for (int c0 = 0; c0 < 256; c0 += 8) { u32x2 u[8]; f32x4 d[8];
#pragma unroll
        for (int j = 0; j < 8; ++j) { u[j] = up[(size_t)(c0 + j) * 32768]; d[j] = dp[(c0 + j) * 128]; }
#pragma unroll
        for (int j = 0; j < 8; ++j) { if (!DRYS || st[0] == 123.456f) up[(size_t)(c0 + j) * 32768] = pk4(st); st = d[j] * st + up4(u[j]); } }
    float* so = a.out + O_SP + (size_t)(hh * 128 + 4 * dq) * 256 + dv;
    if (!DRYS || st[0] == 123.456f) { so[0] = st[0]; so[256] = st[1]; so[512] = st[2]; so[768] = st[3]; }
    }
}

#define XB_TMO      128
#define XB_XCNT(j)  (256  + 64 * (j))
#define XB_XSUB(j)  (1280 + 64 * (j))
#define XB_XGEN(j)  (2304 + 64 * (j))
#define XB_TOP      3328
#define XB_TOPGEN   3392
#define XCD_BAR_WORDS 3456
#define XB_SPIN_CAP (1u << 18)

__device__ __forceinline__ unsigned xb_ld(unsigned* p)              { return __hip_atomic_load(p, __ATOMIC_RELAXED, __HIP_MEMORY_SCOPE_AGENT); }
__device__ __forceinline__ unsigned xb_add(unsigned* p, unsigned v) { return __hip_atomic_fetch_add(p, v, __ATOMIC_RELAXED, __HIP_MEMORY_SCOPE_AGENT); }
__device__ __forceinline__ unsigned xb_xcc_id() { return (unsigned)__builtin_amdgcn_s_getreg((3 << 11) | 20) & 0xFu; }
#define XB_SPIN(cond, bar) do { unsigned _sp = 0; while (cond) { __builtin_amdgcn_s_sleep(1); \
    if ((++_sp & 255u) == 0u) { if (xb_ld(&(bar)[XB_TMO])) break; if (_sp > XB_SPIN_CAP) { atomicAdd(&(bar)[XB_TMO], 1u); break; } } } } while (0)

struct XcdBarrier {
    unsigned* bar; unsigned x;
    volatile LAS unsigned* st;
};

__device__ __forceinline__ XcdBarrier xcd_barrier_post(unsigned* bar, volatile LAS unsigned* st) {
    XcdBarrier b; b.bar = bar; b.x = xb_xcc_id(); b.st = st;
    if (threadIdx.x == 0) (void)xb_add(&bar[XB_XCNT(b.x)], 1u);
    return b;
}
__device__ __forceinline__ void xcd_barrier_complete(unsigned* bar, unsigned x, unsigned& nloc, unsigned& nx) {
    const unsigned G = gridDim.x * gridDim.y * gridDim.z;
    unsigned sum, cnt, mine, sp = 0u;
    for (;;) {
        sum = 0u; cnt = 0u; mine = 0u;
#pragma unroll
        for (unsigned j = 0; j < 16; ++j) { const unsigned c = xb_ld(&bar[XB_XCNT(j)]); sum += c; cnt += (c > 0u) ? 1u : 0u; mine = (j == x) ? c : mine; }
        if (sum == G) break;
        __builtin_amdgcn_s_sleep(1);
        if ((++sp & 255u) == 0u) { if (xb_ld(&bar[XB_TMO])) break; if (sp > XB_SPIN_CAP) { atomicAdd(&bar[XB_TMO], 1u); break; } }
    }
    nloc = mine > 0u ? mine : 1u; nx = cnt > 0u ? cnt : 1u;
}

__device__ __forceinline__ void xcd_barrier(const XcdBarrier& b) {
    asm volatile("s_waitcnt vmcnt(0)" ::: "memory");
    __syncthreads();
    if (threadIdx.x == 0) {
        unsigned* bar = b.bar;
        __builtin_amdgcn_s_waitcnt(0);
        unsigned nloc = b.st[0], nx = b.st[1];
        if (nloc == 0u) { xcd_barrier_complete(bar, b.x, nloc, nx); b.st[0] = nloc; b.st[1] = nx; }
        const unsigned old = xb_add(&bar[XB_XSUB(b.x)], 1u);
        const unsigned gen = old / nloc;
        if (old + 1u == (gen + 1u) * nloc) {
            __builtin_amdgcn_fence(__ATOMIC_RELEASE, "agent");
            asm volatile("s_waitcnt vmcnt(0)" ::: "memory");
            const unsigned og = xb_add(&bar[XB_TOP], 1u);
            const unsigned tg = og / nx;
            if (og + 1u == (tg + 1u) * nx) xb_add(&bar[XB_TOPGEN], 1u);
            else XB_SPIN(xb_ld(&bar[XB_TOPGEN]) == tg, bar);
            __builtin_amdgcn_fence(__ATOMIC_ACQUIRE, "agent");
            xb_add(&bar[XB_XGEN(b.x)], 1u);
            asm volatile("s_waitcnt vmcnt(0)" ::: "memory");
        } else {
            XB_SPIN(xb_ld(&bar[XB_XGEN(b.x)]) == gen, bar);
            __builtin_amdgcn_fence(__ATOMIC_ACQUIRE, "agent");
            asm volatile("s_waitcnt vmcnt(0)" ::: "memory");
        }
    }
    __syncthreads();
}


constexpr size_t WS_BAR = 36315136;
constexpr int NPH = 14;
__global__ void __launch_bounds__(512) fwd_kernel(Args a) {
    extern __shared__ __attribute__((aligned(16))) unsigned char lds_raw[];
    LAS unsigned char* lds = (LAS unsigned char*)lds_raw;
    const int tid = threadIdx.x, lane = tid & 63, wave = __builtin_amdgcn_readfirstlane(tid >> 6);
    const int G = gridDim.x, gw = blockIdx.x * 8 + wave, NGW = G * 8;
    cg::grid_group grid = cg::this_grid();
    volatile LAS unsigned* xst = (volatile LAS unsigned*)(lds + LDS_BYTES - 16);
    if (tid < 4) xst[tid] = 0u;
    __syncthreads();
    if (a.ph_lo == 0) { if (blockIdx.x == 0) for (int i = tid; i < XCD_BAR_WORDS; i += 512) ((unsigned*)(a.ws + WS_BAR))[i] = 0u;
        grid.sync(); (void)xcd_barrier_post((unsigned*)(a.ws + WS_BAR), xst); }
#define SEAM(k) do { XcdBarrier xb_; xb_.bar = (unsigned*)(a.ws + WS_BAR); xb_.x = xb_xcc_id(); xb_.st = (volatile LAS unsigned*)(lds + LDS_BYTES - 16); xcd_barrier(xb_); } while (0)
#define PH(k) if (a.ph_lo <= (k) && (k) < a.ph_hi) { if ((k) > a.ph_lo && (k) != 6) SEAM(k);
#define PHEND }
#define GEMM_N1024(EPI, Aoff, Woff, Mrows, Kdim, rowbase, Gn, cid, ...) do { pg8::Gemm g{(const bf16_t*)(a.ws + (Aoff)) + (size_t)(rowbase) * (Kdim), (const bf16_t*)(a.ws + (Woff)), (Mrows), 1024, (Kdim)}; \
        pg8::StaticOrder S; S.init((Mrows), 1024, (Gn), (cid)); EPI E{__VA_ARGS__, (rowbase)}; pg8::gemm_phase<EPI, pg8::StaticOrder, false, true>(lds, g, S, E); } while (0)
    const int bx = (int)blockIdx.x;
    PH(0) {
        float* rss = (float*)(a.ws + WS_RSS1);
        for (int i = bx * 512 + tid; i < 2 * MT; i += G * 512) rss[i] = 0.f;
        p0_convert(a, (LAS float*)lds + wave * (64 * 65), gw, NGW, lane);
        __syncthreads();
        p0_rows(a, lds, gw, NGW, wave, lane, tid);
    } PHEND
    PH(1) {
        pg8::Gemm g{(const bf16_t*)((const unsigned char*)a.out + Y_H), (const bf16_t*)(a.ws + WS_WIN), MT, NIN, 1024}; pg8::StaticOrder S; S.init(MT, NIN, G, bx);
        EpiIn E{a.ws, a.out}; pg8::gemm_phase<EpiIn, pg8::StaticOrder, true, true>(lds, g, S, E);
    } PHEND
    PH(2) {
        LAS float* biasL = (LAS float*)(lds + 8 * 64 * VT_PITCH * 2);
        for (int i = tid; i < 8 * 257; i += 512) biasL[i] = a.in[I_RELB][i] * 1.4426950408889634f;
        __syncthreads();
        LAS bf16_t* vT = (LAS bf16_t*)lds + wave * (64 * VT_PITCH);
        for (int u = gw; u < 256; u += NGW) attn_unit<2, true>(a, u >> 3, u & 7, 0, vT, biasL + (u & 7) * 257, lane);
        __syncthreads();
        const bool few = (G == 256) && bx < 32;
        for (int u = (G != 256) ? bx : (few ? bx : 64 + bx - 32); u < (few ? 64 : 1024 + 128); u += (G != 256) ? G : (few ? 32 : 224)) {
            if (u < 1024) gla_unit<0>(a, lds, u >> 2, u & 3, tid);
            else gla_unit<2>(a, lds, (u - 1024) >> 2, u & 3, tid); }
    } PHEND
    PH(3) {
        if (bx < 16) {
            GEMM_N1024(EpiN1024<0>, A_QA, WS_WPA, MS, 512, MP, 16, bx, (bf16_t*)(a.ws + A_GA), nullptr, nullptr);
            GEMM_N1024(EpiN1024<1>, A_VB, WS_WPB, MS, 1024, MP, 16, bx, (bf16_t*)(a.ws + A_GA), (const bf16_t*)(a.ws + A_GB), nullptr);
        } else {
            LAS float* biasL = (LAS float*)(lds + 8 * 64 * VT_PITCH * 2);
            for (int i = tid; i < 8 * 257; i += 512) biasL[i] = a.in[I_RELB][i] * 1.4426950408889634f;
            __syncthreads();
            if (wave >= 3) { LAS bf16_t* vT = (LAS bf16_t*)lds + wave * (64 * VT_PITCH);
                for (int u = (bx - 16) * 5 + (wave - 3); u < 4096; u += (G - 16) * 5) attn_unit<2, false>(a, u >> 4, u & 7, ((u >> 3) & 1) * 32, vT, biasL + (u & 7) * 257, lane); }
            else scan_phase(a, tid, 192, bx - 16, G - 16);
        }
    } PHEND
    PH(4) { for (int u = bx; u < 1024; u += G) gla_unit<1>(a, lds, u >> 2, u & 3, tid); } PHEND
    PH(5) {
        GEMM_N1024(EpiN1024<0>, A_QA, WS_WPA, MP, 512, 0, G, bx, (bf16_t*)(a.ws + A_GA), nullptr, nullptr);
        GEMM_N1024(EpiN1024<1>, A_VB, WS_WPB, MP, 1024, 0, G, bx, (bf16_t*)(a.ws + A_GA), (const bf16_t*)(a.ws + A_GB), nullptr);
    } PHEND
    PH(6) { } PHEND
    PH(7) { GEMM_N1024(EpiN1024<2>, A_GA, WS_WOUT, MP, 1024, 0, G, bx, (bf16_t*)(a.ws + A_GB), nullptr, (float*)(a.ws + WS_RSS1)); } PHEND
    PH(8) {
        if (G >= 32 && bx < 16) GEMM_N1024(EpiN1024<2>, A_GA, WS_WOUT, MS, 1024, MP, 16, bx, (bf16_t*)(a.ws + A_GB), nullptr, (float*)(a.ws + WS_RSS1));
        else if (G >= 32) row_pass1(a, 0, MP, gw - 128, NGW - 128, lane);
        else { row_pass1(a, 0, MP, gw, NGW, lane); GEMM_N1024(EpiN1024<2>, A_GA, WS_WOUT, MS, 1024, MP, G, bx, (bf16_t*)(a.ws + A_GB), nullptr, (float*)(a.ws + WS_RSS1)); }
    } PHEND
    PH(9) { row_pass1(a, MP, MT, gw, NGW, lane); } PHEND
    PH(10) {
        pg8::Gemm g{(const bf16_t*)(a.ws + A_RB), (const bf16_t*)(a.ws + WS_WGU), MT, NGU, 1024}; pg8::StaticOrder S; S.init(MT, NGU, G, bx);
        EpiSwiglu E{(bf16_t*)(a.ws + A_HID)}; pg8::gemm_phase<EpiSwiglu, pg8::StaticOrder, true, true>(lds, g, S, E);
    } PHEND
    PH(11) { GEMM_N1024(EpiN1024<2>, A_HID, WS_WDN, MP, DFF, 0, G, bx, (bf16_t*)(a.ws + A_GA), nullptr, (float*)(a.ws + WS_RSS2)); } PHEND
    PH(12) {
        if (G >= 32 && bx < 16) GEMM_N1024(EpiN1024<2>, A_HID, WS_WDN, MS, DFF, MP, 16, bx, (bf16_t*)(a.ws + A_GA), nullptr, (float*)(a.ws + WS_RSS2));
        else if (G >= 32) row_pass2(a, 0, MP, gw - 128, NGW - 128, lane);
        else { row_pass2(a, 0, MP, gw, NGW, lane); GEMM_N1024(EpiN1024<2>, A_HID, WS_WDN, MS, DFF, MP, G, bx, (bf16_t*)(a.ws + A_GA), nullptr, (float*)(a.ws + WS_RSS2)); }
    } PHEND
    PH(13) { row_pass2(a, MP, MT, gw, NGW, lane); } PHEND
}

#ifndef ONE_LAUNCH
#define ONE_LAUNCH 1
#endif
extern "C" void kernel_launch(void* const* d_in, const int* in_sizes, int n_in, void* d_out, int out_size, void* d_ws, size_t ws_size, hipStream_t stream) {
    static int grid = 0;
    if (grid == 0) {
        if (n_in != 20 || ws_size < A_END || out_size != 23724032) { fprintf(stderr, "kernel_launch: unexpected sizes n_in %d ws %zu out %d\n", n_in, ws_size, out_size); }
        int dev = 0, cus = 0, per_cu = 0;
        hipGetDevice(&dev); hipDeviceGetAttribute(&cus, hipDeviceAttributeMultiprocessorCount, dev);
        hipFuncSetAttribute((const void*)fwd_kernel, hipFuncAttributeMaxDynamicSharedMemorySize, LDS_BYTES);
        hipOccupancyMaxActiveBlocksPerMultiprocessor(&per_cu, (const void*)fwd_kernel, 512, LDS_BYTES);
        if (per_cu < 1) { fprintf(stderr, "kernel_launch: occupancy query says %d blocks per CU\n", per_cu); per_cu = 1; }
        grid = cus * 1;
        (void)hipGetLastError();
    }
    Args a{};
    for (int i = 0; i < 20; ++i) a.in[i] = (const float*)d_in[i];
    a.out = (float*)d_out; a.ws = (unsigned char*)d_ws;
#if ONE_LAUNCH
    a.ph_lo = 0; a.ph_hi = NPH;
    void* args[] = {&a};
    hipError_t e = hipLaunchCooperativeKernel((const void*)fwd_kernel, dim3(grid), dim3(512), args, LDS_BYTES, stream);
    if (e != hipSuccess) fprintf(stderr, "cooperative launch failed: %s (grid %d)\n", hipGetErrorString(e), grid);
#else
    for (int ph = 0; ph < NPH; ++ph) { a.ph_lo = ph; a.ph_hi = ph + 1; hipLaunchKernelGGL(fwd_kernel, dim3(grid), dim3(512), LDS_BYTES, stream, a); }
#endif
}
```

```cpp
#include <hip/hip_runtime.h>
#include <hip/hip_cooperative_groups.h>
#include <cstdio>
namespace cg = cooperative_groups;

#define LAS __attribute__((address_space(3)))
typedef unsigned short bf16_t;
typedef short bf16x8 __attribute__((ext_vector_type(8)));
typedef float f32x4 __attribute__((ext_vector_type(4)));
typedef float f32x2 __attribute__((ext_vector_type(2)));
typedef unsigned u32x4 __attribute__((ext_vector_type(4)));
typedef unsigned u32x2 __attribute__((ext_vector_type(2)));

constexpr int MP = 16384, MS = 1024, MT = MP + MS, DM = 1024, DIN = 6672, NIN = 6656, DFF = 2816, NGU = 2 * DFF;
constexpr float EPS = 1e-6f;
constexpr size_t O_Y = 0, O_KP = 17825792, O_VP = 18087936, O_SP = 18350080, O_KS = 18481152, O_VS = 19005440, O_SS = 19529728;
constexpr size_t WS_WIN = 0, WS_WPA = 13631488, WS_WPB = 14680064, WS_WOUT = 16777216, WS_WGU = 18874368, WS_WDN = 30408704, WS_RSS1 = 36175872, WS_RSS2 = WS_RSS1 + 69632;
constexpr size_t WS_ACT = 36700160;
constexpr size_t A_QA = WS_ACT, A_KA = A_QA + 17825792, A_VA = A_KA + 17825792, A_QB = A_VA + 17825792, A_KB = A_QB + 17825792, A_VB = A_KB + 17825792,
                 A_RB = A_VB + 35651584, A_GA = A_RB + 35651584, A_GB = A_GA + 35651584, A_END = A_GB + 35651584, A_HID = A_QA;
static_assert(A_END == 268435456, "ws map");
constexpr size_t Y_H = 0, Y_US = 0, Y_DLR = 67108864, Y_DEC = Y_DLR + 1114112;
static_assert(Y_DEC + 524288 <= 71303168, "y scratch");

typedef __bf16 bf16x2_t __attribute__((ext_vector_type(2)));
__device__ __forceinline__ unsigned cvt_pk_bf16(float lo, float hi) { f32x2 v = {lo, hi}; bf16x2_t b = __builtin_convertvector(v, bf16x2_t); return __builtin_bit_cast(unsigned, b); }
__device__ __forceinline__ float bf_lo(unsigned u) { return __uint_as_float(u << 16); }
__device__ __forceinline__ float bf_hi(unsigned u) { return __uint_as_float(u & 0xffff0000u); }
__device__ __forceinline__ float bf2f(bf16_t b) { return __uint_as_float(((unsigned)b) << 16); }
__device__ __forceinline__ bf16_t f2bf(float f) { return (bf16_t)(cvt_pk_bf16(f, 0.f) & 0xffffu); }
__device__ __forceinline__ float wave_sum(float v) { for (int o = 32; o >= 1; o >>= 1) v += __shfl_xor(v, o); return v; }
__device__ __forceinline__ void wave_lds_sync() { asm volatile("s_waitcnt lgkmcnt(0)" ::: "memory"); __builtin_amdgcn_wave_barrier(); }
__device__ __forceinline__ float fast_sigmoid(float x) { return __builtin_amdgcn_rcpf(1.0f + __expf(-x)); }
__device__ __forceinline__ bf16x8 mk8(u32x2 a, u32x2 b) { u32x4 w; w.x = a.x; w.y = a.y; w.z = b.x; w.w = b.y; return __builtin_bit_cast(bf16x8, w); }
__device__ __forceinline__ bf16x8 pk8(f32x4 a, f32x4 b) { u32x4 w; w.x = cvt_pk_bf16(a[0], a[1]); w.y = cvt_pk_bf16(a[2], a[3]); w.z = cvt_pk_bf16(b[0], b[1]); w.w = cvt_pk_bf16(b[2], b[3]); return __builtin_bit_cast(bf16x8, w); }
#define MFMA16(a, b, c) __builtin_amdgcn_mfma_f32_16x16x32_bf16((a), (b), (c), 0, 0, 0)

namespace pg8 {
#define PG8_LAS __attribute__((address_space(3)))
constexpr int BM = 256, BK = 64, HALF = 128, HTB = HALF * BK * 2, STAGE_BYTES = 8 * HTB, NXCD = 8, WGM = 8;
__host__ __device__ __forceinline__ int lds_byte(int r, int c) { const int st = (r >> 4) * 2 + (c >> 5), rr = r & 15, cc = c & 31, ob = rr * 64 + cc * 2; return st * 1024 + (ob ^ (((ob >> 9) & 1) << 5)); }
__host__ __device__ __forceinline__ void stage_rc(int b, int& R, int& C) { const int st = b / 1024, sb = b % 1024, swz = sb ^ (((sb >> 9) & 1) << 5); R = (st >> 1) * 16 + swz / 64; C = (st & 1) * 32 + (swz % 64) / 2; }
__host__ __device__ __forceinline__ int perm32(int rho) { const int n = rho >> 4, i = rho & 15; return 8 * (i >> 2) + 4 * n + (i & 3); }
struct Unit { int pm, pn; };
struct Gemm { const bf16_t* A; const bf16_t* Bt; int M, N, K; };
struct StaticOrder {
    int nM, nN, nwg, G, c;
    __host__ __device__ void init(int M, int N, int G_, int c_) { nM = M / BM; nN = N / BM; nwg = nM * nN; G = G_; c = c_; }
    __host__ __device__ bool next(int i, Unit& u) const {
        const long L = (long)i * G + c; if (L >= nwg) return false;
        int wgid = (int)L; { const int q = nwg / NXCD, r = nwg % NXCD, xcd = wgid % NXCD, off = wgid / NXCD; wgid = (xcd < r ? xcd * (q + 1) : r * (q + 1) + (xcd - r) * q) + off; }
        const int nig = WGM * nN, gid = wgid / nig, fm = gid * WGM, gsz = (nM - fm) < WGM ? (nM - fm) : WGM;
        u.pm = fm + ((wgid % nig) % gsz); u.pn = (wgid % nig) / gsz; return true;
    }
    __device__ __forceinline__ void a_ready(const Unit&) const {}
    __device__ __forceinline__ void done(const Unit&) const {}
};
template <class Epi, class Sched, bool ALIGN_EPI = false, bool SP2 = false>
__device__ __forceinline__ void gemm_phase(PG8_LAS unsigned char* lds, const Gemm g, const Sched& S, const Epi& E) {
    const int tid = threadIdx.x, wid = __builtin_amdgcn_readfirstlane(tid >> 6), lane = tid & 63, wr = wid >> 2, wc = wid & 3, fr = lane & 15, fq = lane >> 4;
    const int K = g.K, nt = K / BK;
    unsigned voffA[2], voffB[2];
#pragma unroll
    for (int i = 0; i < 2; ++i) { int R, C; stage_rc(tid * 16 + i * 8192, R, C); const int Rb = Epi::PERM ? ((R & ~31) + perm32(R & 31)) : R;
        voffA[i] = (unsigned)(R * K + C) * 2u; voffB[i] = (unsigned)(Rb * K + C) * 2u; }
    const size_t kstep = (size_t)(BK * 2);
    const size_t hstep = (size_t)HALF * K * 2;
    const size_t tstep = 2 * hstep;
    const unsigned ldsw = (unsigned)wid * 1024u;
    const int aoff = lds_byte(wr * 64 + fr, fq * 8), boff = lds_byte(wc * 32 + fr, fq * 8);
#define PG8_SA(b, h) (((b) * 2 + (h)) * HTB)
#define PG8_SB(b, h) ((4 + (b) * 2 + (h)) * HTB)
#define PG8_STAGE(bufoff, gbase, voff) do { _Pragma("unroll") for (int _i = 0; _i < 2; ++_i) \
        __builtin_amdgcn_global_load_lds((const unsigned*)((const char*)(gbase) + (voff)[_i]), (PG8_LAS unsigned*)(lds + (bufoff) + ldsw + _i * 8192), 16, 0, 0); } while (0)
#define PG8_LDA(dst, b, h) do { _Pragma("unroll") for (int m = 0; m < 4; ++m) _Pragma("unroll") for (int k = 0; k < 2; ++k) dst[m][k] = *(const PG8_LAS bf16x8*)(lds + PG8_SA(b, h) + aoff + m * 2048 + k * 1024); } while (0)
#define PG8_LDB(dst, b, h) do { _Pragma("unroll") for (int n = 0; n < 2; ++n) _Pragma("unroll") for (int k = 0; k < 2; ++k) dst[n][k] = *(const PG8_LAS bf16x8*)(lds + PG8_SB(b, h) + boff + n * 2048 + k * 1024); } while (0)
#define PG8_MMA(ai, bj, At, Bt) do { __builtin_amdgcn_s_setprio(1); _Pragma("unroll") for (int m = 0; m < 4; ++m) _Pragma("unroll") for (int n = 0; n < 2; ++n) _Pragma("unroll") for (int k = 0; k < 2; ++k) \
        acc[ai][bj][m][n] = __builtin_amdgcn_mfma_f32_16x16x32_bf16(Bt[n][k], At[m][k], acc[ai][bj][m][n], 0, 0, 0); __builtin_amdgcn_s_setprio(0); } while (0)
#define PG8_WAIT_V(n) asm volatile("s_waitcnt vmcnt(" #n ")" ::: "memory")
#define PG8_WAIT_L(n) asm volatile("s_waitcnt lgkmcnt(" #n ")" ::: "memory")
#define PG8_BAR __builtin_amdgcn_s_barrier()
#define PG8_SCHED __builtin_amdgcn_sched_barrier(0)
    Unit cur, nxt; int ui = 0;
    if (!S.next(0, cur)) return;
    f32x4 acc[2][2][4][2];
#pragma unroll
    for (int a = 0; a < 2; ++a)
#pragma unroll
        for (int b = 0; b < 2; ++b)
#pragma unroll
            for (int m = 0; m < 4; ++m)
#pragma unroll
                for (int n = 0; n < 2; ++n) acc[a][b][m][n] = (f32x4){0.f, 0.f, 0.f, 0.f};
    bf16x8 At[4][2], B0[2][2], B1[2][2];
    const char* cA = (const char*)g.A + (size_t)cur.pm * tstep; const char* cB = (const char*)g.Bt + (size_t)cur.pn * tstep;
    S.a_ready(cur);
    if constexpr (SP2) {
        PG8_STAGE(PG8_SB(0, 0), cB, voffB); PG8_STAGE(PG8_SB(0, 1), cB + hstep, voffB); PG8_STAGE(PG8_SA(0, 0), cA, voffA); PG8_STAGE(PG8_SA(0, 1), cA + hstep, voffA);
        if (wr == 1) PG8_BAR;
        PG8_WAIT_V(2); PG8_BAR;
        PG8_STAGE(PG8_SB(1, 0), cB + kstep, voffB); PG8_STAGE(PG8_SA(1, 0), cA + kstep, voffA); PG8_STAGE(PG8_SB(1, 1), cB + hstep + kstep, voffB);
        PG8_WAIT_V(6); PG8_BAR;
    } else {
        PG8_STAGE(PG8_SB(0, 0), cB, voffB); PG8_STAGE(PG8_SA(0, 0), cA, voffA); PG8_STAGE(PG8_SB(0, 1), cB + hstep, voffB); PG8_STAGE(PG8_SA(0, 1), cA + hstep, voffA);
        if (wr == 1) PG8_BAR;
        PG8_WAIT_V(4); PG8_BAR;
        PG8_STAGE(PG8_SB(1, 0), cB + kstep, voffB); PG8_STAGE(PG8_SA(1, 0), cA + kstep, voffA); PG8_STAGE(PG8_SB(1, 1), cB + hstep + kstep, voffB);
        PG8_WAIT_V(6); PG8_BAR;
    }
    for (;;) {
        const bool has_next = S.next(ui + 1, nxt);
        const char* nA = has_next ? (const char*)g.A + (size_t)nxt.pm * tstep : cA; const char* nB = has_next ? (const char*)g.Bt + (size_t)nxt.pn * tstep : cB;
        for (int t = 0; t < nt; t += 2) {
            const bool last = (t == nt - 2);
            const char* a1 = cA + (size_t)(t + 1) * kstep;
            const char* a2 = last ? nA : cA + (size_t)(t + 2) * kstep; const char* b2 = last ? nB : cB + (size_t)(t + 2) * kstep;
            const char* a3 = a2 + kstep; const char* b3 = b2 + kstep;
            if (last && has_next) S.a_ready(nxt);
            if constexpr (SP2) {
            PG8_LDB(B0, 0, 0); PG8_LDB(B1, 0, 1); PG8_SCHED; PG8_LDA(At, 0, 0); PG8_STAGE(PG8_SA(1, 1), a1 + hstep, voffA);
            PG8_WAIT_V(8); PG8_WAIT_L(0); PG8_BAR; PG8_MMA(0, 0, At, B0); PG8_MMA(0, 1, At, B1); PG8_BAR; PG8_SCHED;
            PG8_LDA(At, 0, 1); PG8_STAGE(PG8_SB(0, 0), b2, voffB); PG8_STAGE(PG8_SB(0, 1), b2 + hstep, voffB); PG8_STAGE(PG8_SA(0, 0), a2, voffA);
            PG8_WAIT_V(8); PG8_WAIT_L(0); PG8_BAR; PG8_MMA(1, 0, At, B0); PG8_MMA(1, 1, At, B1); PG8_BAR; PG8_SCHED;
            PG8_LDB(B0, 1, 0); PG8_LDB(B1, 1, 1); PG8_SCHED; PG8_LDA(At, 1, 0); PG8_STAGE(PG8_SA(0, 1), a2 + hstep, voffA);
            PG8_WAIT_V(8); PG8_WAIT_L(0); PG8_BAR; PG8_MMA(0, 0, At, B0); PG8_MMA(0, 1, At, B1); PG8_BAR; PG8_SCHED;
            PG8_LDA(At, 1, 1); PG8_STAGE(PG8_SB(1, 0), b3, voffB); PG8_STAGE(PG8_SB(1, 1), b3 + hstep, voffB); PG8_STAGE(PG8_SA(1, 0), a3, voffA);
            PG8_WAIT_V(8); PG8_WAIT_L(0); PG8_BAR; PG8_MMA(1, 0, At, B0); PG8_MMA(1, 1, At, B1); PG8_BAR; PG8_SCHED;
            } else {
            PG8_LDB(B0, 0, 0); PG8_SCHED; PG8_LDA(At, 0, 0); PG8_STAGE(PG8_SA(1, 1), a1 + hstep, voffA);
            PG8_WAIT_L(8); PG8_BAR; PG8_WAIT_L(0); PG8_MMA(0, 0, At, B0); PG8_BAR; PG8_SCHED;
            PG8_LDB(B1, 0, 1); PG8_STAGE(PG8_SB(0, 0), b2, voffB);
            PG8_BAR; PG8_WAIT_L(0); PG8_MMA(0, 1, At, B1); PG8_BAR;
            PG8_LDA(At, 0, 1); PG8_STAGE(PG8_SA(0, 0), a2, voffA);
            PG8_BAR; PG8_WAIT_L(0); PG8_MMA(1, 0, At, B0); PG8_BAR; PG8_SCHED;
            PG8_STAGE(PG8_SB(0, 1), b2 + hstep, voffB);
            PG8_WAIT_V(6); PG8_BAR; PG8_MMA(1, 1, At, B1); PG8_BAR;
            PG8_LDB(B0, 1, 0); PG8_SCHED; PG8_LDA(At, 1, 0); PG8_STAGE(PG8_SA(0, 1), a2 + hstep, voffA);
            PG8_WAIT_L(8); PG8_BAR; PG8_WAIT_L(0); PG8_MMA(0, 0, At, B0); PG8_BAR; PG8_SCHED;
            PG8_LDB(B1, 1, 1); PG8_STAGE(PG8_SB(1, 0), b3, voffB);
            PG8_BAR; PG8_WAIT_L(0); PG8_MMA(0, 1, At, B1); PG8_BAR;
            PG8_LDA(At, 1, 1); PG8_STAGE(PG8_SA(1, 0), a3, voffA);
            PG8_BAR; PG8_WAIT_L(0); PG8_MMA(1, 0, At, B0); PG8_BAR; PG8_SCHED;
            PG8_STAGE(PG8_SB(1, 1), b3 + hstep, voffB);
            PG8_WAIT_V(6); PG8_BAR; PG8_MMA(1, 1, At, B1); PG8_BAR;
            }
        }
        if constexpr (ALIGN_EPI) { if (wr == 0) PG8_BAR; }
        if constexpr (!Epi::AFTER_DRAIN) { E(acc, cur, wr, wc, fr, fq); S.done(cur); }
        if (!has_next) break;
#pragma unroll
        for (int a = 0; a < 2; ++a)
#pragma unroll
            for (int b = 0; b < 2; ++b)
#pragma unroll
                for (int m = 0; m < 4; ++m)
#pragma unroll
                    for (int n = 0; n < 2; ++n) acc[a][b][m][n] = (f32x4){0.f, 0.f, 0.f, 0.f};
        cur = nxt; cA = nA; cB = nB; ++ui;
        if constexpr (ALIGN_EPI) { if (wr == 1) PG8_BAR; }
    }
    PG8_WAIT_V(0);
    if constexpr (!ALIGN_EPI) { if (wr == 0) PG8_BAR; }
    PG8_BAR;
    if constexpr (Epi::AFTER_DRAIN) { E.fused(acc, cur, wr, wc, fr, fq, lds, wid, lane); S.done(cur); }
#undef PG8_SA
#undef PG8_SB
#undef PG8_STAGE
#undef PG8_LDA
#undef PG8_LDB
#undef PG8_MMA
#undef PG8_WAIT_V
#undef PG8_WAIT_L
#undef PG8_BAR
#undef PG8_SCHED
}
}

typedef f32x4 AccT[2][2][4][2];
__device__ __forceinline__ u32x2 pk4(f32x4 v) { u32x2 w; w.x = cvt_pk_bf16(v[0], v[1]); w.y = cvt_pk_bf16(v[2], v[3]); return w; }
__device__ __forceinline__ f32x4 up4(u32x2 w) { return (f32x4){bf_lo(w.x), bf_hi(w.x), bf_lo(w.y), bf_hi(w.y)}; }

struct EpiIn {
    static constexpr bool PERM = true, AFTER_DRAIN = false;
    unsigned char* ws; float* out;
    __device__ __forceinline__ void operator()(const AccT& acc, const pg8::Unit& u, int wr, int wc, int fr, int fq) const {
        const int pn = u.pn; size_t off; int ldc = 512, cb, mode = 0, kv = 0; float scale = 1.f;
        if (pn < 2) { off = A_QA; cb = pn; mode = 1; scale = 0.125f * 1.4426950408889634f; }
        else if (pn < 4) { off = A_KA; cb = pn - 2; kv = 1; }
        else if (pn < 6) { off = A_VA; cb = pn - 4; kv = 2; }
        else if (pn < 8) { off = A_QB; cb = pn - 6; mode = 1; scale = 0.08838834764831845f; }
        else if (pn < 10) { off = A_KB; cb = pn - 8; }
        else if (pn < 14) { off = A_VB; cb = pn - 10; ldc = 1024; }
        else if (pn < 18) { off = A_RB; cb = pn - 14; ldc = 1024; mode = 2; }
        else if (pn < 22) { off = A_GA; cb = pn - 18; ldc = 1024; mode = 3; }
        else { off = A_GB; cb = pn - 22; ldc = 1024; mode = 3; }
        bf16_t* dst = (bf16_t*)(ws + off);
        const int col0 = cb * 256 + wc * 32 + 8 * fq, row0 = u.pm * 256 + wr * 64 + fr;
        const bool f32out = (kv != 0) && (u.pm >= 62);
        float* ob = nullptr;
        if (f32out) ob = (u.pm < 64) ? out + (kv == 1 ? O_KP : O_VP) - (size_t)15872 * 512 : out + (kv == 1 ? O_KS : O_VS) - (size_t)16384 * 512;
#pragma unroll
        for (int ai = 0; ai < 2; ++ai)
#pragma unroll
            for (int m = 0; m < 4; ++m) { const int row = row0 + ai * 128 + m * 16;
#pragma unroll
                for (int bj = 0; bj < 2; ++bj) { f32x4 v0 = acc[ai][bj][m][0], v1 = acc[ai][bj][m][1]; const int col = col0 + bj * 128;
                    if (f32out) { float* o = ob + (size_t)row * 512 + col; *(f32x4*)o = v0; *(f32x4*)(o + 4) = v1; }
                    if (mode == 1) { v0 = v0 * scale; v1 = v1 * scale; }
                    else if (mode == 2) { for (int j = 0; j < 4; ++j) { v0[j] = v0[j] * fast_sigmoid(v0[j]); v1[j] = v1[j] * fast_sigmoid(v1[j]); } }
                    else if (mode == 3) { for (int j = 0; j < 4; ++j) { v0[j] = fast_sigmoid(v0[j]); v1[j] = fast_sigmoid(v1[j]); } }
                    *(bf16x8*)(dst + (size_t)row * ldc + col) = pk8(v0, v1); }
                asm volatile("" ::: "memory"); }
    }
};
template <int MODE, bool DRYE = false> struct EpiN1024 {
    static constexpr bool PERM = false, AFTER_DRAIN = false;
    bf16_t* io; const bf16_t* g2; float* rowss; int row_base;
    __device__ __forceinline__ void operator()(const AccT& acc, const pg8::Unit& u, int wr, int wc, int fr, int fq) const {
        const int col0 = u.pn * 256 + wc * 32 + 4 * fq, row0 = row_base + u.pm * 256 + wr * 64 + fr;
#pragma unroll
        for (int ai = 0; ai < 2; ++ai)
#pragma unroll
            for (int m = 0; m < 4; ++m) { const int row = row0 + ai * 128 + m * 16; float ss = 0.f;
#pragma unroll
                for (int bj = 0; bj < 2; ++bj)
#pragma unroll
                    for (int n = 0; n < 2; ++n) { f32x4 v = acc[ai][bj][m][n]; const size_t idx = (size_t)row * 1024 + col0 + bj * 128 + n * 16;
                        if (MODE == 0) v = v * up4(*(const u32x2*)(io + idx));
                        else if (MODE == 1) v = up4(*(const u32x2*)(io + idx)) + up4(*(const u32x2*)(g2 + idx)) * v;
                        else ss += (v[0] * v[0] + v[1] * v[1]) + (v[2] * v[2] + v[3] * v[3]);
                        if (!DRYE || v[0] == 123.456f) *(u32x2*)(io + idx) = pk4(v); }
                if (MODE == 2 && !DRYE) { ss += __shfl_xor(ss, 16); ss += __shfl_xor(ss, 32); if (fq == 0) atomicAdd(rowss + row, ss); } }
    }
};
template <int MODE> using EpiN1024D = EpiN1024<MODE, true>;
struct EpiSwiglu {
    static constexpr bool PERM = true, AFTER_DRAIN = false;
    bf16_t* hid;
    __device__ __forceinline__ void operator()(const AccT& acc, const pg8::Unit& u, int wr, int wc, int fr, int fq) const {
        const int col0 = u.pn * 128 + wc * 32 + 8 * fq, row0 = u.pm * 256 + wr * 64 + fr;
#pragma unroll
        for (int ai = 0; ai < 2; ++ai)
#pragma unroll
            for (int m = 0; m < 4; ++m) { const int row = row0 + ai * 128 + m * 16; f32x4 v0, v1;
#pragma unroll
                for (int j = 0; j < 4; ++j) { const float g0 = acc[ai][0][m][0][j], g1 = acc[ai][0][m][1][j];
                    v0[j] = g0 * fast_sigmoid(g0) * acc[ai][1][m][0][j]; v1[j] = g1 * fast_sigmoid(g1) * acc[ai][1][m][1][j]; }
                *(bf16x8*)(hid + (size_t)row * DFF + col0) = pk8(v0, v1); }
    }
};

struct Args { const float* in[20]; float* out; unsigned char* ws; int ph_lo, ph_hi; };
enum { I_XP = 0, I_XS, I_CK, I_CV, I_ST, I_NMPRE, I_NMPOST, I_NFPRE, I_NFPOST, I_WIN, I_WUP, I_BDEC, I_RELB, I_GNORM, I_WPA, I_WPB, I_WOUT, I_WG, I_WU, I_WD };
constexpr int LDS_BYTES = 147456;

__device__ __forceinline__ void p0_convert(const Args& a, LAS float* scr, int gw, int NGW, int lane) {
    constexpr int I_IN = 104 * 16, I_PA = 16 * 8, I_PB = 16 * 16, I_OUT = 16 * 16, I_GU = 88 * 16, I_DN = 16 * 44, TOTAL = I_IN + I_PA + I_PB + I_OUT + I_GU + I_DN;
    for (int it = gw; it < TOTAL; it += NGW) {
        int r = it, kind, K; size_t dsto;
        if (r < I_IN) { kind = 0; K = 1024; dsto = WS_WIN; }
        else if ((r -= I_IN) < I_PA) { kind = 1; K = 512; dsto = WS_WPA; }
        else if ((r -= I_PA) < I_PB) { kind = 2; K = 1024; dsto = WS_WPB; }
        else if ((r -= I_PB) < I_OUT) { kind = 3; K = 1024; dsto = WS_WOUT; }
        else if ((r -= I_OUT) < I_GU) { kind = 4; K = 1024; dsto = WS_WGU; }
        else { r -= I_GU; kind = 5; K = 2816; dsto = WS_WDN; }
        const int ktiles = K >> 6, n0 = (r / ktiles) * 64, k0 = (r % ktiles) * 64, n = n0 + lane;
        const float* sp; int srcN;
        if (kind == 0) { sp = a.in[I_WIN] + (n < 4608 ? n : n + 16); srcN = DIN; }
        else if (kind == 1) { sp = a.in[I_WPA] + n; srcN = 1024; }
        else if (kind == 2) { sp = a.in[I_WPB] + n; srcN = 1024; }
        else if (kind == 3) { sp = a.in[I_WOUT] + n; srcN = 1024; }
        else if (kind == 4) { const int pn = n >> 8, rr = n & 255; sp = ((rr < 128) ? a.in[I_WG] : a.in[I_WU]) + 128 * pn + (rr & 127); srcN = DFF; }
        else { sp = a.in[I_WD] + n; srcN = 1024; }
        sp += (size_t)k0 * srcN;
        float tmp[64];
#pragma unroll
        for (int i = 0; i < 64; ++i) tmp[i] = sp[(size_t)i * srcN];
#pragma unroll
        for (int i = 0; i < 64; ++i) scr[lane * 65 + i] = tmp[i];
        wave_lds_sync();
        unsigned* dst = (unsigned*)(a.ws + dsto) + ((size_t)n0 * K + k0) / 2 + (lane & 31);
#pragma unroll 8
        for (int j = 0; j < 32; ++j) { const int row = 2 * j + (lane >> 5), kk = (lane & 31) * 2; dst[(size_t)row * (K / 2)] = cvt_pk_bf16(scr[row * 65 + kk], scr[row * 65 + kk + 1]); }
        wave_lds_sync();
    }
}
__device__ __forceinline__ const float* xrow_ptr(const Args& a, int row) { return row < MP ? a.in[I_XP] + (size_t)row * DM : a.in[I_XS] + (size_t)(row - MP) * DM; }
__device__ __forceinline__ void p0_rows(const Args& a, LAS unsigned char* lds, int gw, int NGW, int wave, int lane, int tid) {
    LAS float* WdL = (LAS float*)lds;
    LAS float* hrow = (LAS float*)(lds + 4 * 4112 * 4) + wave * 1056;
    for (int idx = tid; idx < 1024 * 16; idx += 512) { const int k = idx >> 4, j = idx & 15; WdL[(k >> 8) * 4112 + (k & 255) * 16 + j] = a.in[I_WIN][(size_t)k * DIN + 4608 + j]; }
    __syncthreads();
    bf16_t* H = (bf16_t*)((unsigned char*)a.out + Y_H); float* DLR = (float*)((unsigned char*)a.out + Y_DLR);
    const f32x4* gp = (const f32x4*)a.in[I_NMPRE] + lane; f32x4 g[4];
#pragma unroll
    for (int j = 0; j < 4; ++j) g[j] = gp[64 * j];
    for (int row = gw; row < MT; row += NGW) {
        const f32x4* xr = (const f32x4*)xrow_ptr(a, row) + lane; f32x4 v[4]; float s = 0.f;
#pragma unroll
        for (int j = 0; j < 4; ++j) { v[j] = xr[64 * j]; s += (v[j][0] * v[j][0] + v[j][1] * v[j][1]) + (v[j][2] * v[j][2] + v[j][3] * v[j][3]); }
        const float rstd = rsqrtf(wave_sum(s) * (1.f / DM) + EPS);
        u32x2* ho = (u32x2*)(H + (size_t)row * DM) + lane;
#pragma unroll
        for (int j = 0; j < 4; ++j) { v[j] = v[j] * rstd * g[j]; ho[64 * j] = pk4(v[j]); *(LAS f32x4*)(hrow + j * 264 + 4 * lane) = v[j]; }
        wave_lds_sync();
        const int jj = lane & 15, p = lane >> 4; float acc = 0.f;
        const LAS float* hp = hrow + p * 264; const LAS float* wp = WdL + p * 4112 + jj;
#pragma unroll 8
        for (int kk = 0; kk < 256; ++kk) acc += hp[kk] * wp[kk * 16];
        acc += __shfl_xor(acc, 16); acc += __shfl_xor(acc, 32);
        if (lane < 16) DLR[(size_t)row * 16 + jj] = acc;
        wave_lds_sync();
    }
}

__device__ __forceinline__ void row_pass1(const Args& a, int row_lo, int row_hi, int gw, int NGW, int lane) {
    const bf16_t* Y = (const bf16_t*)(a.ws + A_GB); bf16_t* A2 = (bf16_t*)(a.ws + A_RB); const float* rss = (const float*)(a.ws + WS_RSS1); float* XO = a.out + O_Y;
    f32x4 gp[4], gq[4];
#pragma unroll
    for (int j = 0; j < 4; ++j) { gp[j] = ((const f32x4*)a.in[I_NMPOST])[lane + 64 * j]; gq[j] = ((const f32x4*)a.in[I_NFPRE])[lane + 64 * j]; }
    for (int r0 = row_lo + 2 * gw; r0 < row_hi; r0 += 2 * NGW) {
        f32x4 xv[2][4]; u32x2 yv[2][4]; float rs[2];
#pragma unroll
        for (int r = 0; r < 2; ++r) { const int row = (r0 + r < row_hi) ? r0 + r : r0; rs[r] = rss[row];
            const f32x4* xr = (const f32x4*)xrow_ptr(a, row) + lane; const u32x2* yr = (const u32x2*)(Y + (size_t)row * DM) + lane;
#pragma unroll
            for (int j = 0; j < 4; ++j) { xv[r][j] = xr[64 * j]; yv[r][j] = yr[64 * j]; } }
#pragma unroll
        for (int r = 0; r < 2; ++r) { const int row = r0 + r; if (row >= row_hi) break;
            const float rstd = rsqrtf(rs[r] * (1.f / DM) + EPS); f32x4 v[4]; float s = 0.f;
#pragma unroll
            for (int j = 0; j < 4; ++j) { v[j] = xv[r][j] + up4(yv[r][j]) * rstd * gp[j]; s += (v[j][0] * v[j][0] + v[j][1] * v[j][1]) + (v[j][2] * v[j][2] + v[j][3] * v[j][3]); }
            const float rstd2 = rsqrtf(wave_sum(s) * (1.f / DM) + EPS);
            f32x4* xo = (f32x4*)(XO + (size_t)row * DM) + lane; u32x2* ao = (u32x2*)(A2 + (size_t)row * DM) + lane;
#pragma unroll
            for (int j = 0; j < 4; ++j) { xo[64 * j] = v[j]; ao[64 * j] = pk4(v[j] * rstd2 * gq[j]); } }
    }
}
template <bool DRYR = false>
__device__ __forceinline__ void row_pass2(const Args& a, int row_lo, int row_hi, int gw, int NGW, int lane) {
    const bf16_t* F = (const bf16_t*)(a.ws + A_GA); const float* rss = (const float*)(a.ws + WS_RSS2); float* XO = a.out + O_Y;
    f32x4 gp[4];
#pragma unroll
    for (int j = 0; j < 4; ++j) gp[j] = ((const f32x4*)a.in[I_NFPOST])[lane + 64 * j];
    for (int r0 = row_lo + 2 * gw; r0 < row_hi; r0 += 2 * NGW) {
        f32x4 xv[2][4]; u32x2 fv[2][4]; float rs[2];
#pragma unroll
        for (int r = 0; r < 2; ++r) { const int row = (r0 + r < row_hi) ? r0 + r : r0; rs[r] = rss[row];
            const f32x4* xo = (const f32x4*)(XO + (size_t)row * DM) + lane; const u32x2* fr = (const u32x2*)(F + (size_t)row * DM) + lane;
#pragma unroll
            for (int j = 0; j < 4; ++j) { xv[r][j] = xo[64 * j]; fv[r][j] = fr[64 * j]; } }
#pragma unroll
        for (int r = 0; r < 2; ++r) { const int row = r0 + r; if (row >= row_hi) break;
            const float rstd = rsqrtf(rs[r] * (1.f / DM) + EPS); f32x4* xo = (f32x4*)(XO + (size_t)row * DM) + lane;
#pragma unroll
            for (int j = 0; j < 4; ++j) { const f32x4 o = xv[r][j] + up4(fv[r][j]) * rstd * gp[j]; if (!DRYR || o[0] == 123.456f) xo[64 * j] = o; } }
    }
}

constexpr int VT_PITCH = 72;
__device__ __forceinline__ bf16x8 ld8_f32(const float* p) { const f32x4 a = *(const f32x4*)p, b = *(const f32x4*)(p + 4); return pk8(a, b); }
template <bool SAMPLE>
__device__ __forceinline__ void attn_load(const Args& a, int idx, int h, int kt, int lane, bf16x8 (&ka)[4][2], bf16x8 (&vv)[8]) {
    const int fr = lane & 15, kq = lane >> 4;
    if (SAMPLE && kt < 8) {
        const size_t base = ((size_t)(idx * 512 + 64 * kt)) * 512 + h * 64; const float* ck = a.in[I_CK] + base; const float* cv = a.in[I_CV] + base;
#pragma unroll
        for (int mt = 0; mt < 4; ++mt)
#pragma unroll
            for (int ks = 0; ks < 2; ++ks) ka[mt][ks] = ld8_f32(ck + (size_t)(16 * mt + fr) * 512 + 32 * ks + 8 * kq);
#pragma unroll
        for (int g = 0; g < 8; ++g) vv[g] = ld8_f32(cv + (size_t)(8 * g + (lane >> 3)) * 512 + 8 * (lane & 7));
    } else {
        const bf16_t* KA = (const bf16_t*)(a.ws + A_KA); const bf16_t* VA = (const bf16_t*)(a.ws + A_VA);
        const int krow0 = SAMPLE ? MP + idx * 32 : (idx - 8 + kt) * 64, nvalid = SAMPLE ? 32 : 64;
#pragma unroll
        for (int mt = 0; mt < 4; ++mt) { int key = 16 * mt + fr; if (key >= nvalid) key = nvalid - 1;
#pragma unroll
            for (int ks = 0; ks < 2; ++ks) ka[mt][ks] = *(const bf16x8*)(KA + (size_t)(krow0 + key) * 512 + h * 64 + 32 * ks + 8 * kq); }
#pragma unroll
        for (int g = 0; g < 8; ++g) { int key = 8 * g + (lane >> 3); if (key >= nvalid) key = nvalid - 1;
            vv[g] = *(const bf16x8*)(VA + (size_t)(krow0 + key) * 512 + h * 64 + 8 * (lane & 7)); }
    }
}
__device__ __forceinline__ void attn_load_kraw(const Args& a, int idx, int h, int kt, int half, int lane, f32x4 (&kr)[8]) {
    const int fr = lane & 15, kq = lane >> 4; const float* ck = a.in[I_CK] + ((size_t)(idx * 512 + 64 * kt)) * 512 + h * 64;
#pragma unroll
    for (int m = 0; m < 2; ++m)
#pragma unroll
        for (int ks = 0; ks < 2; ++ks) { const float* p = ck + (size_t)(16 * (2 * half + m) + fr) * 512 + 32 * ks + 8 * kq; kr[(m * 2 + ks) * 2] = *(const f32x4*)p; kr[(m * 2 + ks) * 2 + 1] = *(const f32x4*)(p + 4); }
}
__device__ __forceinline__ void attn_load_vraw(const Args& a, int idx, int h, int kt, int half, int lane, f32x4 (&vr)[8]) {
    const float* cv = a.in[I_CV] + ((size_t)(idx * 512 + 64 * kt)) * 512 + h * 64;
#pragma unroll
    for (int g = 0; g < 4; ++g) { const float* p = cv + (size_t)(8 * (4 * half + g) + (lane >> 3)) * 512 + 8 * (lane & 7); vr[2 * g] = *(const f32x4*)p; vr[2 * g + 1] = *(const f32x4*)(p + 4); }
}
#define PIN8(x) asm volatile("" : "+v"(x[0]), "+v"(x[1]), "+v"(x[2]), "+v"(x[3]), "+v"(x[4]), "+v"(x[5]), "+v"(x[6]), "+v"(x[7]))
typedef short v4i16_t __attribute__((ext_vector_type(4)));
__device__ __forceinline__ void attn_put_v(LAS bf16_t* vR, const bf16x8 (&vv)[8], int lane) {
#pragma unroll
    for (int g = 0; g < 8; ++g) *(LAS bf16x8*)(vR + (8 * g + (lane >> 3)) * VT_PITCH + 8 * (lane & 7)) = vv[g];
}
__device__ __forceinline__ u32x2 tr_read(const LAS bf16_t* p) { return __builtin_bit_cast(u32x2, __builtin_amdgcn_ds_read_tr16_b64_v4i16((LAS v4i16_t*)p)); }
template <int NQ, bool SAMPLE, bool dry = false>
__device__ __forceinline__ void attn_unit(const Args& a, int idx, int h, int qoff, LAS bf16_t* vT, const LAS float* biasL, int lane) {
    const int fr = lane & 15, kq = lane >> 4;
    bf16_t* QA = (bf16_t*)(a.ws + A_QA);
    const int qrow0 = SAMPLE ? MP + idx * 32 : idx * 64 + qoff;
    bf16x8 bq[NQ][2];
#pragma unroll
    for (int nt = 0; nt < NQ; ++nt)
#pragma unroll
        for (int ks = 0; ks < 2; ++ks) bq[nt][ks] = *(const bf16x8*)(QA + (size_t)(qrow0 + 16 * nt + fr) * 512 + h * 64 + 32 * ks + 8 * kq);
    f32x4 o[4][NQ]; float mrun[NQ], lrun[NQ];
#pragma unroll
    for (int nt = 0; nt < NQ; ++nt) { mrun[nt] = -1e30f; lrun[nt] = 0.f;
#pragma unroll
        for (int dt = 0; dt < 4; ++dt) o[dt][nt] = (f32x4){0.f, 0.f, 0.f, 0.f}; }
    const float bias_far = biasL[256];
    int kt = SAMPLE ? 0 : (idx < 8 ? 8 - idx : 0);
    bf16x8 ka[4][2];
    if (!SAMPLE) { bf16x8 vv[8]; attn_load<SAMPLE>(a, idx, h, kt, lane, ka, vv); attn_put_v(vT, vv, lane); }
#pragma unroll 1
    for (; kt < 9; ++kt) {
        bf16x8 vvN[8]; f32x4 vr[8];
        if (SAMPLE) {
            if (kt < 8) {
#pragma unroll
                for (int hf = 0; hf < 2; ++hf) { f32x4 kr[8]; attn_load_kraw(a, idx, h, kt, hf, lane, kr); PIN8(kr);
#pragma unroll
                    for (int j = 0; j < 4; ++j) ka[2 * hf + (j >> 1)][j & 1] = pk8(kr[2 * j], kr[2 * j + 1]); } }
            else attn_load<true>(a, idx, h, 8, lane, ka, vvN);
        }
        const int nvalid = (SAMPLE && kt == 8) ? 32 : 64;
        f32x4 s[4][NQ];
#pragma unroll
        for (int mt = 0; mt < 4; ++mt)
#pragma unroll
            for (int nt = 0; nt < NQ; ++nt) { f32x4 z = (f32x4){0.f, 0.f, 0.f, 0.f}; z = MFMA16(ka[mt][0], bq[nt][0], z); s[mt][nt] = MFMA16(ka[mt][1], bq[nt][1], z); }
        if (!SAMPLE && kt < 8) attn_load<false>(a, idx, h, kt + 1, lane, ka, vvN);
        if (SAMPLE && kt < 8) attn_load_vraw(a, idx, h, kt, 0, lane, vr);
        const int dbase = 64 * (8 - kt);
#pragma unroll
        for (int mt = 0; mt < 4; ++mt)
#pragma unroll
            for (int nt = 0; nt < NQ; ++nt)
#pragma unroll
                for (int i = 0; i < 4; ++i) { const int key = 16 * mt + 4 * kq + i, q = qoff + 16 * nt + fr; float bv = bias_far;
                    if (kt >= 6) { int d = q - key + dbase; d = d < -128 ? -128 : (d > 128 ? 128 : d); bv = biasL[d + 128]; }
                    float sv = s[mt][nt][i] + bv; if (SAMPLE && key >= nvalid) sv = -1e30f; s[mt][nt][i] = sv; }
        bf16x8 pb[NQ][2];
#pragma unroll
        for (int nt = 0; nt < NQ; ++nt) {
            float mx = -1e30f;
#pragma unroll
            for (int mt = 0; mt < 4; ++mt) mx = fmaxf(mx, fmaxf(fmaxf(s[mt][nt][0], s[mt][nt][1]), fmaxf(s[mt][nt][2], s[mt][nt][3])));
            mx = fmaxf(mx, __shfl_xor(mx, 16)); mx = fmaxf(mx, __shfl_xor(mx, 32));
            const float mnew = fmaxf(mrun[nt], mx), sc = __builtin_amdgcn_exp2f(mrun[nt] - mnew); mrun[nt] = mnew; lrun[nt] *= sc;
#pragma unroll
            for (int dt = 0; dt < 4; ++dt) o[dt][nt] = o[dt][nt] * sc;
            const float mcur = mnew; float ls = 0.f;
#pragma unroll
            for (int mt = 0; mt < 4; ++mt)
#pragma unroll
                for (int i = 0; i < 4; ++i) { const float p = __builtin_amdgcn_exp2f(s[mt][nt][i] - mcur); s[mt][nt][i] = p; ls += p; }
            lrun[nt] += ls;
            pb[nt][0] = pk8(s[0][nt], s[1][nt]); pb[nt][1] = pk8(s[2][nt], s[3][nt]);
        }
        if (SAMPLE) {
            if (kt < 8) { PIN8(vr);
#pragma unroll
                for (int g = 0; g < 4; ++g) *(LAS bf16x8*)(vT + (8 * g + (lane >> 3)) * VT_PITCH + 8 * (lane & 7)) = pk8(vr[2 * g], vr[2 * g + 1]);
                attn_load_vraw(a, idx, h, kt, 1, lane, vr); PIN8(vr);
#pragma unroll
                for (int g = 0; g < 4; ++g) *(LAS bf16x8*)(vT + (8 * (4 + g) + (lane >> 3)) * VT_PITCH + 8 * (lane & 7)) = pk8(vr[2 * g], vr[2 * g + 1]); }
            else attn_put_v(vT, vvN, lane); }
        wave_lds_sync();
#pragma unroll
        for (int ks = 0; ks < 2; ++ks)
#pragma unroll
            for (int dt = 0; dt < 4; ++dt) { const LAS bf16_t* vp = vT + (32 * ks + 4 * kq + (fr >> 2)) * VT_PITCH + 16 * dt + 4 * (fr & 3);
                const bf16x8 va = mk8(tr_read(vp), tr_read(vp + 16 * VT_PITCH));
#pragma unroll
                for (int nt = 0; nt < NQ; ++nt) o[dt][nt] = MFMA16(va, pb[nt][ks], o[dt][nt]);
                if (dt & 1) asm volatile("" ::: "memory"); }
        wave_lds_sync();
        if (!SAMPLE && kt < 8) attn_put_v(vT, vvN, lane);
    }
#pragma unroll
    for (int nt = 0; nt < NQ; ++nt) { float l = lrun[nt]; l += __shfl_xor(l, 16); l += __shfl_xor(l, 32); const float inv = 1.f / l;
        bf16_t* op = QA + (size_t)(qrow0 + 16 * nt + fr) * 512 + h * 64 + 4 * kq;
#pragma unroll
        for (int dt = 0; dt < 4; ++dt) if (!dry) *(u32x2*)(op + 16 * dt) = pk4(o[dt][nt] * inv); }
}

constexpr int QE_P = 136, TT_P = 72;
constexpr int G_QE = 0, G_KE = G_QE + 64 * QE_P * 2, G_KLT = G_KE + 64 * QE_P * 2, G_VT = G_KLT + 128 * TT_P * 2, G_ATT = G_VT + 256 * TT_P * 2,
              G_PSUM = G_ATT + 64 * TT_P * 2, G_BLAST = G_PSUM + 2048, G_DVEC = G_BLAST + 512, G_RED = G_DVEC + 512, G_END = G_RED + 2048;
static_assert(G_END <= 131072, "gla lds");
template <int MODE, bool dry = false>
__device__ __forceinline__ void gla_unit(const Args& a, LAS unsigned char* lds, int idx, int h, int tid) {
    constexpr int C = (MODE == 2) ? 32 : 64, TPT = C / 4, NTL = C / 16, KS_T = C / 32;
    const int lane = tid & 63, wave = __builtin_amdgcn_readfirstlane(tid >> 6), fr = lane & 15, kq = lane >> 4;
    LAS bf16_t* qe = (LAS bf16_t*)(lds + G_QE); LAS bf16_t* ke = (LAS bf16_t*)(lds + G_KE); LAS bf16_t* klT = (LAS bf16_t*)(lds + G_KLT);
    LAS bf16_t* vT = (LAS bf16_t*)(lds + G_VT); LAS bf16_t* att = (LAS bf16_t*)(lds + G_ATT);
    LAS float* psum = (LAS float*)(lds + G_PSUM); LAS float* blast = (LAS float*)(lds + G_BLAST); LAS float* dvec = (LAS float*)(lds + G_DVEC); LAS float* red = (LAS float*)(lds + G_RED);
    const int row0 = (MODE == 2) ? MP + idx * 32 : idx * 64;
    const bf16_t* QB = (const bf16_t*)(a.ws + A_QB); const bf16_t* KB = (const bf16_t*)(a.ws + A_KB); bf16_t* VB = (bf16_t*)(a.ws + A_VB); const bf16_t* RB = (const bf16_t*)(a.ws + A_RB);
    const float* DLR = (const float*)((const unsigned char*)a.out + Y_DLR);
    bf16_t* US = (bf16_t*)((unsigned char*)a.out + Y_US) + (size_t)(idx * 4 + h) * 32768;
    bf16x8 vraw[C / 16];
    { const int t = tid & (C - 1), g0 = tid / C;
#pragma unroll
        for (int gi = 0; gi < C / 16; ++gi) vraw[gi] = *(const bf16x8*)(VB + (size_t)(row0 + t) * 1024 + h * 256 + 8 * (g0 * (C / 16) + gi)); }
    bf16x8 sraw[4][2];
    if (MODE == 1) {
#pragma unroll
        for (int ks = 0; ks < 4; ++ks)
#pragma unroll
            for (int m = 0; m < 2; ++m) sraw[ks][m] = *(const bf16x8*)(US + (size_t)(32 * wave + 16 * m + fr) * 128 + 32 * ks + 8 * kq); }
    {
        const int dk = tid & 127, tq = wave >> 1, col = h * 128 + dk;
        float wu[16];
#pragma unroll
        for (int j = 0; j < 16; ++j) wu[j] = a.in[I_WUP][j * 512 + col];
        const float bd = a.in[I_BDEC][col];
        bf16_t kraw[TPT], qraw[TPT];
#pragma unroll
        for (int i = 0; i < TPT; ++i) { const size_t gi = (size_t)(row0 + tq * TPT + i) * 512 + col; kraw[i] = KB[gi]; qraw[i] = (MODE != 0) ? QB[gi] : (bf16_t)0; }
        float bl[TPT]; float run = 0.f;
#pragma unroll
        for (int i = 0; i < TPT; ++i) { const f32x4* dp = (const f32x4*)(DLR + (size_t)(row0 + tq * TPT + i) * 16); float z = bd;
#pragma unroll
            for (int j4 = 0; j4 < 4; ++j4) { const f32x4 d = dp[j4]; z += d[0] * wu[4 * j4] + d[1] * wu[4 * j4 + 1] + d[2] * wu[4 * j4 + 2] + d[3] * wu[4 * j4 + 3]; }
            const float la = (fminf(z, 0.f) - __logf(1.f + __expf(-fabsf(z)))) * (1.f / 16.f);
            run += la; bl[i] = run; }
        psum[tq * 128 + dk] = run;
        __syncthreads();
        float off = 0.f, tot = 0.f;
#pragma unroll
        for (int p = 0; p < 4; ++p) { const float v = psum[p * 128 + dk]; tot += v; if (p < tq) off += v; }
        if (tq == 0) { dvec[dk] = __expf(tot); if (MODE == 0) ((float*)((unsigned char*)a.out + Y_DEC))[(size_t)(idx * 4 + h) * 128 + dk] = __expf(tot); }
#pragma unroll
        for (int i = 0; i < TPT; ++i) { const int t = tq * TPT + i; const float b = bl[i] + off;
            const float kv = bf2f(kraw[i]);
            if (MODE != 0) { const float qv = bf2f(qraw[i]); qe[t * QE_P + dk] = f2bf(qv * __expf(b)); ke[t * QE_P + dk] = f2bf(kv * __expf(-b)); }
            if (MODE != 1) klT[dk * TT_P + t] = f2bf(kv * __expf(tot - b)); }
    }
    {
        const int t = tid & (C - 1), g0 = tid / C;
#pragma unroll
        for (int gi = 0; gi < C / 16; ++gi) { const int g = g0 * (C / 16) + gi; const bf16x8 vv = vraw[gi];
#pragma unroll
            for (int j = 0; j < 8; ++j) vT[(8 * g + j) * TT_P + t] = (bf16_t)vv[j]; }
    }
    __syncthreads();
    if (MODE != 0) {
        for (int id = wave; id < NTL * NTL; id += 8) { const int ms = id / NTL, nt = id % NTL; f32x4 acc = (f32x4){0.f, 0.f, 0.f, 0.f};
#pragma unroll
            for (int ks = 0; ks < 4; ++ks) acc = MFMA16(*(const LAS bf16x8*)(ke + (16 * ms + fr) * QE_P + 32 * ks + 8 * kq), *(const LAS bf16x8*)(qe + (16 * nt + fr) * QE_P + 32 * ks + 8 * kq), acc);
            const int t = 16 * nt + fr;
#pragma unroll
            for (int i = 0; i < 4; ++i) if (16 * ms + 4 * kq + i > t) acc[i] = 0.f;
            *(LAS u32x2*)(att + t * TT_P + 16 * ms + 4 * kq) = pk4(acc); }
    }
    if (MODE != 1) {
        f32x4 u[8][2];
#pragma unroll
        for (int mt = 0; mt < 8; ++mt)
#pragma unroll
            for (int n = 0; n < 2; ++n) u[mt][n] = (f32x4){0.f, 0.f, 0.f, 0.f};
#pragma unroll
        for (int ks = 0; ks < KS_T; ++ks) { bf16x8 bv[2];
#pragma unroll
            for (int n = 0; n < 2; ++n) bv[n] = *(const LAS bf16x8*)(vT + (32 * wave + 16 * n + fr) * TT_P + 32 * ks + 8 * kq);
#pragma unroll
            for (int mt = 0; mt < 8; ++mt) { const bf16x8 av = *(const LAS bf16x8*)(klT + (16 * mt + fr) * TT_P + 32 * ks + 8 * kq);
#pragma unroll
                for (int n = 0; n < 2; ++n) u[mt][n] = MFMA16(av, bv[n], u[mt][n]); } }
        if (MODE == 0) {
#pragma unroll
            for (int mt = 0; mt < 8; ++mt)
#pragma unroll
                for (int n = 0; n < 2; ++n) *(u32x2*)(US + (size_t)(32 * wave + 16 * n + fr) * 128 + 16 * mt + 4 * kq) = pk4(u[mt][n]);
        } else {
            const float* S0 = a.in[I_ST] + (size_t)(idx * 4 + h) * 32768; float* S1 = a.out + O_SS + (size_t)(idx * 4 + h) * 32768;
#pragma unroll
            for (int mt = 0; mt < 8; ++mt)
#pragma unroll
                for (int n = 0; n < 2; ++n)
#pragma unroll
                    for (int i = 0; i < 4; ++i) { const int dk = 16 * mt + 4 * kq + i, dv = 32 * wave + 16 * n + fr; S1[dk * 256 + dv] = dvec[dk] * S0[dk * 256 + dv] + u[mt][n][i]; }
        }
    }
    if (MODE != 0) {
        __syncthreads();
        f32x4 o[2][NTL];
#pragma unroll
        for (int m = 0; m < 2; ++m)
#pragma unroll
            for (int nt = 0; nt < NTL; ++nt) o[m][nt] = (f32x4){0.f, 0.f, 0.f, 0.f};
#pragma unroll
        for (int ks = 0; ks < KS_T; ++ks) { bf16x8 av[2];
#pragma unroll
            for (int m = 0; m < 2; ++m) av[m] = *(const LAS bf16x8*)(vT + (32 * wave + 16 * m + fr) * TT_P + 32 * ks + 8 * kq);
#pragma unroll
            for (int nt = 0; nt < NTL; ++nt) { const bf16x8 bv = *(const LAS bf16x8*)(att + (16 * nt + fr) * TT_P + 32 * ks + 8 * kq);
#pragma unroll
                for (int m = 0; m < 2; ++m) o[m][nt] = MFMA16(av[m], bv, o[m][nt]); } }
#pragma unroll
        for (int ks = 0; ks < 4; ++ks) { bf16x8 av[2];
#pragma unroll
            for (int m = 0; m < 2; ++m) { const int dv = 32 * wave + 16 * m + fr;
                if (MODE == 1) av[m] = sraw[ks][m];
                else { const float* sp = a.in[I_ST] + (size_t)(idx * 4 + h) * 32768 + (size_t)(32 * ks + 8 * kq) * 256 + dv; f32x4 x0, x1;
#pragma unroll
                    for (int j = 0; j < 4; ++j) { x0[j] = sp[j * 256]; x1[j] = sp[(j + 4) * 256]; }
                    av[m] = pk8(x0, x1); } }
#pragma unroll
            for (int nt = 0; nt < NTL; ++nt) { const bf16x8 bv = *(const LAS bf16x8*)(qe + (16 * nt + fr) * QE_P + 32 * ks + 8 * kq);
#pragma unroll
                for (int m = 0; m < 2; ++m) o[m][nt] = MFMA16(av[m], bv, o[m][nt]); } }
#pragma unroll
        for (int nt = 0; nt < NTL; ++nt) { float ss = 0.f;
#pragma unroll
            for (int m = 0; m < 2; ++m) ss += (o[m][nt][0] * o[m][nt][0] + o[m][nt][1] * o[m][nt][1]) + (o[m][nt][2] * o[m][nt][2] + o[m][nt][3] * o[m][nt][3]);
            ss += __shfl_xor(ss, 16); ss += __shfl_xor(ss, 32);
            if (kq == 0) red[wave * 64 + 16 * nt + fr] = ss; }
        __syncthreads();
#pragma unroll
        for (int nt = 0; nt < NTL; ++nt) { const int t = 16 * nt + fr; float tot = 0.f;
#pragma unroll
            for (int w = 0; w < 8; ++w) tot += red[w * 64 + t];
            const float rstd = rsqrtf(tot * (1.f / 256.f) + EPS);
#pragma unroll
            for (int m = 0; m < 2; ++m) { const int dv = 32 * wave + 16 * m + 4 * kq; const size_t gi = (size_t)(row0 + t) * 1024 + h * 256 + dv;
                const f32x4 gn = *(const f32x4*)(a.in[I_GNORM] + dv); const f32x4 rb = up4(*(const u32x2*)(RB + gi));
                if (!dry) *(u32x2*)(VB + gi) = pk4(o[m][nt] * rstd * gn * rb); } }
    }
    __syncthreads();
}

template <bool DRYS = false>
__device__ __forceinline__ void scan_phase(const Args& a, int tid, int nthr, int blk, int nblk) {
    u32x2* US64 = (u32x2*)((unsigned char*)a.out + Y_US); const f32x4* DEC = (const f32x4*)((const unsigned char*)a.out + Y_DEC);
    const int per = (32768 + nblk - 1) / nblk;
    if (tid >= nthr) return;
    for (int q = tid; q < per; q += nthr) {
    const int p = blk * per + q; if (p >= 32768) break;
    const int hh = p >> 13, dv = (p >> 5) & 255, dq = p & 31; f32x4 st = (f32x4){0.f, 0.f, 0.f, 0.f};
    u32x2* up = US64 + (size_t)hh * 8192 + dv * 32 + dq; const f32x4* dp = DEC + hh * 32 + dq;
    for (int c0 = 0; c0 < 256; c0 += 8) { u32x2 u[8]; f32x4 d[8];
#pragma unroll
        for (int j = 0; j < 8; ++j) { u[j] = up[(size_t)(c0 + j) * 32768]; d[j] = dp[(c0 + j) * 128]; }
#pragma unroll
        for (int j = 0; j < 8; ++j) { if (!DRYS || st[0] == 123.456f) up[(size_t)(c0 + j) * 32768] = pk4(st); st = d[j] * st + up4(u[j]); } }
    float* so = a.out + O_SP + (size_t)(hh * 128 + 4 * dq) * 256 + dv;
    if (!DRYS || st[0] == 123.456f) { so[0] = st[0]; so[256] = st[1]; so[512] = st[2]; so[768] = st[3]; }
    }
}

#define XB_TMO      128
#define XB_XCNT(j)  (256  + 64 * (j))
#define XB_XSUB(j)  (1280 + 64 * (j))
#define XB_XGEN(j)  (2304 + 64 * (j))
#define XB_TOP      3328
#define XB_TOPGEN   3392
#define XCD_BAR_WORDS 3456
#define XB_SPIN_CAP (1u << 18)

__device__ __forceinline__ unsigned xb_ld(unsigned* p)              { return __hip_atomic_load(p, __ATOMIC_RELAXED, __HIP_MEMORY_SCOPE_AGENT); }
__device__ __forceinline__ unsigned xb_add(unsigned* p, unsigned v) { return __hip_atomic_fetch_add(p, v, __ATOMIC_RELAXED, __HIP_MEMORY_SCOPE_AGENT); }
__device__ __forceinline__ unsigned xb_xcc_id() { return (unsigned)__builtin_amdgcn_s_getreg((3 << 11) | 20) & 0xFu; }
#define XB_SPIN(cond, bar) do { unsigned _sp = 0; while (cond) { __builtin_amdgcn_s_sleep(1); \
    if ((++_sp & 255u) == 0u) { if (xb_ld(&(bar)[XB_TMO])) break; if (_sp > XB_SPIN_CAP) { atomicAdd(&(bar)[XB_TMO], 1u); break; } } } } while (0)

struct XcdBarrier {
    unsigned* bar; unsigned x;
    volatile LAS unsigned* st;
};

__device__ __forceinline__ XcdBarrier xcd_barrier_post(unsigned* bar, volatile LAS unsigned* st) {
    XcdBarrier b; b.bar = bar; b.x = xb_xcc_id(); b.st = st;
    if (threadIdx.x == 0) (void)xb_add(&bar[XB_XCNT(b.x)], 1u);
    return b;
}
__device__ __forceinline__ void xcd_barrier_complete(unsigned* bar, unsigned x, unsigned& nloc, unsigned& nx) {
    const unsigned G = gridDim.x * gridDim.y * gridDim.z;
    unsigned sum, cnt, mine, sp = 0u;
    for (;;) {
        sum = 0u; cnt = 0u; mine = 0u;
#pragma unroll
        for (unsigned j = 0; j < 16; ++j) { const unsigned c = xb_ld(&bar[XB_XCNT(j)]); sum += c; cnt += (c > 0u) ? 1u : 0u; mine = (j == x) ? c : mine; }
        if (sum == G) break;
        __builtin_amdgcn_s_sleep(1);
        if ((++sp & 255u) == 0u) { if (xb_ld(&bar[XB_TMO])) break; if (sp > XB_SPIN_CAP) { atomicAdd(&bar[XB_TMO], 1u); break; } }
    }
    nloc = mine > 0u ? mine : 1u; nx = cnt > 0u ? cnt : 1u;
}

__device__ __forceinline__ void xcd_barrier(const XcdBarrier& b) {
    asm volatile("s_waitcnt vmcnt(0)" ::: "memory");
    __syncthreads();
    if (threadIdx.x == 0) {
        unsigned* bar = b.bar;
        __builtin_amdgcn_s_waitcnt(0);
        unsigned nloc = b.st[0], nx = b.st[1];
        if (nloc == 0u) { xcd_barrier_complete(bar, b.x, nloc, nx); b.st[0] = nloc; b.st[1] = nx; }
        const unsigned old = xb_add(&bar[XB_XSUB(b.x)], 1u);
        const unsigned gen = old / nloc;
        if (old + 1u == (gen + 1u) * nloc) {
            __builtin_amdgcn_fence(__ATOMIC_RELEASE, "agent");
            asm volatile("s_waitcnt vmcnt(0)" ::: "memory");
            const unsigned og = xb_add(&bar[XB_TOP], 1u);
            const unsigned tg = og / nx;
            if (og + 1u == (tg + 1u) * nx) xb_add(&bar[XB_TOPGEN], 1u);
            else XB_SPIN(xb_ld(&bar[XB_TOPGEN]) == tg, bar);
            __builtin_amdgcn_fence(__ATOMIC_ACQUIRE, "agent");
            xb_add(&bar[XB_XGEN(b.x)], 1u);
            asm volatile("s_waitcnt vmcnt(0)" ::: "memory");
        } else {
            XB_SPIN(xb_ld(&bar[XB_XGEN(b.x)]) == gen, bar);
            __builtin_amdgcn_fence(__ATOMIC_ACQUIRE, "agent");
            asm volatile("s_waitcnt vmcnt(0)" ::: "memory");
        }
    }
    __syncthreads();
}


constexpr size_t WS_BAR = 36315136;
constexpr int NPH = 14;
__global__ void __launch_bounds__(512) fwd_kernel(Args a) {
    extern __shared__ __attribute__((aligned(16))) unsigned char lds_raw[];
    LAS unsigned char* lds = (LAS unsigned char*)lds_raw;
    const int tid = threadIdx.x, lane = tid & 63, wave = __builtin_amdgcn_readfirstlane(tid >> 6);
    const int G = gridDim.x, gw = blockIdx.x * 8 + wave, NGW = G * 8;
    cg::grid_group grid = cg::this_grid();
    volatile LAS unsigned* xst = (volatile LAS unsigned*)(lds + LDS_BYTES - 16);
    if (tid < 4) xst[tid] = 0u;
    __syncthreads();
    if (a.ph_lo == 0) { if (blockIdx.x == 0) for (int i = tid; i < XCD_BAR_WORDS; i += 512) ((unsigned*)(a.ws + WS_BAR))[i] = 0u;
        grid.sync(); (void)xcd_barrier_post((unsigned*)(a.ws + WS_BAR), xst); }
#define SEAM(k) do { XcdBarrier xb_; xb_.bar = (unsigned*)(a.ws + WS_BAR); xb_.x = xb_xcc_id(); xb_.st = (volatile LAS unsigned*)(lds + LDS_BYTES - 16); xcd_barrier(xb_); } while (0)
#define PH(k) if (a.ph_lo <= (k) && (k) < a.ph_hi) { if ((k) > a.ph_lo && (k) != 6) SEAM(k);
#define PHEND }
#define GEMM_N1024(EPI, Aoff, Woff, Mrows, Kdim, rowbase, Gn, cid, ...) do { pg8::Gemm g{(const bf16_t*)(a.ws + (Aoff)) + (size_t)(rowbase) * (Kdim), (const bf16_t*)(a.ws + (Woff)), (Mrows), 1024, (Kdim)}; \
        pg8::StaticOrder S; S.init((Mrows), 1024, (Gn), (cid)); EPI E{__VA_ARGS__, (rowbase)}; pg8::gemm_phase<EPI, pg8::StaticOrder, false, true>(lds, g, S, E); } while (0)
    const int bx = (int)blockIdx.x;
    PH(0) {
        float* rss = (float*)(a.ws + WS_RSS1);
        for (int i = bx * 512 + tid; i < 2 * MT; i += G * 512) rss[i] = 0.f;
        p0_convert(a, (LAS float*)lds + wave * (64 * 65), gw, NGW, lane);
        __syncthreads();
        p0_rows(a, lds, gw, NGW, wave, lane, tid);
    } PHEND
    PH(1) {
        pg8::Gemm g{(const bf16_t*)((const unsigned char*)a.out + Y_H), (const bf16_t*)(a.ws + WS_WIN), MT, NIN, 1024}; pg8::StaticOrder S; S.init(MT, NIN, G, bx);
        EpiIn E{a.ws, a.out}; pg8::gemm_phase<EpiIn, pg8::StaticOrder, true, true>(lds, g, S, E);
    } PHEND
    PH(2) {
        LAS float* biasL = (LAS float*)(lds + 8 * 64 * VT_PITCH * 2);
        for (int i = tid; i < 8 * 257; i += 512) biasL[i] = a.in[I_RELB][i] * 1.4426950408889634f;
        __syncthreads();
        LAS bf16_t* vT = (LAS bf16_t*)lds + wave * (64 * VT_PITCH);
        for (int u = gw; u < 256; u += NGW) attn_unit<2, true>(a, u >> 3, u & 7, 0, vT, biasL + (u & 7) * 257, lane);
        __syncthreads();
        const bool few = (G == 256) && bx < 32;
        for (int u = (G != 256) ? bx : (few ? bx : 64 + bx - 32); u < (few ? 64 : 1024 + 128); u += (G != 256) ? G : (few ? 32 : 224)) {
            if (u < 1024) gla_unit<0>(a, lds, u >> 2, u & 3, tid);
            else gla_unit<2>(a, lds, (u - 1024) >> 2, u & 3, tid); }
    } PHEND
    PH(3) {
        if (bx < 16) {
            GEMM_N1024(EpiN1024<0>, A_QA, WS_WPA, MS, 512, MP, 16, bx, (bf16_t*)(a.ws + A_GA), nullptr, nullptr);
            GEMM_N1024(EpiN1024<1>, A_VB, WS_WPB, MS, 1024, MP, 16, bx, (bf16_t*)(a.ws + A_GA), (const bf16_t*)(a.ws + A_GB), nullptr);
        } else {
            LAS float* biasL = (LAS float*)(lds + 8 * 64 * VT_PITCH * 2);
            for (int i = tid; i < 8 * 257; i += 512) biasL[i] = a.in[I_RELB][i] * 1.4426950408889634f;
            __syncthreads();
            if (wave >= 3) { LAS bf16_t* vT = (LAS bf16_t*)lds + wave * (64 * VT_PITCH);
                for (int u = (bx - 16) * 5 + (wave - 3); u < 4096; u += (G - 16) * 5) attn_unit<2, false>(a, u >> 4, u & 7, ((u >> 3) & 1) * 32, vT, biasL + (u & 7) * 257, lane); }
            else scan_phase(a, tid, 192, bx - 16, G - 16);
        }
    } PHEND
    PH(4) { for (int u = bx; u < 1024; u += G) gla_unit<1>(a, lds, u >> 2, u & 3, tid); } PHEND
    PH(5) {
        GEMM_N1024(EpiN1024<0>, A_QA, WS_WPA, MP, 512, 0, G, bx, (bf16_t*)(a.ws + A_GA), nullptr, nullptr);
        GEMM_N1024(EpiN1024<1>, A_VB, WS_WPB, MP, 1024, 0, G, bx, (bf16_t*)(a.ws + A_GA), (const bf16_t*)(a.ws + A_GB), nullptr);
    } PHEND
    PH(6) { } PHEND
    PH(7) { GEMM_N1024(EpiN1024<2>, A_GA, WS_WOUT, MP, 1024, 0, G, bx, (bf16_t*)(a.ws + A_GB), nullptr, (float*)(a.ws + WS_RSS1)); } PHEND
    PH(8) {
        if (G >= 32 && bx < 16) GEMM_N1024(EpiN1024<2>, A_GA, WS_WOUT, MS, 1024, MP, 16, bx, (bf16_t*)(a.ws + A_GB), nullptr, (float*)(a.ws + WS_RSS1));
        else if (G >= 32) row_pass1(a, 0, MP, gw - 128, NGW - 128, lane);
        else { row_pass1(a, 0, MP, gw, NGW, lane); GEMM_N1024(EpiN1024<2>, A_GA, WS_WOUT, MS, 1024, MP, G, bx, (bf16_t*)(a.ws + A_GB), nullptr, (float*)(a.ws + WS_RSS1)); }
    } PHEND
    PH(9) { row_pass1(a, MP, MT, gw, NGW, lane); } PHEND
    PH(10) {
        pg8::Gemm g{(const bf16_t*)(a.ws + A_RB), (const bf16_t*)(a.ws + WS_WGU), MT, NGU, 1024}; pg8::StaticOrder S; S.init(MT, NGU, G, bx);
        EpiSwiglu E{(bf16_t*)(a.ws + A_HID)}; pg8::gemm_phase<EpiSwiglu, pg8::StaticOrder, true, true>(lds, g, S, E);
    } PHEND
    PH(11) { GEMM_N1024(EpiN1024<2>, A_HID, WS_WDN, MP, DFF, 0, G, bx, (bf16_t*)(a.ws + A_GA), nullptr, (float*)(a.ws + WS_RSS2)); } PHEND
    PH(12) {
        if (G >= 32 && bx < 16) GEMM_N1024(EpiN1024<2>, A_HID, WS_WDN, MS, DFF, MP, 16, bx, (bf16_t*)(a.ws + A_GA), nullptr, (float*)(a.ws + WS_RSS2));
        else if (G >= 32) row_pass2(a, 0, MP, gw - 128, NGW - 128, lane);
        else { row_pass2(a, 0, MP, gw, NGW, lane); GEMM_N1024(EpiN1024<2>, A_HID, WS_WDN, MS, DFF, MP, G, bx, (bf16_t*)(a.ws + A_GA), nullptr, (float*)(a.ws + WS_RSS2)); }
    } PHEND
    PH(13) { row_pass2(a, MP, MT, gw, NGW, lane); } PHEND
}

extern "C" void kernel_launch(void* const* d_in, const int* in_sizes, int n_in, void* d_out, int out_size, void* d_ws, size_t ws_size, hipStream_t stream) {
    static int grid = 0;
    if (grid == 0) {
        if (n_in != 20 || ws_size < A_END || out_size != 23724032) { fprintf(stderr, "kernel_launch: unexpected sizes n_in %d ws %zu out %d\n", n_in, ws_size, out_size); }
        int dev = 0, cus = 0, per_cu = 0;
        hipGetDevice(&dev); hipDeviceGetAttribute(&cus, hipDeviceAttributeMultiprocessorCount, dev);
        hipFuncSetAttribute((const void*)fwd_kernel, hipFuncAttributeMaxDynamicSharedMemorySize, LDS_BYTES);
        hipOccupancyMaxActiveBlocksPerMultiprocessor(&per_cu, (const void*)fwd_kernel, 512, LDS_BYTES);
        if (per_cu < 1) { fprintf(stderr, "kernel_launch: occupancy query says %d blocks per CU\n", per_cu); per_cu = 1; }
        grid = cus * 1;
        (void)hipGetLastError();
    }
    Args a{};
    for (int i = 0; i < 20; ++i) a.in[i] = (const float*)d_in[i];
    a.out = (float*)d_out; a.ws = (unsigned char*)d_ws;
    a.ph_lo = 0; a.ph_hi = NPH;
    void* args[] = {&a};
    hipError_t e = hipLaunchCooperativeKernel((const void*)fwd_kernel, dim3(grid), dim3(512), args, LDS_BYTES, stream);
    if (e != hipSuccess) fprintf(stderr, "cooperative launch failed: %s (grid %d)\n", hipGetErrorString(e), grid);
}
```

```cpp
#include <hip/hip_runtime.h>
#include <hip/hip_cooperative_groups.h>
#include <cstdio>
namespace cg = cooperative_groups;

#define LAS __attribute__((address_space(3)))
typedef unsigned short bf16_t;
typedef short bf16x8 __attribute__((ext_vector_type(8)));
typedef float f32x4 __attribute__((ext_vector_type(4)));
typedef float f32x2 __attribute__((ext_vector_type(2)));
typedef unsigned u32x4 __attribute__((ext_vector_type(4)));
typedef unsigned u32x2 __attribute__((ext_vector_type(2)));

constexpr int MP = 16384, MS = 1024, MT = MP + MS, DM = 1024, DIN = 6672, NIN = 6656, DFF = 2816, NGU = 2 * DFF;
constexpr float EPS = 1e-6f;
constexpr size_t O_Y = 0, O_KP = 17825792, O_VP = 18087936, O_SP = 18350080, O_KS = 18481152, O_VS = 19005440, O_SS = 19529728;
constexpr size_t WS_WIN = 0, WS_WPA = 13631488, WS_WPB = 14680064, WS_WOUT = 16777216, WS_WGU = 18874368, WS_WDN = 30408704, WS_RSS1 = 36175872, WS_RSS2 = WS_RSS1 + 69632;
constexpr size_t WS_ACT = 36700160;
constexpr size_t A_QA = WS_ACT, A_KA = A_QA + 17825792, A_VA = A_KA + 17825792, A_QB = A_VA + 17825792, A_KB = A_QB + 17825792, A_VB = A_KB + 17825792,
                 A_RB = A_VB + 35651584, A_GA = A_RB + 35651584, A_GB = A_GA + 35651584, A_END = A_GB + 35651584, A_HID = A_QA;
static_assert(A_END == 268435456, "ws map");
constexpr size_t Y_H = 0, Y_US = 0, Y_DLR = 67108864, Y_DEC = Y_DLR + 1114112;
static_assert(Y_DEC + 524288 <= 71303168, "y scratch");

typedef __bf16 bf16x2_t __attribute__((ext_vector_type(2)));
__device__ __forceinline__ unsigned cvt_pk_bf16(float lo, float hi) { f32x2 v = {lo, hi}; bf16x2_t b = __builtin_convertvector(v, bf16x2_t); return __builtin_bit_cast(unsigned, b); }
__device__ __forceinline__ float bf_lo(unsigned u) { return __uint_as_float(u << 16); }
__device__ __forceinline__ float bf_hi(unsigned u) { return __uint_as_float(u & 0xffff0000u); }
__device__ __forceinline__ float bf2f(bf16_t b) { return __uint_as_float(((unsigned)b) << 16); }
__device__ __forceinline__ bf16_t f2bf(float f) { return (bf16_t)(cvt_pk_bf16(f, 0.f) & 0xffffu); }
__device__ __forceinline__ float wave_sum(float v) { for (int o = 32; o >= 1; o >>= 1) v += __shfl_xor(v, o); return v; }
__device__ __forceinline__ void wave_lds_sync() { asm volatile("s_waitcnt lgkmcnt(0)" ::: "memory"); __builtin_amdgcn_wave_barrier(); }
__device__ __forceinline__ float fast_sigmoid(float x) { return __builtin_amdgcn_rcpf(1.0f + __expf(-x)); }
__device__ __forceinline__ bf16x8 mk8(u32x2 a, u32x2 b) { u32x4 w; w.x = a.x; w.y = a.y; w.z = b.x; w.w = b.y; return __builtin_bit_cast(bf16x8, w); }
__device__ __forceinline__ bf16x8 pk8(f32x4 a, f32x4 b) { u32x4 w; w.x = cvt_pk_bf16(a[0], a[1]); w.y = cvt_pk_bf16(a[2], a[3]); w.z = cvt_pk_bf16(b[0], b[1]); w.w = cvt_pk_bf16(b[2], b[3]); return __builtin_bit_cast(bf16x8, w); }
#define MFMA16(a, b, c) __builtin_amdgcn_mfma_f32_16x16x32_bf16((a), (b), (c), 0, 0, 0)

namespace pg8 {
#define PG8_LAS __attribute__((address_space(3)))
constexpr int BM = 256, BK = 64, HALF = 128, HTB = HALF * BK * 2, STAGE_BYTES = 8 * HTB, NXCD = 8, WGM = 8;
__host__ __device__ __forceinline__ int lds_byte(int r, int c) { const int st = (r >> 4) * 2 + (c >> 5), rr = r & 15, cc = c & 31, ob = rr * 64 + cc * 2; return st * 1024 + (ob ^ (((ob >> 9) & 1) << 5)); }
__host__ __device__ __forceinline__ void stage_rc(int b, int& R, int& C) { const int st = b / 1024, sb = b % 1024, swz = sb ^ (((sb >> 9) & 1) << 5); R = (st >> 1) * 16 + swz / 64; C = (st & 1) * 32 + (swz % 64) / 2; }
__host__ __device__ __forceinline__ int perm32(int rho) { const int n = rho >> 4, i = rho & 15; return 8 * (i >> 2) + 4 * n + (i & 3); }
struct Unit { int pm, pn; };
struct Gemm { const bf16_t* A; const bf16_t* Bt; int M, N, K; };
struct StaticOrder {
    int nM, nN, nwg, G, c;
    __host__ __device__ void init(int M, int N, int G_, int c_) { nM = M / BM; nN = N / BM; nwg = nM * nN; G = G_; c = c_; }
    __host__ __device__ bool next(int i, Unit& u) const {
        const long L = (long)i * G + c; if (L >= nwg) return false;
        int wgid = (int)L; { const int q = nwg / NXCD, r = nwg % NXCD, xcd = wgid % NXCD, off = wgid / NXCD; wgid = (xcd < r ? xcd * (q + 1) : r * (q + 1) + (xcd - r) * q) + off; }
        const int nig = WGM * nN, gid = wgid / nig, fm = gid * WGM, gsz = (nM - fm) < WGM ? (nM - fm) : WGM;
        u.pm = fm + ((wgid % nig) % gsz); u.pn = (wgid % nig) / gsz; return true;
    }
    __device__ __forceinline__ void a_ready(const Unit&) const {}
    __device__ __forceinline__ void done(const Unit&) const {}
};
template <class Epi, class Sched, bool ALIGN_EPI = false, bool SP2 = false>
__device__ __forceinline__ void gemm_phase(PG8_LAS unsigned char* lds, const Gemm g, const Sched& S, const Epi& E) {
    const int tid = threadIdx.x, wid = __builtin_amdgcn_readfirstlane(tid >> 6), lane = tid & 63, wr = wid >> 2, wc = wid & 3, fr = lane & 15, fq = lane >> 4;
    const int K = g.K, nt = K / BK;
    unsigned voffA[2], voffB[2];
#pragma unroll
    for (int i = 0; i < 2; ++i) { int R, C; stage_rc(tid * 16 + i * 8192, R, C); const int Rb = Epi::PERM ? ((R & ~31) + perm32(R & 31)) : R;
        voffA[i] = (unsigned)(R * K + C) * 2u; voffB[i] = (unsigned)(Rb * K + C) * 2u; }
    const size_t kstep = (size_t)(BK * 2);
    const size_t hstep = (size_t)HALF * K * 2;
    const size_t tstep = 2 * hstep;
    const unsigned ldsw = (unsigned)wid * 1024u;
    const int aoff = lds_byte(wr * 64 + fr, fq * 8), boff = lds_byte(wc * 32 + fr, fq * 8);
#define PG8_SA(b, h) (((b) * 2 + (h)) * HTB)
#define PG8_SB(b, h) ((4 + (b) * 2 + (h)) * HTB)
#define PG8_STAGE(bufoff, gbase, voff) do { _Pragma("unroll") for (int _i = 0; _i < 2; ++_i) \
        __builtin_amdgcn_global_load_lds((const unsigned*)((const char*)(gbase) + (voff)[_i]), (PG8_LAS unsigned*)(lds + (bufoff) + ldsw + _i * 8192), 16, 0, 0); } while (0)
#define PG8_LDA(dst, b, h) do { _Pragma("unroll") for (int m = 0; m < 4; ++m) _Pragma("unroll") for (int k = 0; k < 2; ++k) dst[m][k] = *(const PG8_LAS bf16x8*)(lds + PG8_SA(b, h) + aoff + m * 2048 + k * 1024); } while (0)
#define PG8_LDB(dst, b, h) do { _Pragma("unroll") for (int n = 0; n < 2; ++n) _Pragma("unroll") for (int k = 0; k < 2; ++k) dst[n][k] = *(const PG8_LAS bf16x8*)(lds + PG8_SB(b, h) + boff + n * 2048 + k * 1024); } while (0)
#define PG8_MMA(ai, bj, At, Bt) do { __builtin_amdgcn_s_setprio(1); _Pragma("unroll") for (int m = 0; m < 4; ++m) _Pragma("unroll") for (int n = 0; n < 2; ++n) _Pragma("unroll") for (int k = 0; k < 2; ++k) \
        acc[ai][bj][m][n] = __builtin_amdgcn_mfma_f32_16x16x32_bf16(Bt[n][k], At[m][k], acc[ai][bj][m][n], 0, 0, 0); __builtin_amdgcn_s_setprio(0); } while (0)
#define PG8_WAIT_V(n) asm volatile("s_waitcnt vmcnt(" #n ")" ::: "memory")
#define PG8_WAIT_L(n) asm volatile("s_waitcnt lgkmcnt(" #n ")" ::: "memory")
#define PG8_BAR __builtin_amdgcn_s_barrier()
#define PG8_SCHED __builtin_amdgcn_sched_barrier(0)
    Unit cur, nxt; int ui = 0;
    if (!S.next(0, cur)) return;
    f32x4 acc[2][2][4][2];
#pragma unroll
    for (int a = 0; a < 2; ++a)
#pragma unroll
        for (int b = 0; b < 2; ++b)
#pragma unroll
            for (int m = 0; m < 4; ++m)
#pragma unroll
                for (int n = 0; n < 2; ++n) acc[a][b][m][n] = (f32x4){0.f, 0.f, 0.f, 0.f};
    bf16x8 At[4][2], B0[2][2], B1[2][2];
    const char* cA = (const char*)g.A + (size_t)cur.pm * tstep; const char* cB = (const char*)g.Bt + (size_t)cur.pn * tstep;
    S.a_ready(cur);
    if constexpr (SP2) {
        PG8_STAGE(PG8_SB(0, 0), cB, voffB); PG8_STAGE(PG8_SB(0, 1), cB + hstep, voffB); PG8_STAGE(PG8_SA(0, 0), cA, voffA); PG8_STAGE(PG8_SA(0, 1), cA + hstep, voffA);
        if (wr == 1) PG8_BAR;
        PG8_WAIT_V(2); PG8_BAR;
        PG8_STAGE(PG8_SB(1, 0), cB + kstep, voffB); PG8_STAGE(PG8_SA(1, 0), cA + kstep, voffA); PG8_STAGE(PG8_SB(1, 1), cB + hstep + kstep, voffB);
        PG8_WAIT_V(6); PG8_BAR;
    } else {
        PG8_STAGE(PG8_SB(0, 0), cB, voffB); PG8_STAGE(PG8_SA(0, 0), cA, voffA); PG8_STAGE(PG8_SB(0, 1), cB + hstep, voffB); PG8_STAGE(PG8_SA(0, 1), cA + hstep, voffA);
        if (wr == 1) PG8_BAR;
        PG8_WAIT_V(4); PG8_BAR;
        PG8_STAGE(PG8_SB(1, 0), cB + kstep, voffB); PG8_STAGE(PG8_SA(1, 0), cA + kstep, voffA); PG8_STAGE(PG8_SB(1, 1), cB + hstep + kstep, voffB);
        PG8_WAIT_V(6); PG8_BAR;
    }
    for (;;) {
        const bool has_next = S.next(ui + 1, nxt);
        const char* nA = has_next ? (const char*)g.A + (size_t)nxt.pm * tstep : cA; const char* nB = has_next ? (const char*)g.Bt + (size_t)nxt.pn * tstep : cB;
        for (int t = 0; t < nt; t += 2) {
            const bool last = (t == nt - 2);
            const char* a1 = cA + (size_t)(t + 1) * kstep;
            const char* a2 = last ? nA : cA + (size_t)(t + 2) * kstep; const char* b2 = last ? nB : cB + (size_t)(t + 2) * kstep;
            const char* a3 = a2 + kstep; const char* b3 = b2 + kstep;
            if (last && has_next) S.a_ready(nxt);
            if constexpr (SP2) {
            PG8_LDB(B0, 0, 0); PG8_LDB(B1, 0, 1); PG8_SCHED; PG8_LDA(At, 0, 0); PG8_STAGE(PG8_SA(1, 1), a1 + hstep, voffA);
            PG8_WAIT_V(8); PG8_WAIT_L(0); PG8_BAR; PG8_MMA(0, 0, At, B0); PG8_MMA(0, 1, At, B1); PG8_BAR; PG8_SCHED;
            PG8_LDA(At, 0, 1); PG8_STAGE(PG8_SB(0, 0), b2, voffB); PG8_STAGE(PG8_SB(0, 1), b2 + hstep, voffB); PG8_STAGE(PG8_SA(0, 0), a2, voffA);
            PG8_WAIT_V(8); PG8_WAIT_L(0); PG8_BAR; PG8_MMA(1, 0, At, B0); PG8_MMA(1, 1, At, B1); PG8_BAR; PG8_SCHED;
            PG8_LDB(B0, 1, 0); PG8_LDB(B1, 1, 1); PG8_SCHED; PG8_LDA(At, 1, 0); PG8_STAGE(PG8_SA(0, 1), a2 + hstep, voffA);
            PG8_WAIT_V(8); PG8_WAIT_L(0); PG8_BAR; PG8_MMA(0, 0, At, B0); PG8_MMA(0, 1, At, B1); PG8_BAR; PG8_SCHED;
            PG8_LDA(At, 1, 1); PG8_STAGE(PG8_SB(1, 0), b3, voffB); PG8_STAGE(PG8_SB(1, 1), b3 + hstep, voffB); PG8_STAGE(PG8_SA(1, 0), a3, voffA);
            PG8_WAIT_V(8); PG8_WAIT_L(0); PG8_BAR; PG8_MMA(1, 0, At, B0); PG8_MMA(1, 1, At, B1); PG8_BAR; PG8_SCHED;
            } else {
            PG8_LDB(B0, 0, 0); PG8_SCHED; PG8_LDA(At, 0, 0); PG8_STAGE(PG8_SA(1, 1), a1 + hstep, voffA);
            PG8_WAIT_L(8); PG8_BAR; PG8_WAIT_L(0); PG8_MMA(0, 0, At, B0); PG8_BAR; PG8_SCHED;
            PG8_LDB(B1, 0, 1); PG8_STAGE(PG8_SB(0, 0), b2, voffB);
            PG8_BAR; PG8_WAIT_L(0); PG8_MMA(0, 1, At, B1); PG8_BAR;
            PG8_LDA(At, 0, 1); PG8_STAGE(PG8_SA(0, 0), a2, voffA);
            PG8_BAR; PG8_WAIT_L(0); PG8_MMA(1, 0, At, B0); PG8_BAR; PG8_SCHED;
            PG8_STAGE(PG8_SB(0, 1), b2 + hstep, voffB);
            PG8_WAIT_V(6); PG8_BAR; PG8_MMA(1, 1, At, B1); PG8_BAR;
            PG8_LDB(B0, 1, 0); PG8_SCHED; PG8_LDA(At, 1, 0); PG8_STAGE(PG8_SA(0, 1), a2 + hstep, voffA);
            PG8_WAIT_L(8); PG8_BAR; PG8_WAIT_L(0); PG8_MMA(0, 0, At, B0); PG8_BAR; PG8_SCHED;
            PG8_LDB(B1, 1, 1); PG8_STAGE(PG8_SB(1, 0), b3, voffB);
            PG8_BAR; PG8_WAIT_L(0); PG8_MMA(0, 1, At, B1); PG8_BAR;
            PG8_LDA(At, 1, 1); PG8_STAGE(PG8_SA(1, 0), a3, voffA);
            PG8_BAR; PG8_WAIT_L(0); PG8_MMA(1, 0, At, B0); PG8_BAR; PG8_SCHED;
            PG8_STAGE(PG8_SB(1, 1), b3 + hstep, voffB);
            PG8_WAIT_V(6); PG8_BAR; PG8_MMA(1, 1, At, B1); PG8_BAR;
            }
        }
        if constexpr (ALIGN_EPI) { if (wr == 0) PG8_BAR; }
        if constexpr (!Epi::AFTER_DRAIN) { E(acc, cur, wr, wc, fr, fq); S.done(cur); }
        if (!has_next) break;
#pragma unroll
        for (int a = 0; a < 2; ++a)
#pragma unroll
            for (int b = 0; b < 2; ++b)
#pragma unroll
                for (int m = 0; m < 4; ++m)
#pragma unroll
                    for (int n = 0; n < 2; ++n) acc[a][b][m][n] = (f32x4){0.f, 0.f, 0.f, 0.f};
        cur = nxt; cA = nA; cB = nB; ++ui;
        if constexpr (ALIGN_EPI) { if (wr == 1) PG8_BAR; }
    }
    PG8_WAIT_V(0);
    if constexpr (!ALIGN_EPI) { if (wr == 0) PG8_BAR; }
    PG8_BAR;
    if constexpr (Epi::AFTER_DRAIN) { E.fused(acc, cur, wr, wc, fr, fq, lds, wid, lane); S.done(cur); }
#undef PG8_SA
#undef PG8_SB
#undef PG8_STAGE
#undef PG8_LDA
#undef PG8_LDB
#undef PG8_MMA
#undef PG8_WAIT_V
#undef PG8_WAIT_L
#undef PG8_BAR
#undef PG8_SCHED
}
}

typedef f32x4 AccT[2][2][4][2];
__device__ __forceinline__ u32x2 pk4(f32x4 v) { u32x2 w; w.x = cvt_pk_bf16(v[0], v[1]); w.y = cvt_pk_bf16(v[2], v[3]); return w; }
__device__ __forceinline__ f32x4 up4(u32x2 w) { return (f32x4){bf_lo(w.x), bf_hi(w.x), bf_lo(w.y), bf_hi(w.y)}; }

struct EpiIn {
    static constexpr bool PERM = true, AFTER_DRAIN = false;
    unsigned char* ws; float* out;
    __device__ __forceinline__ void operator()(const AccT& acc, const pg8::Unit& u, int wr, int wc, int fr, int fq) const {
        const int pn = u.pn; size_t off; int ldc = 512, cb, mode = 0, kv = 0; float scale = 1.f;
        if (pn < 2) { off = A_QA; cb = pn; mode = 1; scale = 0.125f * 1.4426950408889634f; }
        else if (pn < 4) { off = A_KA; cb = pn - 2; kv = 1; }
        else if (pn < 6) { off = A_VA; cb = pn - 4; kv = 2; }
        else if (pn < 8) { off = A_QB; cb = pn - 6; mode = 1; scale = 0.08838834764831845f; }
        else if (pn < 10) { off = A_KB; cb = pn - 8; }
        else if (pn < 14) { off = A_VB; cb = pn - 10; ldc = 1024; }
        else if (pn < 18) { off = A_RB; cb = pn - 14; ldc = 1024; mode = 2; }
        else if (pn < 22) { off = A_GA; cb = pn - 18; ldc = 1024; mode = 3; }
        else { off = A_GB; cb = pn - 22; ldc = 1024; mode = 3; }
        bf16_t* dst = (bf16_t*)(ws + off);
        const int col0 = cb * 256 + wc * 32 + 8 * fq, row0 = u.pm * 256 + wr * 64 + fr;
        const bool f32out = (kv != 0) && (u.pm >= 62);
        float* ob = nullptr;
        if (f32out) ob = (u.pm < 64) ? out + (kv == 1 ? O_KP : O_VP) - (size_t)15872 * 512 : out + (kv == 1 ? O_KS : O_VS) - (size_t)16384 * 512;
#pragma unroll
        for (int ai = 0; ai < 2; ++ai)
#pragma unroll
            for (int m = 0; m < 4; ++m) { const int row = row0 + ai * 128 + m * 16;
#pragma unroll
                for (int bj = 0; bj < 2; ++bj) { f32x4 v0 = acc[ai][bj][m][0], v1 = acc[ai][bj][m][1]; const int col = col0 + bj * 128;
                    if (f32out) { float* o = ob + (size_t)row * 512 + col; *(f32x4*)o = v0; *(f32x4*)(o + 4) = v1; }
                    if (mode == 1) { v0 = v0 * scale; v1 = v1 * scale; }
                    else if (mode == 2) { for (int j = 0; j < 4; ++j) { v0[j] = v0[j] * fast_sigmoid(v0[j]); v1[j] = v1[j] * fast_sigmoid(v1[j]); } }
                    else if (mode == 3) { for (int j = 0; j < 4; ++j) { v0[j] = fast_sigmoid(v0[j]); v1[j] = fast_sigmoid(v1[j]); } }
                    *(bf16x8*)(dst + (size_t)row * ldc + col) = pk8(v0, v1); }
                asm volatile("" ::: "memory"); }
    }
};
template <int MODE, bool DRYE = false> struct EpiN1024 {
    static constexpr bool PERM = false, AFTER_DRAIN = false;
    bf16_t* io; const bf16_t* g2; float* rowss; int row_base;
    __device__ __forceinline__ void operator()(const AccT& acc, const pg8::Unit& u, int wr, int wc, int fr, int fq) const {
        const int col0 = u.pn * 256 + wc * 32 + 4 * fq, row0 = row_base + u.pm * 256 + wr * 64 + fr;
#pragma unroll
        for (int ai = 0; ai < 2; ++ai)
#pragma unroll
            for (int m = 0; m < 4; ++m) { const int row = row0 + ai * 128 + m * 16; float ss = 0.f;
#pragma unroll
                for (int bj = 0; bj < 2; ++bj)
#pragma unroll
                    for (int n = 0; n < 2; ++n) { f32x4 v = acc[ai][bj][m][n]; const size_t idx = (size_t)row * 1024 + col0 + bj * 128 + n * 16;
                        if (MODE == 0) v = v * up4(*(const u32x2*)(io + idx));
                        else if (MODE == 1) v = up4(*(const u32x2*)(io + idx)) + up4(*(const u32x2*)(g2 + idx)) * v;
                        else ss += (v[0] * v[0] + v[1] * v[1]) + (v[2] * v[2] + v[3] * v[3]);
                        if (!DRYE || v[0] == 123.456f) *(u32x2*)(io + idx) = pk4(v); }
                if (MODE == 2 && !DRYE) { ss += __shfl_xor(ss, 16); ss += __shfl_xor(ss, 32); if (fq == 0) atomicAdd(rowss + row, ss); } }
    }
};
template <int MODE> using EpiN1024D = EpiN1024<MODE, true>;
struct EpiSwiglu {
    static constexpr bool PERM = true, AFTER_DRAIN = false;
    bf16_t* hid;
    __device__ __forceinline__ void operator()(const AccT& acc, const pg8::Unit& u, int wr, int wc, int fr, int fq) const {
        const int col0 = u.pn * 128 + wc * 32 + 8 * fq, row0 = u.pm * 256 + wr * 64 + fr;
#pragma unroll
        for (int ai = 0; ai < 2; ++ai)
#pragma unroll
            for (int m = 0; m < 4; ++m) { const int row = row0 + ai * 128 + m * 16; f32x4 v0, v1;
#pragma unroll
                for (int j = 0; j < 4; ++j) { const float g0 = acc[ai][0][m][0][j], g1 = acc[ai][0][m][1][j];
                    v0[j] = g0 * fast_sigmoid(g0) * acc[ai][1][m][0][j]; v1[j] = g1 * fast_sigmoid(g1) * acc[ai][1][m][1][j]; }
                *(bf16x8*)(hid + (size_t)row * DFF + col0) = pk8(v0, v1); }
    }
};

struct Args { const float* in[20]; float* out; unsigned char* ws; int ph_lo, ph_hi; };
enum { I_XP = 0, I_XS, I_CK, I_CV, I_ST, I_NMPRE, I_NMPOST, I_NFPRE, I_NFPOST, I_WIN, I_WUP, I_BDEC, I_RELB, I_GNORM, I_WPA, I_WPB, I_WOUT, I_WG, I_WU, I_WD };
constexpr int LDS_BYTES = 147456;

__device__ __forceinline__ void p0_convert(const Args& a, LAS float* scr, int gw, int NGW, int lane) {
    constexpr int I_IN = 104 * 16, I_PA = 16 * 8, I_PB = 16 * 16, I_OUT = 16 * 16, I_GU = 88 * 16, I_DN = 16 * 44, TOTAL = I_IN + I_PA + I_PB + I_OUT + I_GU + I_DN;
    for (int it = gw; it < TOTAL; it += NGW) {
        int r = it, kind, K; size_t dsto;
        if (r < I_IN) { kind = 0; K = 1024; dsto = WS_WIN; }
        else if ((r -= I_IN) < I_PA) { kind = 1; K = 512; dsto = WS_WPA; }
        else if ((r -= I_PA) < I_PB) { kind = 2; K = 1024; dsto = WS_WPB; }
        else if ((r -= I_PB) < I_OUT) { kind = 3; K = 1024; dsto = WS_WOUT; }
        else if ((r -= I_OUT) < I_GU) { kind = 4; K = 1024; dsto = WS_WGU; }
        else { r -= I_GU; kind = 5; K = 2816; dsto = WS_WDN; }
        const int ktiles = K >> 6, n0 = (r / ktiles) * 64, k0 = (r % ktiles) * 64, n = n0 + lane;
        const float* sp; int srcN;
        if (kind == 0) { sp = a.in[I_WIN] + (n < 4608 ? n : n + 16); srcN = DIN; }
        else if (kind == 1) { sp = a.in[I_WPA] + n; srcN = 1024; }
        else if (kind == 2) { sp = a.in[I_WPB] + n; srcN = 1024; }
        else if (kind == 3) { sp = a.in[I_WOUT] + n; srcN = 1024; }
        else if (kind == 4) { const int pn = n >> 8, rr = n & 255; sp = ((rr < 128) ? a.in[I_WG] : a.in[I_WU]) + 128 * pn + (rr & 127); srcN = DFF; }
        else { sp = a.in[I_WD] + n; srcN = 1024; }
        sp += (size_t)k0 * srcN;
        float tmp[64];
#pragma unroll
        for (int i = 0; i < 64; ++i) tmp[i] = sp[(size_t)i * srcN];
#pragma unroll
        for (int i = 0; i < 64; ++i) scr[lane * 65 + i] = tmp[i];
        wave_lds_sync();
        unsigned* dst = (unsigned*)(a.ws + dsto) + ((size_t)n0 * K + k0) / 2 + (lane & 31);
#pragma unroll 8
        for (int j = 0; j < 32; ++j) { const int row = 2 * j + (lane >> 5), kk = (lane & 31) * 2; dst[(size_t)row * (K / 2)] = cvt_pk_bf16(scr[row * 65 + kk], scr[row * 65 + kk + 1]); }
        wave_lds_sync();
    }
}
__device__ __forceinline__ const float* xrow_ptr(const Args& a, int row) { return row < MP ? a.in[I_XP] + (size_t)row * DM : a.in[I_XS] + (size_t)(row - MP) * DM; }
__device__ __forceinline__ void p0_rows(const Args& a, LAS unsigned char* lds, int gw, int NGW, int wave, int lane, int tid) {
    LAS float* WdL = (LAS float*)lds;
    LAS float* hrow = (LAS float*)(lds + 4 * 4112 * 4) + wave * 1056;
    for (int idx = tid; idx < 1024 * 16; idx += 512) { const int k = idx >> 4, j = idx & 15; WdL[(k >> 8) * 4112 + (k & 255) * 16 + j] = a.in[I_WIN][(size_t)k * DIN + 4608 + j]; }
    __syncthreads();
    bf16_t* H = (bf16_t*)((unsigned char*)a.out + Y_H); float* DLR = (float*)((unsigned char*)a.out + Y_DLR);
    const f32x4* gp = (const f32x4*)a.in[I_NMPRE] + lane; f32x4 g[4];
#pragma unroll
    for (int j = 0; j < 4; ++j) g[j] = gp[64 * j];
    for (int row = gw; row < MT; row += NGW) {
        const f32x4* xr = (const f32x4*)xrow_ptr(a, row) + lane; f32x4 v[4]; float s = 0.f;
#pragma unroll
        for (int j = 0; j < 4; ++j) { v[j] = xr[64 * j]; s += (v[j][0] * v[j][0] + v[j][1] * v[j][1]) + (v[j][2] * v[j][2] + v[j][3] * v[j][3]); }
        const float rstd = rsqrtf(wave_sum(s) * (1.f / DM) + EPS);
        u32x2* ho = (u32x2*)(H + (size_t)row * DM) + lane;
#pragma unroll
        for (int j = 0; j < 4; ++j) { v[j] = v[j] * rstd * g[j]; ho[64 * j] = pk4(v[j]); *(LAS f32x4*)(hrow + j * 264 + 4 * lane) = v[j]; }
        wave_lds_sync();
        const int jj = lane & 15, p = lane >> 4; float acc = 0.f;
        const LAS float* hp = hrow + p * 264; const LAS float* wp = WdL + p * 4112 + jj;
#pragma unroll 8
        for (int kk = 0; kk < 256; ++kk) acc += hp[kk] * wp[kk * 16];
        acc += __shfl_xor(acc, 16); acc += __shfl_xor(acc, 32);
        if (lane < 16) DLR[(size_t)row * 16 + jj] = acc;
        wave_lds_sync();
    }
}

__device__ __forceinline__ void row_pass1(const Args& a, int row_lo, int row_hi, int gw, int NGW, int lane) {
    const bf16_t* Y = (const bf16_t*)(a.ws + A_GB); bf16_t* A2 = (bf16_t*)(a.ws + A_RB); const float* rss = (const float*)(a.ws + WS_RSS1); float* XO = a.out + O_Y;
    f32x4 gp[4], gq[4];
#pragma unroll
    for (int j = 0; j < 4; ++j) { gp[j] = ((const f32x4*)a.in[I_NMPOST])[lane + 64 * j]; gq[j] = ((const f32x4*)a.in[I_NFPRE])[lane + 64 * j]; }
    for (int r0 = row_lo + 2 * gw; r0 < row_hi; r0 += 2 * NGW) {
        f32x4 xv[2][4]; u32x2 yv[2][4]; float rs[2];
#pragma unroll
        for (int r = 0; r < 2; ++r) { const int row = (r0 + r < row_hi) ? r0 + r : r0; rs[r] = rss[row];
            const f32x4* xr = (const f32x4*)xrow_ptr(a, row) + lane; const u32x2* yr = (const u32x2*)(Y + (size_t)row * DM) + lane;
#pragma unroll
            for (int j = 0; j < 4; ++j) { xv[r][j] = xr[64 * j]; yv[r][j] = yr[64 * j]; } }
#pragma unroll
        for (int r = 0; r < 2; ++r) { const int row = r0 + r; if (row >= row_hi) break;
            const float rstd = rsqrtf(rs[r] * (1.f / DM) + EPS); f32x4 v[4]; float s = 0.f;
#pragma unroll
            for (int j = 0; j < 4; ++j) { v[j] = xv[r][j] + up4(yv[r][j]) * rstd * gp[j]; s += (v[j][0] * v[j][0] + v[j][1] * v[j][1]) + (v[j][2] * v[j][2] + v[j][3] * v[j][3]); }
            const float rstd2 = rsqrtf(wave_sum(s) * (1.f / DM) + EPS);
            f32x4* xo = (f32x4*)(XO + (size_t)row * DM) + lane; u32x2* ao = (u32x2*)(A2 + (size_t)row * DM) + lane;
#pragma unroll
            for (int j = 0; j < 4; ++j) { xo[64 * j] = v[j]; ao[64 * j] = pk4(v[j] * rstd2 * gq[j]); } }
    }
}
template <bool DRYR = false>
__device__ __forceinline__ void row_pass2(const Args& a, int row_lo, int row_hi, int gw, int NGW, int lane) {
    const bf16_t* F = (const bf16_t*)(a.ws + A_GA); const float* rss = (const float*)(a.ws + WS_RSS2); float* XO = a.out + O_Y;
    f32x4 gp[4];
#pragma unroll
    for (int j = 0; j < 4; ++j) gp[j] = ((const f32x4*)a.in[I_NFPOST])[lane + 64 * j];
    for (int r0 = row_lo + 2 * gw; r0 < row_hi; r0 += 2 * NGW) {
        f32x4 xv[2][4]; u32x2 fv[2][4]; float rs[2];
#pragma unroll
        for (int r = 0; r < 2; ++r) { const int row = (r0 + r < row_hi) ? r0 + r : r0; rs[r] = rss[row];
            const f32x4* xo = (const f32x4*)(XO + (size_t)row * DM) + lane; const u32x2* fr = (const u32x2*)(F + (size_t)row * DM) + lane;
#pragma unroll
            for (int j = 0; j < 4; ++j) { xv[r][j] = xo[64 * j]; fv[r][j] = fr[64 * j]; } }
#pragma unroll
        for (int r = 0; r < 2; ++r) { const int row = r0 + r; if (row >= row_hi) break;
            const float rstd = rsqrtf(rs[r] * (1.f / DM) + EPS); f32x4* xo = (f32x4*)(XO + (size_t)row * DM) + lane;
#pragma unroll
            for (int j = 0; j < 4; ++j) { const f32x4 o = xv[r][j] + up4(fv[r][j]) * rstd * gp[j]; if (!DRYR || o[0] == 123.456f) xo[64 * j] = o; } }
    }
}

constexpr int VT_PITCH = 72;
__device__ __forceinline__ bf16x8 ld8_f32(const float* p) { const f32x4 a = *(const f32x4*)p, b = *(const f32x4*)(p + 4); return pk8(a, b); }
template <bool SAMPLE>
__device__ __forceinline__ void attn_load(const Args& a, int idx, int h, int kt, int lane, bf16x8 (&ka)[4][2], bf16x8 (&vv)[8]) {
    const int fr = lane & 15, kq = lane >> 4;
    if (SAMPLE && kt < 8) {
        const size_t base = ((size_t)(idx * 512 + 64 * kt)) * 512 + h * 64; const float* ck = a.in[I_CK] + base; const float* cv = a.in[I_CV] + base;
#pragma unroll
        for (int mt = 0; mt < 4; ++mt)
#pragma unroll
            for (int ks = 0; ks < 2; ++ks) ka[mt][ks] = ld8_f32(ck + (size_t)(16 * mt + fr) * 512 + 32 * ks + 8 * kq);
#pragma unroll
        for (int g = 0; g < 8; ++g) vv[g] = ld8_f32(cv + (size_t)(8 * g + (lane >> 3)) * 512 + 8 * (lane & 7));
    } else {
        const bf16_t* KA = (const bf16_t*)(a.ws + A_KA); const bf16_t* VA = (const bf16_t*)(a.ws + A_VA);
        const int krow0 = SAMPLE ? MP + idx * 32 : (idx - 8 + kt) * 64, nvalid = SAMPLE ? 32 : 64;
#pragma unroll
        for (int mt = 0; mt < 4; ++mt) { int key = 16 * mt + fr; if (key >= nvalid) key = nvalid - 1;
#pragma unroll
            for (int ks = 0; ks < 2; ++ks) ka[mt][ks] = *(const bf16x8*)(KA + (size_t)(krow0 + key) * 512 + h * 64 + 32 * ks + 8 * kq); }
#pragma unroll
        for (int g = 0; g < 8; ++g) { int key = 8 * g + (lane >> 3); if (key >= nvalid) key = nvalid - 1;
            vv[g] = *(const bf16x8*)(VA + (size_t)(krow0 + key) * 512 + h * 64 + 8 * (lane & 7)); }
    }
}
__device__ __forceinline__ void attn_load_kraw(const Args& a, int idx, int h, int kt, int half, int lane, f32x4 (&kr)[8]) {
    const int fr = lane & 15, kq = lane >> 4; const float* ck = a.in[I_CK] + ((size_t)(idx * 512 + 64 * kt)) * 512 + h * 64;
#pragma unroll
    for (int m = 0; m < 2; ++m)
#pragma unroll
        for (int ks = 0; ks < 2; ++ks) { const float* p = ck + (size_t)(16 * (2 * half + m) + fr) * 512 + 32 * ks + 8 * kq; kr[(m * 2 + ks) * 2] = *(const f32x4*)p; kr[(m * 2 + ks) * 2 + 1] = *(const f32x4*)(p + 4); }
}
__device__ __forceinline__ void attn_load_vraw(const Args& a, int idx, int h, int kt, int half, int lane, f32x4 (&vr)[8]) {
    const float* cv = a.in[I_CV] + ((size_t)(idx * 512 + 64 * kt)) * 512 + h * 64;
#pragma unroll
    for (int g = 0; g < 4; ++g) { const float* p = cv + (size_t)(8 * (4 * half + g) + (lane >> 3)) * 512 + 8 * (lane & 7); vr[2 * g] = *(const f32x4*)p; vr[2 * g + 1] = *(const f32x4*)(p + 4); }
}
#define PIN8(x) asm volatile("" : "+v"(x[0]), "+v"(x[1]), "+v"(x[2]), "+v"(x[3]), "+v"(x[4]), "+v"(x[5]), "+v"(x[6]), "+v"(x[7]))
typedef short v4i16_t __attribute__((ext_vector_type(4)));
__device__ __forceinline__ void attn_put_v(LAS bf16_t* vR, const bf16x8 (&vv)[8], int lane) {
#pragma unroll
    for (int g = 0; g < 8; ++g) *(LAS bf16x8*)(vR + (8 * g + (lane >> 3)) * VT_PITCH + 8 * (lane & 7)) = vv[g];
}
__device__ __forceinline__ u32x2 tr_read(const LAS bf16_t* p) { return __builtin_bit_cast(u32x2, __builtin_amdgcn_ds_read_tr16_b64_v4i16((LAS v4i16_t*)p)); }
template <int NQ, bool SAMPLE, bool dry = false>
__device__ __forceinline__ void attn_unit(const Args& a, int idx, int h, int qoff, LAS bf16_t* vT, const LAS float* biasL, int lane) {
    const int fr = lane & 15, kq = lane >> 4;
    bf16_t* QA = (bf16_t*)(a.ws + A_QA);
    const int qrow0 = SAMPLE ? MP + idx * 32 : idx * 64 + qoff;
    bf16x8 bq[NQ][2];
#pragma unroll
    for (int nt = 0; nt < NQ; ++nt)
#pragma unroll
        for (int ks = 0; ks < 2; ++ks) bq[nt][ks] = *(const bf16x8*)(QA + (size_t)(qrow0 + 16 * nt + fr) * 512 + h * 64 + 32 * ks + 8 * kq);
    f32x4 o[4][NQ]; float mrun[NQ], lrun[NQ];
#pragma unroll
    for (int nt = 0; nt < NQ; ++nt) { mrun[nt] = -1e30f; lrun[nt] = 0.f;
#pragma unroll
        for (int dt = 0; dt < 4; ++dt) o[dt][nt] = (f32x4){0.f, 0.f, 0.f, 0.f}; }
    const float bias_far = biasL[256];
    int kt = SAMPLE ? 0 : (idx < 8 ? 8 - idx : 0);
    bf16x8 ka[4][2];
    if (!SAMPLE) { bf16x8 vv[8]; attn_load<SAMPLE>(a, idx, h, kt, lane, ka, vv); attn_put_v(vT, vv, lane); }
#pragma unroll 1
    for (; kt < 9; ++kt) {
        bf16x8 vvN[8]; f32x4 vr[8];
        if (SAMPLE) {
            if (kt < 8) {
#pragma unroll
                for (int hf = 0; hf < 2; ++hf) { f32x4 kr[8]; attn_load_kraw(a, idx, h, kt, hf, lane, kr); PIN8(kr);
#pragma unroll
                    for (int j = 0; j < 4; ++j) ka[2 * hf + (j >> 1)][j & 1] = pk8(kr[2 * j], kr[2 * j + 1]); } }
            else attn_load<true>(a, idx, h, 8, lane, ka, vvN);
        }
        f32x4 s[4][NQ];
#pragma unroll
        for (int mt = 0; mt < 4; ++mt)
#pragma unroll
            for (int nt = 0; nt < NQ; ++nt) { f32x4 z = (f32x4){0.f, 0.f, 0.f, 0.f}; z = MFMA16(ka[mt][0], bq[nt][0], z); s[mt][nt] = MFMA16(ka[mt][1], bq[nt][1], z); }
        if (!SAMPLE && kt < 8) attn_load<false>(a, idx, h, kt + 1, lane, ka, vvN);
        if (SAMPLE && kt < 8) attn_load_vraw(a, idx, h, kt, 0, lane, vr);
        const int dbase = 64 * (8 - kt);
        if (kt >= 6) {
#pragma unroll
            for (int mt = 0; mt < 4; ++mt)
#pragma unroll
                for (int nt = 0; nt < NQ; ++nt)
#pragma unroll
                    for (int i = 0; i < 4; ++i) { int d = (qoff + 16 * nt + fr) - (16 * mt + 4 * kq + i) + dbase; d = d < -128 ? -128 : (d > 128 ? 128 : d); s[mt][nt][i] += biasL[d + 128]; }
        } else {
#pragma unroll
            for (int mt = 0; mt < 4; ++mt)
#pragma unroll
                for (int nt = 0; nt < NQ; ++nt) s[mt][nt] = s[mt][nt] + bias_far;
        }
        if (SAMPLE && kt == 8) {
#pragma unroll
            for (int mt = 2; mt < 4; ++mt)
#pragma unroll
                for (int nt = 0; nt < NQ; ++nt) s[mt][nt] = (f32x4){-1e30f, -1e30f, -1e30f, -1e30f};
        }
        bf16x8 pb[NQ][2];
#pragma unroll
        for (int nt = 0; nt < NQ; ++nt) {
            float mx = -1e30f;
#pragma unroll
            for (int mt = 0; mt < 4; ++mt) mx = fmaxf(mx, fmaxf(fmaxf(s[mt][nt][0], s[mt][nt][1]), fmaxf(s[mt][nt][2], s[mt][nt][3])));
            mx = fmaxf(mx, __shfl_xor(mx, 16)); mx = fmaxf(mx, __shfl_xor(mx, 32));
            const float mnew = fmaxf(mrun[nt], mx), sc = __builtin_amdgcn_exp2f(mrun[nt] - mnew); mrun[nt] = mnew; lrun[nt] *= sc;
#pragma unroll
            for (int dt = 0; dt < 4; ++dt) o[dt][nt] = o[dt][nt] * sc;
            const float mcur = mnew; float ls = 0.f;
#pragma unroll
            for (int mt = 0; mt < 4; ++mt)
#pragma unroll
                for (int i = 0; i < 4; ++i) { const float p = __builtin_amdgcn_exp2f(s[mt][nt][i] - mcur); s[mt][nt][i] = p; ls += p; }
            lrun[nt] += ls;
            pb[nt][0] = pk8(s[0][nt], s[1][nt]); pb[nt][1] = pk8(s[2][nt], s[3][nt]);
        }
        if (SAMPLE) {
            if (kt < 8) { PIN8(vr);
#pragma unroll
                for (int g = 0; g < 4; ++g) *(LAS bf16x8*)(vT + (8 * g + (lane >> 3)) * VT_PITCH + 8 * (lane & 7)) = pk8(vr[2 * g], vr[2 * g + 1]);
                attn_load_vraw(a, idx, h, kt, 1, lane, vr); PIN8(vr);
#pragma unroll
                for (int g = 0; g < 4; ++g) *(LAS bf16x8*)(vT + (8 * (4 + g) + (lane >> 3)) * VT_PITCH + 8 * (lane & 7)) = pk8(vr[2 * g], vr[2 * g + 1]); }
            else attn_put_v(vT, vvN, lane); }
        wave_lds_sync();
#pragma unroll
        for (int ks = 0; ks < 2; ++ks)
#pragma unroll
            for (int dt = 0; dt < 4; ++dt) { const LAS bf16_t* vp = vT + (32 * ks + 4 * kq + (fr >> 2)) * VT_PITCH + 16 * dt + 4 * (fr & 3);
                const bf16x8 va = mk8(tr_read(vp), tr_read(vp + 16 * VT_PITCH));
#pragma unroll
                for (int nt = 0; nt < NQ; ++nt) o[dt][nt] = MFMA16(va, pb[nt][ks], o[dt][nt]);
                if (dt & 1) asm volatile("" ::: "memory"); }
        wave_lds_sync();
        if (!SAMPLE && kt < 8) attn_put_v(vT, vvN, lane);
    }
#pragma unroll
    for (int nt = 0; nt < NQ; ++nt) { float l = lrun[nt]; l += __shfl_xor(l, 16); l += __shfl_xor(l, 32); const float inv = 1.f / l;
        bf16_t* op = QA + (size_t)(qrow0 + 16 * nt + fr) * 512 + h * 64 + 4 * kq;
#pragma unroll
        for (int dt = 0; dt < 4; ++dt) if (!dry) *(u32x2*)(op + 16 * dt) = pk4(o[dt][nt] * inv); }
}

constexpr int QE_P = 136, TT_P = 72;
constexpr int G_QE = 0, G_KE = G_QE + 64 * QE_P * 2, G_KLT = G_KE + 64 * QE_P * 2, G_VT = G_KLT + 128 * TT_P * 2, G_ATT = G_VT + 256 * TT_P * 2,
              G_PSUM = G_ATT + 64 * TT_P * 2, G_BLAST = G_PSUM + 2048, G_DVEC = G_BLAST + 512, G_RED = G_DVEC + 512, G_END = G_RED + 2048;
static_assert(G_END <= 131072, "gla lds");
template <int MODE, bool dry = false>
__device__ __forceinline__ void gla_unit(const Args& a, LAS unsigned char* lds, int idx, int h, int tid) {
    constexpr int C = (MODE == 2) ? 32 : 64, TPT = C / 4, NTL = C / 16, KS_T = C / 32;
    const int lane = tid & 63, wave = __builtin_amdgcn_readfirstlane(tid >> 6), fr = lane & 15, kq = lane >> 4;
    LAS bf16_t* qe = (LAS bf16_t*)(lds + G_QE); LAS bf16_t* ke = (LAS bf16_t*)(lds + G_KE); LAS bf16_t* klT = (LAS bf16_t*)(lds + G_KLT);
    LAS bf16_t* vT = (LAS bf16_t*)(lds + G_VT); LAS bf16_t* att = (LAS bf16_t*)(lds + G_ATT);
    LAS float* psum = (LAS float*)(lds + G_PSUM); LAS float* blast = (LAS float*)(lds + G_BLAST); LAS float* dvec = (LAS float*)(lds + G_DVEC); LAS float* red = (LAS float*)(lds + G_RED);
    const int row0 = (MODE == 2) ? MP + idx * 32 : idx * 64;
    const bf16_t* QB = (const bf16_t*)(a.ws + A_QB); const bf16_t* KB = (const bf16_t*)(a.ws + A_KB); bf16_t* VB = (bf16_t*)(a.ws + A_VB); const bf16_t* RB = (const bf16_t*)(a.ws + A_RB);
    const float* DLR = (const float*)((const unsigned char*)a.out + Y_DLR);
    bf16_t* US = (bf16_t*)((unsigned char*)a.out + Y_US) + (size_t)(idx * 4 + h) * 32768;
    bf16x8 vraw[C / 16];
    { const int t = tid & (C - 1), g0 = tid / C;
#pragma unroll
        for (int gi = 0; gi < C / 16; ++gi) vraw[gi] = *(const bf16x8*)(VB + (size_t)(row0 + t) * 1024 + h * 256 + 8 * (g0 * (C / 16) + gi)); }
    bf16x8 sraw[4][2];
    if (MODE == 1) {
#pragma unroll
        for (int ks = 0; ks < 4; ++ks)
#pragma unroll
            for (int m = 0; m < 2; ++m) sraw[ks][m] = *(const bf16x8*)(US + (size_t)(32 * wave + 16 * m + fr) * 128 + 32 * ks + 8 * kq); }
    {
        const int dk = tid & 127, tq = wave >> 1, col = h * 128 + dk;
        float wu[16];
#pragma unroll
        for (int j = 0; j < 16; ++j) wu[j] = a.in[I_WUP][j * 512 + col];
        const float bd = a.in[I_BDEC][col];
        bf16_t kraw[TPT], qraw[TPT];
#pragma unroll
        for (int i = 0; i < TPT; ++i) { const size_t gi = (size_t)(row0 + tq * TPT + i) * 512 + col; kraw[i] = KB[gi]; qraw[i] = (MODE != 0) ? QB[gi] : (bf16_t)0; }
        float bl[TPT]; float run = 0.f;
#pragma unroll
        for (int i = 0; i < TPT; ++i) { const f32x4* dp = (const f32x4*)(DLR + (size_t)(row0 + tq * TPT + i) * 16); float z = bd;
#pragma unroll
            for (int j4 = 0; j4 < 4; ++j4) { const f32x4 d = dp[j4]; z += d[0] * wu[4 * j4] + d[1] * wu[4 * j4 + 1] + d[2] * wu[4 * j4 + 2] + d[3] * wu[4 * j4 + 3]; }
            const float la = (fminf(z, 0.f) - __logf(1.f + __expf(-fabsf(z)))) * (1.f / 16.f);
            run += la; bl[i] = run; }
        psum[tq * 128 + dk] = run;
        __syncthreads();
        float off = 0.f, tot = 0.f;
#pragma unroll
        for (int p = 0; p < 4; ++p) { const float v = psum[p * 128 + dk]; tot += v; if (p < tq) off += v; }
        if (tq == 0) { dvec[dk] = __expf(tot); if (MODE == 0) ((float*)((unsigned char*)a.out + Y_DEC))[(size_t)(idx * 4 + h) * 128 + dk] = __expf(tot); }
#pragma unroll
        for (int i = 0; i < TPT; ++i) { const int t = tq * TPT + i; const float b = bl[i] + off;
            const float kv = bf2f(kraw[i]);
            if (MODE != 0) { const float qv = bf2f(qraw[i]); qe[t * QE_P + dk] = f2bf(qv * __expf(b)); ke[t * QE_P + dk] = f2bf(kv * __expf(-b)); }
            if (MODE != 1) klT[dk * TT_P + t] = f2bf(kv * __expf(tot - b)); }
    }
    {
        const int t = tid & (C - 1), g0 = tid / C;
#pragma unroll
        for (int gi = 0; gi < C / 16; ++gi) { const int g = g0 * (C / 16) + gi; const bf16x8 vv = vraw[gi];
#pragma unroll
            for (int j = 0; j < 8; ++j) vT[(8 * g + j) * TT_P + t] = (bf16_t)vv[j]; }
    }
    __syncthreads();
    if (MODE != 0) {
        for (int id = wave; id < NTL * NTL; id += 8) { const int ms = id / NTL, nt = id % NTL; f32x4 acc = (f32x4){0.f, 0.f, 0.f, 0.f};
#pragma unroll
            for (int ks = 0; ks < 4; ++ks) acc = MFMA16(*(const LAS bf16x8*)(ke + (16 * ms + fr) * QE_P + 32 * ks + 8 * kq), *(const LAS bf16x8*)(qe + (16 * nt + fr) * QE_P + 32 * ks + 8 * kq), acc);
            const int t = 16 * nt + fr;
#pragma unroll
            for (int i = 0; i < 4; ++i) if (16 * ms + 4 * kq + i > t) acc[i] = 0.f;
            *(LAS u32x2*)(att + t * TT_P + 16 * ms + 4 * kq) = pk4(acc); }
    }
    if (MODE != 1) {
        f32x4 u[8][2];
#pragma unroll
        for (int mt = 0; mt < 8; ++mt)
#pragma unroll
            for (int n = 0; n < 2; ++n) u[mt][n] = (f32x4){0.f, 0.f, 0.f, 0.f};
#pragma unroll
        for (int ks = 0; ks < KS_T; ++ks) { bf16x8 bv[2];
#pragma unroll
            for (int n = 0; n < 2; ++n) bv[n] = *(const LAS bf16x8*)(vT + (32 * wave + 16 * n + fr) * TT_P + 32 * ks + 8 * kq);
#pragma unroll
            for (int mt = 0; mt < 8; ++mt) { const bf16x8 av = *(const LAS bf16x8*)(klT + (16 * mt + fr) * TT_P + 32 * ks + 8 * kq);
#pragma unroll
                for (int n = 0; n < 2; ++n) u[mt][n] = MFMA16(av, bv[n], u[mt][n]); } }
        if (MODE == 0) {
#pragma unroll
            for (int mt = 0; mt < 8; ++mt)
#pragma unroll
                for (int n = 0; n < 2; ++n) *(u32x2*)(US + (size_t)(32 * wave + 16 * n + fr) * 128 + 16 * mt + 4 * kq) = pk4(u[mt][n]);
        } else {
            const float* S0 = a.in[I_ST] + (size_t)(idx * 4 + h) * 32768; float* S1 = a.out + O_SS + (size_t)(idx * 4 + h) * 32768;
#pragma unroll
            for (int mt = 0; mt < 8; ++mt)
#pragma unroll
                for (int n = 0; n < 2; ++n)
#pragma unroll
                    for (int i = 0; i < 4; ++i) { const int dk = 16 * mt + 4 * kq + i, dv = 32 * wave + 16 * n + fr; S1[dk * 256 + dv] = dvec[dk] * S0[dk * 256 + dv] + u[mt][n][i]; }
        }
    }
    if (MODE != 0) {
        __syncthreads();
        f32x4 o[2][NTL];
#pragma unroll
        for (int m = 0; m < 2; ++m)
#pragma unroll
            for (int nt = 0; nt < NTL; ++nt) o[m][nt] = (f32x4){0.f, 0.f, 0.f, 0.f};
#pragma unroll
        for (int ks = 0; ks < KS_T; ++ks) { bf16x8 av[2];
#pragma unroll
            for (int m = 0; m < 2; ++m) av[m] = *(const LAS bf16x8*)(vT + (32 * wave + 16 * m + fr) * TT_P + 32 * ks + 8 * kq);
#pragma unroll
            for (int nt = 0; nt < NTL; ++nt) { const bf16x8 bv = *(const LAS bf16x8*)(att + (16 * nt + fr) * TT_P + 32 * ks + 8 * kq);
#pragma unroll
                for (int m = 0; m < 2; ++m) o[m][nt] = MFMA16(av[m], bv, o[m][nt]); } }
#pragma unroll
        for (int ks = 0; ks < 4; ++ks) { bf16x8 av[2];
#pragma unroll
            for (int m = 0; m < 2; ++m) { const int dv = 32 * wave + 16 * m + fr;
                if (MODE == 1) av[m] = sraw[ks][m];
                else { const float* sp = a.in[I_ST] + (size_t)(idx * 4 + h) * 32768 + (size_t)(32 * ks + 8 * kq) * 256 + dv; f32x4 x0, x1;
#pragma unroll
                    for (int j = 0; j < 4; ++j) { x0[j] = sp[j * 256]; x1[j] = sp[(j + 4) * 256]; }
                    av[m] = pk8(x0, x1); } }
#pragma unroll
            for (int nt = 0; nt < NTL; ++nt) { const bf16x8 bv = *(const LAS bf16x8*)(qe + (16 * nt + fr) * QE_P + 32 * ks + 8 * kq);
#pragma unroll
                for (int m = 0; m < 2; ++m) o[m][nt] = MFMA16(av[m], bv, o[m][nt]); } }
#pragma unroll
        for (int nt = 0; nt < NTL; ++nt) { float ss = 0.f;
#pragma unroll
            for (int m = 0; m < 2; ++m) ss += (o[m][nt][0] * o[m][nt][0] + o[m][nt][1] * o[m][nt][1]) + (o[m][nt][2] * o[m][nt][2] + o[m][nt][3] * o[m][nt][3]);
            ss += __shfl_xor(ss, 16); ss += __shfl_xor(ss, 32);
            if (kq == 0) red[wave * 64 + 16 * nt + fr] = ss; }
        __syncthreads();
#pragma unroll
        for (int nt = 0; nt < NTL; ++nt) { const int t = 16 * nt + fr; float tot = 0.f;
#pragma unroll
            for (int w = 0; w < 8; ++w) tot += red[w * 64 + t];
            const float rstd = rsqrtf(tot * (1.f / 256.f) + EPS);
#pragma unroll
            for (int m = 0; m < 2; ++m) { const int dv = 32 * wave + 16 * m + 4 * kq; const size_t gi = (size_t)(row0 + t) * 1024 + h * 256 + dv;
                const f32x4 gn = *(const f32x4*)(a.in[I_GNORM] + dv); const f32x4 rb = up4(*(const u32x2*)(RB + gi));
                if (!dry) *(u32x2*)(VB + gi) = pk4(o[m][nt] * rstd * gn * rb); } }
    }
    __syncthreads();
}

template <bool DRYS = false>
__device__ __forceinline__ void scan_phase(const Args& a, int tid, int nthr, int blk, int nblk) {
    u32x2* US64 = (u32x2*)((unsigned char*)a.out + Y_US); const f32x4* DEC = (const f32x4*)((const unsigned char*)a.out + Y_DEC);
    const int per = (32768 + nblk - 1) / nblk;
    if (tid >= nthr) return;
    for (int q = tid; q < per; q += nthr) {
    const int p = blk * per + q; if (p >= 32768) break;
    const int hh = p >> 13, dv = (p >> 5) & 255, dq = p & 31; f32x4 st = (f32x4){0.f, 0.f, 0.f, 0.f};
    u32x2* up = US64 + (size_t)hh * 8192 + dv * 32 + dq; const f32x4* dp = DEC + hh * 32 + dq;
    for (int c0 = 0; c0 < 256; c0 += 8) { u32x2 u[8]; f32x4 d[8];
#pragma unroll
        for (int j = 0; j < 8; ++j) { u[j] = up[(size_t)(c0 + j) * 32768]; d[j] = dp[(c0 + j) * 128]; }
#pragma unroll
        for (int j = 0; j < 8; ++j) { if (!DRYS || st[0] == 123.456f) up[(size_t)(c0 + j) * 32768] = pk4(st); st = d[j] * st + up4(u[j]); } }
    float* so = a.out + O_SP + (size_t)(hh * 128 + 4 * dq) * 256 + dv;
    if (!DRYS || st[0] == 123.456f) { so[0] = st[0]; so[256] = st[1]; so[512] = st[2]; so[768] = st[3]; }
    }
}

#define XB_TMO      128
#define XB_XCNT(j)  (256  + 64 * (j))
#define XB_XSUB(j)  (1280 + 64 * (j))
#define XB_XGEN(j)  (2304 + 64 * (j))
#define XB_TOP      3328
#define XB_TOPGEN   3392
#define XCD_BAR_WORDS 3456
#define XB_SPIN_CAP (1u << 18)

__device__ __forceinline__ unsigned xb_ld(unsigned* p)              { return __hip_atomic_load(p, __ATOMIC_RELAXED, __HIP_MEMORY_SCOPE_AGENT); }
__device__ __forceinline__ unsigned xb_add(unsigned* p, unsigned v) { return __hip_atomic_fetch_add(p, v, __ATOMIC_RELAXED, __HIP_MEMORY_SCOPE_AGENT); }
__device__ __forceinline__ unsigned xb_xcc_id() { return (unsigned)__builtin_amdgcn_s_getreg((3 << 11) | 20) & 0xFu; }
#define XB_SPIN(cond, bar) do { unsigned _sp = 0; while (cond) { __builtin_amdgcn_s_sleep(1); \
    if ((++_sp & 255u) == 0u) { if (xb_ld(&(bar)[XB_TMO])) break; if (_sp > XB_SPIN_CAP) { atomicAdd(&(bar)[XB_TMO], 1u); break; } } } } while (0)

struct XcdBarrier {
    unsigned* bar; unsigned x;
    volatile LAS unsigned* st;
};

__device__ __forceinline__ XcdBarrier xcd_barrier_post(unsigned* bar, volatile LAS unsigned* st) {
    XcdBarrier b; b.bar = bar; b.x = xb_xcc_id(); b.st = st;
    if (threadIdx.x == 0) (void)xb_add(&bar[XB_XCNT(b.x)], 1u);
    return b;
}
__device__ __forceinline__ void xcd_barrier_complete(unsigned* bar, unsigned x, unsigned& nloc, unsigned& nx) {
    const unsigned G = gridDim.x * gridDim.y * gridDim.z;
    unsigned sum, cnt, mine, sp = 0u;
    for (;;) {
        sum = 0u; cnt = 0u; mine = 0u;
#pragma unroll
        for (unsigned j = 0; j < 16; ++j) { const unsigned c = xb_ld(&bar[XB_XCNT(j)]); sum += c; cnt += (c > 0u) ? 1u : 0u; mine = (j == x) ? c : mine; }
        if (sum == G) break;
        __builtin_amdgcn_s_sleep(1);
        if ((++sp & 255u) == 0u) { if (xb_ld(&bar[XB_TMO])) break; if (sp > XB_SPIN_CAP) { atomicAdd(&bar[XB_TMO], 1u); break; } }
    }
    nloc = mine > 0u ? mine : 1u; nx = cnt > 0u ? cnt : 1u;
}

__device__ __forceinline__ void xcd_barrier(const XcdBarrier& b) {
    asm volatile("s_waitcnt vmcnt(0)" ::: "memory");
    __syncthreads();
    if (threadIdx.x == 0) {
        unsigned* bar = b.bar;
        __builtin_amdgcn_s_waitcnt(0);
        unsigned nloc = b.st[0], nx = b.st[1];
        if (nloc == 0u) { xcd_barrier_complete(bar, b.x, nloc, nx); b.st[0] = nloc; b.st[1] = nx; }
        const unsigned old = xb_add(&bar[XB_XSUB(b.x)], 1u);
        const unsigned gen = old / nloc;
        if (old + 1u == (gen + 1u) * nloc) {
            __builtin_amdgcn_fence(__ATOMIC_RELEASE, "agent");
            asm volatile("s_waitcnt vmcnt(0)" ::: "memory");
            const unsigned og = xb_add(&bar[XB_TOP], 1u);
            const unsigned tg = og / nx;
            if (og + 1u == (tg + 1u) * nx) xb_add(&bar[XB_TOPGEN], 1u);
            else XB_SPIN(xb_ld(&bar[XB_TOPGEN]) == tg, bar);
            __builtin_amdgcn_fence(__ATOMIC_ACQUIRE, "agent");
            xb_add(&bar[XB_XGEN(b.x)], 1u);
            asm volatile("s_waitcnt vmcnt(0)" ::: "memory");
        } else {
            XB_SPIN(xb_ld(&bar[XB_XGEN(b.x)]) == gen, bar);
            __builtin_amdgcn_fence(__ATOMIC_ACQUIRE, "agent");
            asm volatile("s_waitcnt vmcnt(0)" ::: "memory");
        }
    }
    __syncthreads();
}


constexpr size_t WS_BAR = 36315136;
constexpr int NPH = 14;
__global__ void __launch_bounds__(512) fwd_kernel(Args a) {
    extern __shared__ __attribute__((aligned(16))) unsigned char lds_raw[];
    LAS unsigned char* lds = (LAS unsigned char*)lds_raw;
    const int tid = threadIdx.x, lane = tid & 63, wave = __builtin_amdgcn_readfirstlane(tid >> 6);
    const int G = gridDim.x, gw = blockIdx.x * 8 + wave, NGW = G * 8;
    cg::grid_group grid = cg::this_grid();
    volatile LAS unsigned* xst = (volatile LAS unsigned*)(lds + LDS_BYTES - 16);
    if (tid < 4) xst[tid] = 0u;
    __syncthreads();
    if (a.ph_lo == 0) { if (blockIdx.x == 0) for (int i = tid; i < XCD_BAR_WORDS; i += 512) ((unsigned*)(a.ws + WS_BAR))[i] = 0u;
        grid.sync(); (void)xcd_barrier_post((unsigned*)(a.ws + WS_BAR), xst); }
#define SEAM(k) do { XcdBarrier xb_; xb_.bar = (unsigned*)(a.ws + WS_BAR); xb_.x = xb_xcc_id(); xb_.st = (volatile LAS unsigned*)(lds + LDS_BYTES - 16); xcd_barrier(xb_); } while (0)
#define PH(k) if (a.ph_lo <= (k) && (k) < a.ph_hi) { if ((k) > a.ph_lo && (k) != 6) SEAM(k);
#define PHEND }
#define GEMM_N1024(EPI, Aoff, Woff, Mrows, Kdim, rowbase, Gn, cid, ...) do { pg8::Gemm g{(const bf16_t*)(a.ws + (Aoff)) + (size_t)(rowbase) * (Kdim), (const bf16_t*)(a.ws + (Woff)), (Mrows), 1024, (Kdim)}; \
        pg8::StaticOrder S; S.init((Mrows), 1024, (Gn), (cid)); EPI E{__VA_ARGS__, (rowbase)}; pg8::gemm_phase<EPI, pg8::StaticOrder, false, true>(lds, g, S, E); } while (0)
    const int bx = (int)blockIdx.x;
    PH(0) {
        float* rss = (float*)(a.ws + WS_RSS1);
        for (int i = bx * 512 + tid; i < 2 * MT; i += G * 512) rss[i] = 0.f;
        p0_convert(a, (LAS float*)lds + wave * (64 * 65), gw, NGW, lane);
        __syncthreads();
        p0_rows(a, lds, gw, NGW, wave, lane, tid);
    } PHEND
    PH(1) {
        pg8::Gemm g{(const bf16_t*)((const unsigned char*)a.out + Y_H), (const bf16_t*)(a.ws + WS_WIN), MT, NIN, 1024}; pg8::StaticOrder S; S.init(MT, NIN, G, bx);
        EpiIn E{a.ws, a.out}; pg8::gemm_phase<EpiIn, pg8::StaticOrder, true, true>(lds, g, S, E);
    } PHEND
    PH(2) {
        LAS float* biasL = (LAS float*)(lds + 8 * 64 * VT_PITCH * 2);
        for (int i = tid; i < 8 * 257; i += 512) biasL[i] = a.in[I_RELB][i] * 1.4426950408889634f;
        __syncthreads();
        LAS bf16_t* vT = (LAS bf16_t*)lds + wave * (64 * VT_PITCH);
        for (int u = gw; u < 256; u += NGW) attn_unit<2, true>(a, u >> 3, u & 7, 0, vT, biasL + (u & 7) * 257, lane);
        __syncthreads();
        const bool few = (G == 256) && bx < 32;
        for (int u = (G != 256) ? bx : (few ? bx : 64 + bx - 32); u < (few ? 64 : 1024 + 128); u += (G != 256) ? G : (few ? 32 : 224)) {
            if (u < 1024) gla_unit<0>(a, lds, u >> 2, u & 3, tid);
            else gla_unit<2>(a, lds, (u - 1024) >> 2, u & 3, tid); }
    } PHEND
    PH(3) {
        if (bx < 16) {
            GEMM_N1024(EpiN1024<0>, A_QA, WS_WPA, MS, 512, MP, 16, bx, (bf16_t*)(a.ws + A_GA), nullptr, nullptr);
            GEMM_N1024(EpiN1024<1>, A_VB, WS_WPB, MS, 1024, MP, 16, bx, (bf16_t*)(a.ws + A_GA), (const bf16_t*)(a.ws + A_GB), nullptr);
        } else {
            LAS float* biasL = (LAS float*)(lds + 8 * 64 * VT_PITCH * 2);
            for (int i = tid; i < 8 * 257; i += 512) biasL[i] = a.in[I_RELB][i] * 1.4426950408889634f;
            __syncthreads();
            if (wave >= 3) { LAS bf16_t* vT = (LAS bf16_t*)lds + wave * (64 * VT_PITCH);
                for (int u = (bx - 16) * 5 + (wave - 3); u < 4096; u += (G - 16) * 5) attn_unit<2, false>(a, u >> 4, u & 7, ((u >> 3) & 1) * 32, vT, biasL + (u & 7) * 257, lane); }
            else scan_phase(a, tid, 192, bx - 16, G - 16);
        }
    } PHEND
    PH(4) { for (int u = bx; u < 1024; u += G) gla_unit<1>(a, lds, u >> 2, u & 3, tid); } PHEND
    PH(5) {
        GEMM_N1024(EpiN1024<0>, A_QA, WS_WPA, MP, 512, 0, G, bx, (bf16_t*)(a.ws + A_GA), nullptr, nullptr);
        GEMM_N1024(EpiN1024<1>, A_VB, WS_WPB, MP, 1024, 0, G, bx, (bf16_t*)(a.ws + A_GA), (const bf16_t*)(a.ws + A_GB), nullptr);
    } PHEND
    PH(6) { } PHEND
    PH(7) { GEMM_N1024(EpiN1024<2>, A_GA, WS_WOUT, MP, 1024, 0, G, bx, (bf16_t*)(a.ws + A_GB), nullptr, (float*)(a.ws + WS_RSS1)); } PHEND
    PH(8) {
        if (G >= 32 && bx < 16) GEMM_N1024(EpiN1024<2>, A_GA, WS_WOUT, MS, 1024, MP, 16, bx, (bf16_t*)(a.ws + A_GB), nullptr, (float*)(a.ws + WS_RSS1));
        else if (G >= 32) row_pass1(a, 0, MP, gw - 128, NGW - 128, lane);
        else { row_pass1(a, 0, MP, gw, NGW, lane); GEMM_N1024(EpiN1024<2>, A_GA, WS_WOUT, MS, 1024, MP, G, bx, (bf16_t*)(a.ws + A_GB), nullptr, (float*)(a.ws + WS_RSS1)); }
    } PHEND
    PH(9) { row_pass1(a, MP, MT, gw, NGW, lane); } PHEND
    PH(10) {
        pg8::Gemm g{(const bf16_t*)(a.ws + A_RB), (const bf16_t*)(a.ws + WS_WGU), MT, NGU, 1024}; pg8::StaticOrder S; S.init(MT, NGU, G, bx);
        EpiSwiglu E{(bf16_t*)(a.ws + A_HID)}; pg8::gemm_phase<EpiSwiglu, pg8::StaticOrder, true, true>(lds, g, S, E);
    } PHEND
    PH(11) { GEMM_N1024(EpiN1024<2>, A_HID, WS_WDN, MP, DFF, 0, G, bx, (bf16_t*)(a.ws + A_GA), nullptr, (float*)(a.ws + WS_RSS2)); } PHEND
    PH(12) {
        if (G >= 32 && bx < 16) GEMM_N1024(EpiN1024<2>, A_HID, WS_WDN, MS, DFF, MP, 16, bx, (bf16_t*)(a.ws + A_GA), nullptr, (float*)(a.ws + WS_RSS2));
        else if (G >= 32) row_pass2(a, 0, MP, gw - 128, NGW - 128, lane);
        else { row_pass2(a, 0, MP, gw, NGW, lane); GEMM_N1024(EpiN1024<2>, A_HID, WS_WDN, MS, DFF, MP, G, bx, (bf16_t*)(a.ws + A_GA), nullptr, (float*)(a.ws + WS_RSS2)); }
    } PHEND
    PH(13) { row_pass2(a, MP, MT, gw, NGW, lane); } PHEND
}

extern "C" void kernel_launch(void* const* d_in, const int* in_sizes, int n_in, void* d_out, int out_size, void* d_ws, size_t ws_size, hipStream_t stream) {
    static int grid = 0;
    if (grid == 0) {
        if (n_in != 20 || ws_size < A_END || out_size != 23724032) { fprintf(stderr, "kernel_launch: unexpected sizes n_in %d ws %zu out %d\n", n_in, ws_size, out_size); }
        int dev = 0, cus = 0, per_cu = 0;
        hipGetDevice(&dev); hipDeviceGetAttribute(&cus, hipDeviceAttributeMultiprocessorCount, dev);
        hipFuncSetAttribute((const void*)fwd_kernel, hipFuncAttributeMaxDynamicSharedMemorySize, LDS_BYTES);
        hipOccupancyMaxActiveBlocksPerMultiprocessor(&per_cu, (const void*)fwd_kernel, 512, LDS_BYTES);
        if (per_cu < 1) { fprintf(stderr, "kernel_launch: occupancy query says %d blocks per CU\n", per_cu); per_cu = 1; }
        grid = cus * 1;
        (void)hipGetLastError();
    }
    Args a{};
    for (int i = 0; i < 20; ++i) a.in[i] = (const float*)d_in[i];
    a.out = (float*)d_out; a.ws = (unsigned char*)d_ws;
    a.ph_lo = 0; a.ph_hi = NPH;
    void* args[] = {&a};
    hipError_t e = hipLaunchCooperativeKernel((const void*)fwd_kernel, dim3(grid), dim3(512), args, LDS_BYTES, stream);
    if (e != hipSuccess) fprintf(stderr, "cooperative launch failed: %s (grid %d)\n", hipGetErrorString(e), grid);
}
```

```cpp
#include <hip/hip_runtime.h>
#include <hip/hip_cooperative_groups.h>
#include <cstdio>
namespace cg = cooperative_groups;

#define LAS __attribute__((address_space(3)))
typedef unsigned short bf16_t;
typedef short bf16x8 __attribute__((ext_vector_type(8)));
typedef float f32x4 __attribute__((ext_vector_type(4)));
typedef float f32x2 __attribute__((ext_vector_type(2)));
typedef unsigned u32x4 __attribute__((ext_vector_type(4)));
typedef unsigned u32x2 __attribute__((ext_vector_type(2)));

constexpr int MP = 16384, MS = 1024, MT = MP + MS, DM = 1024, DIN = 6672, NIN = 6656, DFF = 2816, NGU = 2 * DFF;
constexpr float EPS = 1e-6f;
constexpr size_t O_Y = 0, O_KP = 17825792, O_VP = 18087936, O_SP = 18350080, O_KS = 18481152, O_VS = 19005440, O_SS = 19529728;
constexpr size_t WS_WIN = 0, WS_WPA = 13631488, WS_WPB = 14680064, WS_WOUT = 16777216, WS_WGU = 18874368, WS_WDN = 30408704, WS_RSS1 = 36175872, WS_RSS2 = WS_RSS1 + 69632;
constexpr size_t WS_ACT = 36700160;
constexpr size_t A_QA = WS_ACT, A_KA = A_QA + 17825792, A_VA = A_KA + 17825792, A_QB = A_VA + 17825792, A_KB = A_QB + 17825792, A_VB = A_KB + 17825792,
                 A_RB = A_VB + 35651584, A_GA = A_RB + 35651584, A_GB = A_GA + 35651584, A_END = A_GB + 35651584, A_HID = A_QA;
static_assert(A_END == 268435456, "ws map");
constexpr size_t Y_H = 0, Y_US = 0, Y_DLR = 67108864, Y_DEC = Y_DLR + 1114112;
static_assert(Y_DEC + 524288 <= 71303168, "y scratch");

typedef __bf16 bf16x2_t __attribute__((ext_vector_type(2)));
__device__ __forceinline__ unsigned cvt_pk_bf16(float lo, float hi) { f32x2 v = {lo, hi}; bf16x2_t b = __builtin_convertvector(v, bf16x2_t); return __builtin_bit_cast(unsigned, b); }
__device__ __forceinline__ float bf_lo(unsigned u) { return __uint_as_float(u << 16); }
__device__ __forceinline__ float bf_hi(unsigned u) { return __uint_as_float(u & 0xffff0000u); }
__device__ __forceinline__ float bf2f(bf16_t b) { return __uint_as_float(((unsigned)b) << 16); }
__device__ __forceinline__ bf16_t f2bf(float f) { return (bf16_t)(cvt_pk_bf16(f, 0.f) & 0xffffu); }
__device__ __forceinline__ float wave_sum(float v) { for (int o = 32; o >= 1; o >>= 1) v += __shfl_xor(v, o); return v; }
__device__ __forceinline__ void wave_lds_sync() { asm volatile("s_waitcnt lgkmcnt(0)" ::: "memory"); __builtin_amdgcn_wave_barrier(); }
__device__ __forceinline__ float fast_sigmoid(float x) { return __builtin_amdgcn_rcpf(1.0f + __expf(-x)); }
__device__ __forceinline__ bf16x8 mk8(u32x2 a, u32x2 b) { u32x4 w; w.x = a.x; w.y = a.y; w.z = b.x; w.w = b.y; return __builtin_bit_cast(bf16x8, w); }
__device__ __forceinline__ bf16x8 pk8(f32x4 a, f32x4 b) { u32x4 w; w.x = cvt_pk_bf16(a[0], a[1]); w.y = cvt_pk_bf16(a[2], a[3]); w.z = cvt_pk_bf16(b[0], b[1]); w.w = cvt_pk_bf16(b[2], b[3]); return __builtin_bit_cast(bf16x8, w); }
#define MFMA16(a, b, c) __builtin_amdgcn_mfma_f32_16x16x32_bf16((a), (b), (c), 0, 0, 0)

namespace pg8 {
#define PG8_LAS __attribute__((address_space(3)))
constexpr int BM = 256, BK = 64, HALF = 128, HTB = HALF * BK * 2, STAGE_BYTES = 8 * HTB, NXCD = 8, WGM = 8;
__host__ __device__ __forceinline__ int lds_byte(int r, int c) { const int st = (r >> 4) * 2 + (c >> 5), rr = r & 15, cc = c & 31, ob = rr * 64 + cc * 2; return st * 1024 + (ob ^ (((ob >> 9) & 1) << 5)); }
__host__ __device__ __forceinline__ void stage_rc(int b, int& R, int& C) { const int st = b / 1024, sb = b % 1024, swz = sb ^ (((sb >> 9) & 1) << 5); R = (st >> 1) * 16 + swz / 64; C = (st & 1) * 32 + (swz % 64) / 2; }
__host__ __device__ __forceinline__ int perm32(int rho) { const int n = rho >> 4, i = rho & 15; return 8 * (i >> 2) + 4 * n + (i & 3); }
struct Unit { int pm, pn; };
struct Gemm { const bf16_t* A; const bf16_t* Bt; int M, N, K; };
struct StaticOrder {
    int nM, nN, nwg, G, c;
    __host__ __device__ void init(int M, int N, int G_, int c_) { nM = M / BM; nN = N / BM; nwg = nM * nN; G = G_; c = c_; }
    __host__ __device__ bool next(int i, Unit& u) const {
        const long L = (long)i * G + c; if (L >= nwg) return false;
        int wgid = (int)L; { const int q = nwg / NXCD, r = nwg % NXCD, xcd = wgid % NXCD, off = wgid / NXCD; wgid = (xcd < r ? xcd * (q + 1) : r * (q + 1) + (xcd - r) * q) + off; }
        const int nig = WGM * nN, gid = wgid / nig, fm = gid * WGM, gsz = (nM - fm) < WGM ? (nM - fm) : WGM;
        u.pm = fm + ((wgid % nig) % gsz); u.pn = (wgid % nig) / gsz; return true;
    }
    __device__ __forceinline__ void a_ready(const Unit&) const {}
    __device__ __forceinline__ void done(const Unit&) const {}
};
template <class Epi, class Sched, bool ALIGN_EPI = false, bool SP2 = false>
__device__ __forceinline__ void gemm_phase(PG8_LAS unsigned char* lds, const Gemm g, const Sched& S, const Epi& E) {
    const int tid = threadIdx.x, wid = __builtin_amdgcn_readfirstlane(tid >> 6), lane = tid & 63, wr = wid >> 2, wc = wid & 3, fr = lane & 15, fq = lane >> 4;
    const int K = g.K, nt = K / BK;
    unsigned voffA[2], voffB[2];
#pragma unroll
    for (int i = 0; i < 2; ++i) { int R, C; stage_rc(tid * 16 + i * 8192, R, C); const int Rb = Epi::PERM ? ((R & ~31) + perm32(R & 31)) : R;
        voffA[i] = (unsigned)(R * K + C) * 2u; voffB[i] = (unsigned)(Rb * K + C) * 2u; }
    const size_t kstep = (size_t)(BK * 2);
    const size_t hstep = (size_t)HALF * K * 2;
    const size_t tstep = 2 * hstep;
    const unsigned ldsw = (unsigned)wid * 1024u;
    const int aoff = lds_byte(wr * 64 + fr, fq * 8), boff = lds_byte(wc * 32 + fr, fq * 8);
#define PG8_SA(b, h) (((b) * 2 + (h)) * HTB)
#define PG8_SB(b, h) ((4 + (b) * 2 + (h)) * HTB)
#define PG8_STAGE(bufoff, gbase, voff) do { _Pragma("unroll") for (int _i = 0; _i < 2; ++_i) \
        __builtin_amdgcn_global_load_lds((const unsigned*)((const char*)(gbase) + (voff)[_i]), (PG8_LAS unsigned*)(lds + (bufoff) + ldsw + _i * 8192), 16, 0, 0); } while (0)
#define PG8_LDA(dst, b, h) do { _Pragma("unroll") for (int m = 0; m < 4; ++m) _Pragma("unroll") for (int k = 0; k < 2; ++k) dst[m][k] = *(const PG8_LAS bf16x8*)(lds + PG8_SA(b, h) + aoff + m * 2048 + k * 1024); } while (0)
#define PG8_LDB(dst, b, h) do { _Pragma("unroll") for (int n = 0; n < 2; ++n) _Pragma("unroll") for (int k = 0; k < 2; ++k) dst[n][k] = *(const PG8_LAS bf16x8*)(lds + PG8_SB(b, h) + boff + n * 2048 + k * 1024); } while (0)
#define PG8_MMA(ai, bj, At, Bt) do { __builtin_amdgcn_s_setprio(1); _Pragma("unroll") for (int m = 0; m < 4; ++m) _Pragma("unroll") for (int n = 0; n < 2; ++n) _Pragma("unroll") for (int k = 0; k < 2; ++k) \
        acc[ai][bj][m][n] = __builtin_amdgcn_mfma_f32_16x16x32_bf16(Bt[n][k], At[m][k], acc[ai][bj][m][n], 0, 0, 0); __builtin_amdgcn_s_setprio(0); } while (0)
#define PG8_WAIT_V(n) asm volatile("s_waitcnt vmcnt(" #n ")" ::: "memory")
#define PG8_WAIT_L(n) asm volatile("s_waitcnt lgkmcnt(" #n ")" ::: "memory")
#define PG8_BAR __builtin_amdgcn_s_barrier()
#define PG8_SCHED __builtin_amdgcn_sched_barrier(0)
    Unit cur, nxt; int ui = 0;
    if (!S.next(0, cur)) return;
    f32x4 acc[2][2][4][2];
#pragma unroll
    for (int a = 0; a < 2; ++a)
#pragma unroll
        for (int b = 0; b < 2; ++b)
#pragma unroll
            for (int m = 0; m < 4; ++m)
#pragma unroll
                for (int n = 0; n < 2; ++n) acc[a][b][m][n] = (f32x4){0.f, 0.f, 0.f, 0.f};
    bf16x8 At[4][2], B0[2][2], B1[2][2];
    const char* cA = (const char*)g.A + (size_t)cur.pm * tstep; const char* cB = (const char*)g.Bt + (size_t)cur.pn * tstep;
    S.a_ready(cur);
    if constexpr (SP2) {
        PG8_STAGE(PG8_SB(0, 0), cB, voffB); PG8_STAGE(PG8_SB(0, 1), cB + hstep, voffB); PG8_STAGE(PG8_SA(0, 0), cA, voffA); PG8_STAGE(PG8_SA(0, 1), cA + hstep, voffA);
        if (wr == 1) PG8_BAR;
        PG8_WAIT_V(2); PG8_BAR;
        PG8_STAGE(PG8_SB(1, 0), cB + kstep, voffB); PG8_STAGE(PG8_SA(1, 0), cA + kstep, voffA); PG8_STAGE(PG8_SB(1, 1), cB + hstep + kstep, voffB);
        PG8_WAIT_V(6); PG8_BAR;
    } else {
        PG8_STAGE(PG8_SB(0, 0), cB, voffB); PG8_STAGE(PG8_SA(0, 0), cA, voffA); PG8_STAGE(PG8_SB(0, 1), cB + hstep, voffB); PG8_STAGE(PG8_SA(0, 1), cA + hstep, voffA);
        if (wr == 1) PG8_BAR;
        PG8_WAIT_V(4); PG8_BAR;
        PG8_STAGE(PG8_SB(1, 0), cB + kstep, voffB); PG8_STAGE(PG8_SA(1, 0), cA + kstep, voffA); PG8_STAGE(PG8_SB(1, 1), cB + hstep + kstep, voffB);
        PG8_WAIT_V(6); PG8_BAR;
    }
    for (;;) {
        const bool has_next = S.next(ui + 1, nxt);
        const char* nA = has_next ? (const char*)g.A + (size_t)nxt.pm * tstep : cA; const char* nB = has_next ? (const char*)g.Bt + (size_t)nxt.pn * tstep : cB;
        for (int t = 0; t < nt; t += 2) {
            const bool last = (t == nt - 2);
            const char* a1 = cA + (size_t)(t + 1) * kstep;
            const char* a2 = last ? nA : cA + (size_t)(t + 2) * kstep; const char* b2 = last ? nB : cB + (size_t)(t + 2) * kstep;
            const char* a3 = a2 + kstep; const char* b3 = b2 + kstep;
            if (last && has_next) S.a_ready(nxt);
            if constexpr (SP2) {
            PG8_LDB(B0, 0, 0); PG8_LDB(B1, 0, 1); PG8_SCHED; PG8_LDA(At, 0, 0); PG8_STAGE(PG8_SA(1, 1), a1 + hstep, voffA);
            PG8_WAIT_V(8); PG8_WAIT_L(0); PG8_BAR; PG8_MMA(0, 0, At, B0); PG8_MMA(0, 1, At, B1); PG8_BAR; PG8_SCHED;
            PG8_LDA(At, 0, 1); PG8_STAGE(PG8_SB(0, 0), b2, voffB); PG8_STAGE(PG8_SB(0, 1), b2 + hstep, voffB); PG8_STAGE(PG8_SA(0, 0), a2, voffA);
            PG8_WAIT_V(8); PG8_WAIT_L(0); PG8_BAR; PG8_MMA(1, 0, At, B0); PG8_MMA(1, 1, At, B1); PG8_BAR; PG8_SCHED;
            PG8_LDB(B0, 1, 0); PG8_LDB(B1, 1, 1); PG8_SCHED; PG8_LDA(At, 1, 0); PG8_STAGE(PG8_SA(0, 1), a2 + hstep, voffA);
            PG8_WAIT_V(8); PG8_WAIT_L(0); PG8_BAR; PG8_MMA(0, 0, At, B0); PG8_MMA(0, 1, At, B1); PG8_BAR; PG8_SCHED;
            PG8_LDA(At, 1, 1); PG8_STAGE(PG8_SB(1, 0), b3, voffB); PG8_STAGE(PG8_SB(1, 1), b3 + hstep, voffB); PG8_STAGE(PG8_SA(1, 0), a3, voffA);
            PG8_WAIT_V(8); PG8_WAIT_L(0); PG8_BAR; PG8_MMA(1, 0, At, B0); PG8_MMA(1, 1, At, B1); PG8_BAR; PG8_SCHED;
            } else {
            PG8_LDB(B0, 0, 0); PG8_SCHED; PG8_LDA(At, 0, 0); PG8_STAGE(PG8_SA(1, 1), a1 + hstep, voffA);
            PG8_WAIT_L(8); PG8_BAR; PG8_WAIT_L(0); PG8_MMA(0, 0, At, B0); PG8_BAR; PG8_SCHED;
            PG8_LDB(B1, 0, 1); PG8_STAGE(PG8_SB(0, 0), b2, voffB);
            PG8_BAR; PG8_WAIT_L(0); PG8_MMA(0, 1, At, B1); PG8_BAR;
            PG8_LDA(At, 0, 1); PG8_STAGE(PG8_SA(0, 0), a2, voffA);
            PG8_BAR; PG8_WAIT_L(0); PG8_MMA(1, 0, At, B0); PG8_BAR; PG8_SCHED;
            PG8_STAGE(PG8_SB(0, 1), b2 + hstep, voffB);
            PG8_WAIT_V(6); PG8_BAR; PG8_MMA(1, 1, At, B1); PG8_BAR;
            PG8_LDB(B0, 1, 0); PG8_SCHED; PG8_LDA(At, 1, 0); PG8_STAGE(PG8_SA(0, 1), a2 + hstep, voffA);
            PG8_WAIT_L(8); PG8_BAR; PG8_WAIT_L(0); PG8_MMA(0, 0, At, B0); PG8_BAR; PG8_SCHED;
            PG8_LDB(B1, 1, 1); PG8_STAGE(PG8_SB(1, 0), b3, voffB);
            PG8_BAR; PG8_WAIT_L(0); PG8_MMA(0, 1, At, B1); PG8_BAR;
            PG8_LDA(At, 1, 1); PG8_STAGE(PG8_SA(1, 0), a3, voffA);
            PG8_BAR; PG8_WAIT_L(0); PG8_MMA(1, 0, At, B0); PG8_BAR; PG8_SCHED;
            PG8_STAGE(PG8_SB(1, 1), b3 + hstep, voffB);
            PG8_WAIT_V(6); PG8_BAR; PG8_MMA(1, 1, At, B1); PG8_BAR;
            }
        }
        if constexpr (ALIGN_EPI) { if (wr == 0) PG8_BAR; }
        if constexpr (!Epi::AFTER_DRAIN) { E(acc, cur, wr, wc, fr, fq); S.done(cur); }
        if (!has_next) break;
#pragma unroll
        for (int a = 0; a < 2; ++a)
#pragma unroll
            for (int b = 0; b < 2; ++b)
#pragma unroll
                for (int m = 0; m < 4; ++m)
#pragma unroll
                    for (int n = 0; n < 2; ++n) acc[a][b][m][n] = (f32x4){0.f, 0.f, 0.f, 0.f};
        cur = nxt; cA = nA; cB = nB; ++ui;
        if constexpr (ALIGN_EPI) { if (wr == 1) PG8_BAR; }
    }
    PG8_WAIT_V(0);
    if constexpr (!ALIGN_EPI) { if (wr == 0) PG8_BAR; }
    PG8_BAR;
    if constexpr (Epi::AFTER_DRAIN) { E.fused(acc, cur, wr, wc, fr, fq, lds, wid, lane); S.done(cur); }
#undef PG8_SA
#undef PG8_SB
#undef PG8_STAGE
#undef PG8_LDA
#undef PG8_LDB
#undef PG8_MMA
#undef PG8_WAIT_V
#undef PG8_WAIT_L
#undef PG8_BAR
#undef PG8_SCHED
}
}

typedef f32x4 AccT[2][2][4][2];
__device__ __forceinline__ u32x2 pk4(f32x4 v) { u32x2 w; w.x = cvt_pk_bf16(v[0], v[1]); w.y = cvt_pk_bf16(v[2], v[3]); return w; }
__device__ __forceinline__ f32x4 up4(u32x2 w) { return (f32x4){bf_lo(w.x), bf_hi(w.x), bf_lo(w.y), bf_hi(w.y)}; }

struct EpiIn {
    static constexpr bool PERM = true, AFTER_DRAIN = false;
    unsigned char* ws; float* out;
    __device__ __forceinline__ void operator()(const AccT& acc, const pg8::Unit& u, int wr, int wc, int fr, int fq) const {
        const int pn = u.pn; size_t off; int ldc = 512, cb, mode = 0, kv = 0; float scale = 1.f;
        if (pn < 2) { off = A_QA; cb = pn; mode = 1; scale = 0.125f * 1.4426950408889634f; }
        else if (pn < 4) { off = A_KA; cb = pn - 2; kv = 1; }
        else if (pn < 6) { off = A_VA; cb = pn - 4; kv = 2; }
        else if (pn < 8) { off = A_QB; cb = pn - 6; mode = 1; scale = 0.08838834764831845f; }
        else if (pn < 10) { off = A_KB; cb = pn - 8; }
        else if (pn < 14) { off = A_VB; cb = pn - 10; ldc = 1024; }
        else if (pn < 18) { off = A_RB; cb = pn - 14; ldc = 1024; mode = 2; }
        else if (pn < 22) { off = A_GA; cb = pn - 18; ldc = 1024; mode = 3; }
        else { off = A_GB; cb = pn - 22; ldc = 1024; mode = 3; }
        bf16_t* dst = (bf16_t*)(ws + off);
        const int col0 = cb * 256 + wc * 32 + 8 * fq, row0 = u.pm * 256 + wr * 64 + fr;
        const bool f32out = (kv != 0) && (u.pm >= 62);
        float* ob = nullptr;
        if (f32out) ob = (u.pm < 64) ? out + (kv == 1 ? O_KP : O_VP) - (size_t)15872 * 512 : out + (kv == 1 ? O_KS : O_VS) - (size_t)16384 * 512;
#pragma unroll
        for (int ai = 0; ai < 2; ++ai)
#pragma unroll
            for (int m = 0; m < 4; ++m) { const int row = row0 + ai * 128 + m * 16;
#pragma unroll
                for (int bj = 0; bj < 2; ++bj) { f32x4 v0 = acc[ai][bj][m][0], v1 = acc[ai][bj][m][1]; const int col = col0 + bj * 128;
                    if (f32out) { float* o = ob + (size_t)row * 512 + col; *(f32x4*)o = v0; *(f32x4*)(o + 4) = v1; }
                    if (mode == 1) { v0 = v0 * scale; v1 = v1 * scale; }
                    else if (mode == 2) { for (int j = 0; j < 4; ++j) { v0[j] = v0[j] * fast_sigmoid(v0[j]); v1[j] = v1[j] * fast_sigmoid(v1[j]); } }
                    else if (mode == 3) { for (int j = 0; j < 4; ++j) { v0[j] = fast_sigmoid(v0[j]); v1[j] = fast_sigmoid(v1[j]); } }
                    *(bf16x8*)(dst + (size_t)row * ldc + col) = pk8(v0, v1); }
                asm volatile("" ::: "memory"); }
    }
};
template <int MODE, bool DRYE = false> struct EpiN1024 {
    static constexpr bool PERM = false, AFTER_DRAIN = false;
    bf16_t* io; const bf16_t* g2; float* rowss; int row_base;
    __device__ __forceinline__ void operator()(const AccT& acc, const pg8::Unit& u, int wr, int wc, int fr, int fq) const {
        const int col0 = u.pn * 256 + wc * 32 + 4 * fq, row0 = row_base + u.pm * 256 + wr * 64 + fr;
#pragma unroll
        for (int ai = 0; ai < 2; ++ai)
#pragma unroll
            for (int m = 0; m < 4; ++m) { const int row = row0 + ai * 128 + m * 16; float ss = 0.f;
#pragma unroll
                for (int bj = 0; bj < 2; ++bj)
#pragma unroll
                    for (int n = 0; n < 2; ++n) { f32x4 v = acc[ai][bj][m][n]; const size_t idx = (size_t)row * 1024 + col0 + bj * 128 + n * 16;
                        if (MODE == 0) v = v * up4(*(const u32x2*)(io + idx));
                        else if (MODE == 1) v = up4(*(const u32x2*)(io + idx)) + up4(*(const u32x2*)(g2 + idx)) * v;
                        else ss += (v[0] * v[0] + v[1] * v[1]) + (v[2] * v[2] + v[3] * v[3]);
                        if (!DRYE || v[0] == 123.456f) *(u32x2*)(io + idx) = pk4(v); }
                if (MODE == 2 && !DRYE) { ss += __shfl_xor(ss, 16); ss += __shfl_xor(ss, 32); if (fq == 0) atomicAdd(rowss + row, ss); } }
    }
};
template <int MODE> using EpiN1024D = EpiN1024<MODE, true>;
struct EpiSwiglu {
    static constexpr bool PERM = true, AFTER_DRAIN = false;
    bf16_t* hid;
    __device__ __forceinline__ void operator()(const AccT& acc, const pg8::Unit& u, int wr, int wc, int fr, int fq) const {
        const int col0 = u.pn * 128 + wc * 32 + 8 * fq, row0 = u.pm * 256 + wr * 64 + fr;
#pragma unroll
        for (int ai = 0; ai < 2; ++ai)
#pragma unroll
            for (int m = 0; m < 4; ++m) { const int row = row0 + ai * 128 + m * 16; f32x4 v0, v1;
#pragma unroll
                for (int j = 0; j < 4; ++j) { const float g0 = acc[ai][0][m][0][j], g1 = acc[ai][0][m][1][j];
                    v0[j] = g0 * fast_sigmoid(g0) * acc[ai][1][m][0][j]; v1[j] = g1 * fast_sigmoid(g1) * acc[ai][1][m][1][j]; }
                *(bf16x8*)(hid + (size_t)row * DFF + col0) = pk8(v0, v1); }
    }
};

struct Args { const float* in[20]; float* out; unsigned char* ws; int ph_lo, ph_hi; };
enum { I_XP = 0, I_XS, I_CK, I_CV, I_ST, I_NMPRE, I_NMPOST, I_NFPRE, I_NFPOST, I_WIN, I_WUP, I_BDEC, I_RELB, I_GNORM, I_WPA, I_WPB, I_WOUT, I_WG, I_WU, I_WD };
constexpr int LDS_BYTES = 147456;

__device__ __forceinline__ void p0_convert(const Args& a, LAS float* scr, int gw, int NGW, int lane) {
    constexpr int I_IN = 104 * 16, I_PA = 16 * 8, I_PB = 16 * 16, I_OUT = 16 * 16, I_GU = 88 * 16, I_DN = 16 * 44, TOTAL = I_IN + I_PA + I_PB + I_OUT + I_GU + I_DN;
    for (int it = gw; it < TOTAL; it += NGW) {
        int r = it, kind, K; size_t dsto;
        if (r < I_IN) { kind = 0; K = 1024; dsto = WS_WIN; }
        else if ((r -= I_IN) < I_PA) { kind = 1; K = 512; dsto = WS_WPA; }
        else if ((r -= I_PA) < I_PB) { kind = 2; K = 1024; dsto = WS_WPB; }
        else if ((r -= I_PB) < I_OUT) { kind = 3; K = 1024; dsto = WS_WOUT; }
        else if ((r -= I_OUT) < I_GU) { kind = 4; K = 1024; dsto = WS_WGU; }
        else { r -= I_GU; kind = 5; K = 2816; dsto = WS_WDN; }
        const int ktiles = K >> 6, n0 = (r / ktiles) * 64, k0 = (r % ktiles) * 64, n = n0 + lane;
        const float* sp; int srcN;
        if (kind == 0) { sp = a.in[I_WIN] + (n < 4608 ? n : n + 16); srcN = DIN; }
        else if (kind == 1) { sp = a.in[I_WPA] + n; srcN = 1024; }
        else if (kind == 2) { sp = a.in[I_WPB] + n; srcN = 1024; }
        else if (kind == 3) { sp = a.in[I_WOUT] + n; srcN = 1024; }
        else if (kind == 4) { const int pn = n >> 8, rr = n & 255; sp = ((rr < 128) ? a.in[I_WG] : a.in[I_WU]) + 128 * pn + (rr & 127); srcN = DFF; }
        else { sp = a.in[I_WD] + n; srcN = 1024; }
        sp += (size_t)k0 * srcN;
        float tmp[64];
#pragma unroll
        for (int i = 0; i < 64; ++i) tmp[i] = sp[(size_t)i * srcN];
#pragma unroll
        for (int i = 0; i < 64; ++i) scr[lane * 65 + i] = tmp[i];
        wave_lds_sync();
        unsigned* dst = (unsigned*)(a.ws + dsto) + ((size_t)n0 * K + k0) / 2 + (lane & 31);
#pragma unroll 8
        for (int j = 0; j < 32; ++j) { const int row = 2 * j + (lane >> 5), kk = (lane & 31) * 2; dst[(size_t)row * (K / 2)] = cvt_pk_bf16(scr[row * 65 + kk], scr[row * 65 + kk + 1]); }
        wave_lds_sync();
    }
}
__device__ __forceinline__ const float* xrow_ptr(const Args& a, int row) { return row < MP ? a.in[I_XP] + (size_t)row * DM : a.in[I_XS] + (size_t)(row - MP) * DM; }
__device__ __forceinline__ void p0_rows(const Args& a, LAS unsigned char* lds, int gw, int NGW, int wave, int lane, int tid) {
    LAS float* WdL = (LAS float*)lds;
    LAS float* hrow = (LAS float*)(lds + 4 * 4112 * 4) + wave * 1056;
    for (int idx = tid; idx < 1024 * 16; idx += 512) { const int k = idx >> 4, j = idx & 15; WdL[(k >> 8) * 4112 + (k & 255) * 16 + j] = a.in[I_WIN][(size_t)k * DIN + 4608 + j]; }
    __syncthreads();
    bf16_t* H = (bf16_t*)((unsigned char*)a.out + Y_H); float* DLR = (float*)((unsigned char*)a.out + Y_DLR);
    const f32x4* gp = (const f32x4*)a.in[I_NMPRE] + lane; f32x4 g[4];
#pragma unroll
    for (int j = 0; j < 4; ++j) g[j] = gp[64 * j];
    for (int row = gw; row < MT; row += NGW) {
        const f32x4* xr = (const f32x4*)xrow_ptr(a, row) + lane; f32x4 v[4]; float s = 0.f;
#pragma unroll
        for (int j = 0; j < 4; ++j) { v[j] = xr[64 * j]; s += (v[j][0] * v[j][0] + v[j][1] * v[j][1]) + (v[j][2] * v[j][2] + v[j][3] * v[j][3]); }
        const float rstd = rsqrtf(wave_sum(s) * (1.f / DM) + EPS);
        u32x2* ho = (u32x2*)(H + (size_t)row * DM) + lane;
#pragma unroll
        for (int j = 0; j < 4; ++j) { v[j] = v[j] * rstd * g[j]; ho[64 * j] = pk4(v[j]); *(LAS f32x4*)(hrow + j * 264 + 4 * lane) = v[j]; }
        wave_lds_sync();
        const int jj = lane & 15, p = lane >> 4; float acc = 0.f;
        const LAS float* hp = hrow + p * 264; const LAS float* wp = WdL + p * 4112 + jj;
#pragma unroll 8
        for (int kk = 0; kk < 256; ++kk) acc += hp[kk] * wp[kk * 16];
        acc += __shfl_xor(acc, 16); acc += __shfl_xor(acc, 32);
        if (lane < 16) DLR[(size_t)row * 16 + jj] = acc;
        wave_lds_sync();
    }
}

__device__ __forceinline__ void row_pass1(const Args& a, int row_lo, int row_hi, int gw, int NGW, int lane) {
    const bf16_t* Y = (const bf16_t*)(a.ws + A_GB); bf16_t* A2 = (bf16_t*)(a.ws + A_RB); const float* rss = (const float*)(a.ws + WS_RSS1); float* XO = a.out + O_Y;
    f32x4 gp[4], gq[4];
#pragma unroll
    for (int j = 0; j < 4; ++j) { gp[j] = ((const f32x4*)a.in[I_NMPOST])[lane + 64 * j]; gq[j] = ((const f32x4*)a.in[I_NFPRE])[lane + 64 * j]; }
    for (int r0 = row_lo + 2 * gw; r0 < row_hi; r0 += 2 * NGW) {
        f32x4 xv[2][4]; u32x2 yv[2][4]; float rs[2];
#pragma unroll
        for (int r = 0; r < 2; ++r) { const int row = (r0 + r < row_hi) ? r0 + r : r0; rs[r] = rss[row];
            const f32x4* xr = (const f32x4*)xrow_ptr(a, row) + lane; const u32x2* yr = (const u32x2*)(Y + (size_t)row * DM) + lane;
#pragma unroll
            for (int j = 0; j < 4; ++j) { xv[r][j] = xr[64 * j]; yv[r][j] = yr[64 * j]; } }
#pragma unroll
        for (int r = 0; r < 2; ++r) { const int row = r0 + r; if (row >= row_hi) break;
            const float rstd = rsqrtf(rs[r] * (1.f / DM) + EPS); f32x4 v[4]; float s = 0.f;
#pragma unroll
            for (int j = 0; j < 4; ++j) { v[j] = xv[r][j] + up4(yv[r][j]) * rstd * gp[j]; s += (v[j][0] * v[j][0] + v[j][1] * v[j][1]) + (v[j][2] * v[j][2] + v[j][3] * v[j][3]); }
            const float rstd2 = rsqrtf(wave_sum(s) * (1.f / DM) + EPS);
            f32x4* xo = (f32x4*)(XO + (size_t)row * DM) + lane; u32x2* ao = (u32x2*)(A2 + (size_t)row * DM) + lane;
#pragma unroll
            for (int j = 0; j < 4; ++j) { xo[64 * j] = v[j]; ao[64 * j] = pk4(v[j] * rstd2 * gq[j]); } }
    }
}
template <bool DRYR = false>
__device__ __forceinline__ void row_pass2(const Args& a, int row_lo, int row_hi, int gw, int NGW, int lane) {
    const bf16_t* F = (const bf16_t*)(a.ws + A_GA); const float* rss = (const float*)(a.ws + WS_RSS2); float* XO = a.out + O_Y;
    f32x4 gp[4];
#pragma unroll
    for (int j = 0; j < 4; ++j) gp[j] = ((const f32x4*)a.in[I_NFPOST])[lane + 64 * j];
    for (int r0 = row_lo + 2 * gw; r0 < row_hi; r0 += 2 * NGW) {
        f32x4 xv[2][4]; u32x2 fv[2][4]; float rs[2];
#pragma unroll
        for (int r = 0; r < 2; ++r) { const int row = (r0 + r < row_hi) ? r0 + r : r0; rs[r] = rss[row];
            const f32x4* xo = (const f32x4*)(XO + (size_t)row * DM) + lane; const u32x2* fr = (const u32x2*)(F + (size_t)row * DM) + lane;
#pragma unroll
            for (int j = 0; j < 4; ++j) { xv[r][j] = xo[64 * j]; fv[r][j] = fr[64 * j]; } }
#pragma unroll
        for (int r = 0; r < 2; ++r) { const int row = r0 + r; if (row >= row_hi) break;
            const float rstd = rsqrtf(rs[r] * (1.f / DM) + EPS); f32x4* xo = (f32x4*)(XO + (size_t)row * DM) + lane;
#pragma unroll
            for (int j = 0; j < 4; ++j) { const f32x4 o = xv[r][j] + up4(fv[r][j]) * rstd * gp[j]; if (!DRYR || o[0] == 123.456f) xo[64 * j] = o; } }
    }
}

constexpr int VT_PITCH = 72;
__device__ __forceinline__ bf16x8 ld8_f32(const float* p) { const f32x4 a = *(const f32x4*)p, b = *(const f32x4*)(p + 4); return pk8(a, b); }
template <bool SAMPLE>
__device__ __forceinline__ void attn_load(const Args& a, int idx, int h, int kt, int lane, bf16x8 (&ka)[4][2], bf16x8 (&vv)[8]) {
    const int fr = lane & 15, kq = lane >> 4;
    if (SAMPLE && kt < 8) {
        const size_t base = ((size_t)(idx * 512 + 64 * kt)) * 512 + h * 64; const float* ck = a.in[I_CK] + base; const float* cv = a.in[I_CV] + base;
#pragma unroll
        for (int mt = 0; mt < 4; ++mt)
#pragma unroll
            for (int ks = 0; ks < 2; ++ks) ka[mt][ks] = ld8_f32(ck + (size_t)(16 * mt + fr) * 512 + 32 * ks + 8 * kq);
#pragma unroll
        for (int g = 0; g < 8; ++g) vv[g] = ld8_f32(cv + (size_t)(8 * g + (lane >> 3)) * 512 + 8 * (lane & 7));
    } else {
        const bf16_t* KA = (const bf16_t*)(a.ws + A_KA); const bf16_t* VA = (const bf16_t*)(a.ws + A_VA);
        const int krow0 = SAMPLE ? MP + idx * 32 : (idx - 8 + kt) * 64, nvalid = SAMPLE ? 32 : 64;
#pragma unroll
        for (int mt = 0; mt < 4; ++mt) { int key = 16 * mt + fr; if (key >= nvalid) key = nvalid - 1;
#pragma unroll
            for (int ks = 0; ks < 2; ++ks) ka[mt][ks] = *(const bf16x8*)(KA + (size_t)(krow0 + key) * 512 + h * 64 + 32 * ks + 8 * kq); }
#pragma unroll
        for (int g = 0; g < 8; ++g) { int key = 8 * g + (lane >> 3); if (key >= nvalid) key = nvalid - 1;
            vv[g] = *(const bf16x8*)(VA + (size_t)(krow0 + key) * 512 + h * 64 + 8 * (lane & 7)); }
    }
}
__device__ __forceinline__ void attn_load_kraw(const Args& a, int idx, int h, int kt, int half, int lane, f32x4 (&kr)[8]) {
    const int fr = lane & 15, kq = lane >> 4; const float* ck = a.in[I_CK] + ((size_t)(idx * 512 + 64 * kt)) * 512 + h * 64;
#pragma unroll
    for (int m = 0; m < 2; ++m)
#pragma unroll
        for (int ks = 0; ks < 2; ++ks) { const float* p = ck + (size_t)(16 * (2 * half + m) + fr) * 512 + 32 * ks + 8 * kq; kr[(m * 2 + ks) * 2] = *(const f32x4*)p; kr[(m * 2 + ks) * 2 + 1] = *(const f32x4*)(p + 4); }
}
__device__ __forceinline__ void attn_load_vraw(const Args& a, int idx, int h, int kt, int half, int lane, f32x4 (&vr)[8]) {
    const float* cv = a.in[I_CV] + ((size_t)(idx * 512 + 64 * kt)) * 512 + h * 64;
#pragma unroll
    for (int g = 0; g < 4; ++g) { const float* p = cv + (size_t)(8 * (4 * half + g) + (lane >> 3)) * 512 + 8 * (lane & 7); vr[2 * g] = *(const f32x4*)p; vr[2 * g + 1] = *(const f32x4*)(p + 4); }
}
#define PIN8(x) asm volatile("" : "+v"(x[0]), "+v"(x[1]), "+v"(x[2]), "+v"(x[3]), "+v"(x[4]), "+v"(x[5]), "+v"(x[6]), "+v"(x[7]))
typedef short v4i16_t __attribute__((ext_vector_type(4)));
__device__ __forceinline__ void attn_put_v(LAS bf16_t* vR, const bf16x8 (&vv)[8], int lane) {
#pragma unroll
    for (int g = 0; g < 8; ++g) *(LAS bf16x8*)(vR + (8 * g + (lane >> 3)) * VT_PITCH + 8 * (lane & 7)) = vv[g];
}
__device__ __forceinline__ u32x2 tr_read(const LAS bf16_t* p) { return __builtin_bit_cast(u32x2, __builtin_amdgcn_ds_read_tr16_b64_v4i16((LAS v4i16_t*)p)); }
template <int NQ, bool SAMPLE, bool dry = false>
__device__ __forceinline__ void attn_unit(const Args& a, int idx, int h, int qoff, LAS bf16_t* vT, const LAS float* biasL, int lane) {
    const int fr = lane & 15, kq = lane >> 4;
    bf16_t* QA = (bf16_t*)(a.ws + A_QA);
    const int qrow0 = SAMPLE ? MP + idx * 32 : idx * 64 + qoff;
    bf16x8 bq[NQ][2];
#pragma unroll
    for (int nt = 0; nt < NQ; ++nt)
#pragma unroll
        for (int ks = 0; ks < 2; ++ks) bq[nt][ks] = *(const bf16x8*)(QA + (size_t)(qrow0 + 16 * nt + fr) * 512 + h * 64 + 32 * ks + 8 * kq);
    f32x4 o[4][NQ]; float mrun[NQ], lrun[NQ];
#pragma unroll
    for (int nt = 0; nt < NQ; ++nt) { mrun[nt] = -1e30f; lrun[nt] = 0.f;
#pragma unroll
        for (int dt = 0; dt < 4; ++dt) o[dt][nt] = (f32x4){0.f, 0.f, 0.f, 0.f}; }
    const float bias_far = biasL[256];
    int kt = SAMPLE ? 0 : (idx < 8 ? 8 - idx : 0);
    bf16x8 ka[4][2];
    if (!SAMPLE) { bf16x8 vv[8]; attn_load<SAMPLE>(a, idx, h, kt, lane, ka, vv); attn_put_v(vT, vv, lane); }
#pragma unroll 1
    for (; kt < 9; ++kt) {
        bf16x8 vvN[8]; f32x4 vr[8];
        if (SAMPLE) {
            if (kt < 8) {
#pragma unroll
                for (int hf = 0; hf < 2; ++hf) { f32x4 kr[8]; attn_load_kraw(a, idx, h, kt, hf, lane, kr); PIN8(kr);
#pragma unroll
                    for (int j = 0; j < 4; ++j) ka[2 * hf + (j >> 1)][j & 1] = pk8(kr[2 * j], kr[2 * j + 1]); } }
            else attn_load<true>(a, idx, h, 8, lane, ka, vvN);
        }
        f32x4 s[4][NQ];
#pragma unroll
        for (int mt = 0; mt < 4; ++mt)
#pragma unroll
            for (int nt = 0; nt < NQ; ++nt) { f32x4 z = (f32x4){0.f, 0.f, 0.f, 0.f}; z = MFMA16(ka[mt][0], bq[nt][0], z); s[mt][nt] = MFMA16(ka[mt][1], bq[nt][1], z); }
        if (!SAMPLE && kt < 8) attn_load<false>(a, idx, h, kt + 1, lane, ka, vvN);
        if (SAMPLE && kt < 8) attn_load_vraw(a, idx, h, kt, 0, lane, vr);
        const int dbase = 64 * (8 - kt);
        if (kt >= 6) {
#pragma unroll
            for (int mt = 0; mt < 4; ++mt)
#pragma unroll
                for (int nt = 0; nt < NQ; ++nt)
#pragma unroll
                    for (int i = 0; i < 4; ++i) { int d = (qoff + 16 * nt + fr) - (16 * mt + 4 * kq + i) + dbase; d = d < -128 ? -128 : (d > 128 ? 128 : d); s[mt][nt][i] += biasL[d + 128]; }
        } else {
#pragma unroll
            for (int mt = 0; mt < 4; ++mt)
#pragma unroll
                for (int nt = 0; nt < NQ; ++nt) s[mt][nt] = s[mt][nt] + bias_far;
        }
        if (SAMPLE && kt == 8) {
#pragma unroll
            for (int mt = 2; mt < 4; ++mt)
#pragma unroll
                for (int nt = 0; nt < NQ; ++nt) s[mt][nt] = (f32x4){-1e30f, -1e30f, -1e30f, -1e30f};
        }
        bf16x8 pb[NQ][2];
#pragma unroll
        for (int nt = 0; nt < NQ; ++nt) {
            float mx = -1e30f;
#pragma unroll
            for (int mt = 0; mt < 4; ++mt) mx = fmaxf(mx, fmaxf(fmaxf(s[mt][nt][0], s[mt][nt][1]), fmaxf(s[mt][nt][2], s[mt][nt][3])));
            mx = fmaxf(mx, __shfl_xor(mx, 16)); mx = fmaxf(mx, __shfl_xor(mx, 32));
            const float mnew = fmaxf(mrun[nt], mx), sc = __builtin_amdgcn_exp2f(mrun[nt] - mnew); mrun[nt] = mnew; lrun[nt] *= sc;
#pragma unroll
            for (int dt = 0; dt < 4; ++dt) o[dt][nt] = o[dt][nt] * sc;
            const float mcur = mnew; float ls = 0.f;
#pragma unroll
            for (int mt = 0; mt < 4; ++mt)
#pragma unroll
                for (int i = 0; i < 4; ++i) { const float p = __builtin_amdgcn_exp2f(s[mt][nt][i] - mcur); s[mt][nt][i] = p; ls += p; }
            lrun[nt] += ls;
            pb[nt][0] = pk8(s[0][nt], s[1][nt]); pb[nt][1] = pk8(s[2][nt], s[3][nt]);
        }
        if (SAMPLE) {
            if (kt < 8) { PIN8(vr);
#pragma unroll
                for (int g = 0; g < 4; ++g) *(LAS bf16x8*)(vT + (8 * g + (lane >> 3)) * VT_PITCH + 8 * (lane & 7)) = pk8(vr[2 * g], vr[2 * g + 1]);
                attn_load_vraw(a, idx, h, kt, 1, lane, vr); PIN8(vr);
#pragma unroll
                for (int g = 0; g < 4; ++g) *(LAS bf16x8*)(vT + (8 * (4 + g) + (lane >> 3)) * VT_PITCH + 8 * (lane & 7)) = pk8(vr[2 * g], vr[2 * g + 1]); }
            else attn_put_v(vT, vvN, lane); }
        wave_lds_sync();
#pragma unroll
        for (int ks = 0; ks < 2; ++ks)
#pragma unroll
            for (int dt = 0; dt < 4; ++dt) { const LAS bf16_t* vp = vT + (32 * ks + 4 * kq + (fr >> 2)) * VT_PITCH + 16 * dt + 4 * (fr & 3);
                const bf16x8 va = mk8(tr_read(vp), tr_read(vp + 16 * VT_PITCH));
#pragma unroll
                for (int nt = 0; nt < NQ; ++nt) o[dt][nt] = MFMA16(va, pb[nt][ks], o[dt][nt]);
                if (dt & 1) asm volatile("" ::: "memory"); }
        wave_lds_sync();
        if (!SAMPLE && kt < 8) attn_put_v(vT, vvN, lane);
    }
#pragma unroll
    for (int nt = 0; nt < NQ; ++nt) { float l = lrun[nt]; l += __shfl_xor(l, 16); l += __shfl_xor(l, 32); const float inv = 1.f / l;
        bf16_t* op = QA + (size_t)(qrow0 + 16 * nt + fr) * 512 + h * 64 + 4 * kq;
#pragma unroll
        for (int dt = 0; dt < 4; ++dt) if (!dry) *(u32x2*)(op + 16 * dt) = pk4(o[dt][nt] * inv); }
}

constexpr int QE_P = 136, TT_P = 72;
constexpr int G_QE = 0, G_KE = G_QE + 64 * QE_P * 2, G_KLT = G_KE + 64 * QE_P * 2, G_VT = G_KLT + 128 * TT_P * 2, G_ATT = G_VT + 256 * TT_P * 2,
              G_PSUM = G_ATT + 64 * TT_P * 2, G_BLAST = G_PSUM + 2048, G_DVEC = G_BLAST + 512, G_RED = G_DVEC + 512, G_DLR = G_RED + 2048, G_END = G_DLR + 4096;
static_assert(G_END <= 131072, "gla lds");
template <int MODE, bool dry = false>
__device__ __forceinline__ void gla_unit(const Args& a, LAS unsigned char* lds, int idx, int h, int tid) {
    constexpr int C = (MODE == 2) ? 32 : 64, TPT = C / 4, NTL = C / 16, KS_T = C / 32;
    const int lane = tid & 63, wave = __builtin_amdgcn_readfirstlane(tid >> 6), fr = lane & 15, kq = lane >> 4;
    LAS bf16_t* qe = (LAS bf16_t*)(lds + G_QE); LAS bf16_t* ke = (LAS bf16_t*)(lds + G_KE); LAS bf16_t* klT = (LAS bf16_t*)(lds + G_KLT);
    LAS bf16_t* vT = (LAS bf16_t*)(lds + G_VT); LAS bf16_t* att = (LAS bf16_t*)(lds + G_ATT);
    LAS float* psum = (LAS float*)(lds + G_PSUM); LAS float* blast = (LAS float*)(lds + G_BLAST); LAS float* dvec = (LAS float*)(lds + G_DVEC); LAS float* red = (LAS float*)(lds + G_RED);
    const int row0 = (MODE == 2) ? MP + idx * 32 : idx * 64;
    const bf16_t* QB = (const bf16_t*)(a.ws + A_QB); const bf16_t* KB = (const bf16_t*)(a.ws + A_KB); bf16_t* VB = (bf16_t*)(a.ws + A_VB); const bf16_t* RB = (const bf16_t*)(a.ws + A_RB);
    const float* DLR = (const float*)((const unsigned char*)a.out + Y_DLR);
    bf16_t* US = (bf16_t*)((unsigned char*)a.out + Y_US) + (size_t)(idx * 4 + h) * 32768;
    bf16x8 vraw[C / 16];
    { const int t = tid & (C - 1), g0 = tid / C;
#pragma unroll
        for (int gi = 0; gi < C / 16; ++gi) vraw[gi] = *(const bf16x8*)(VB + (size_t)(row0 + t) * 1024 + h * 256 + 8 * (g0 * (C / 16) + gi)); }
    bf16x8 sraw[4][2];
    if (MODE == 1) {
#pragma unroll
        for (int ks = 0; ks < 4; ++ks)
#pragma unroll
            for (int m = 0; m < 2; ++m) sraw[ks][m] = *(const bf16x8*)(US + (size_t)(32 * wave + 16 * m + fr) * 128 + 32 * ks + 8 * kq); }
    LAS f32x4* dlrL = (LAS f32x4*)(lds + G_DLR);
    if (tid < C * 4) dlrL[tid] = ((const f32x4*)(DLR + (size_t)row0 * 16))[tid];
    __syncthreads();
    {
        const int dk = tid & 127, tq = wave >> 1, col = h * 128 + dk;
        float wu[16];
#pragma unroll
        for (int j = 0; j < 16; ++j) wu[j] = a.in[I_WUP][j * 512 + col];
        const float bd = a.in[I_BDEC][col];
        bf16_t kraw[TPT], qraw[TPT];
#pragma unroll
        for (int i = 0; i < TPT; ++i) { const size_t gi = (size_t)(row0 + tq * TPT + i) * 512 + col; kraw[i] = KB[gi]; qraw[i] = (MODE != 0) ? QB[gi] : (bf16_t)0; }
        float bl[TPT]; float run = 0.f;
#pragma unroll
        for (int i = 0; i < TPT; ++i) { const LAS f32x4* dp = dlrL + (tq * TPT + i) * 4; float z = bd;
#pragma unroll
            for (int j4 = 0; j4 < 4; ++j4) { const f32x4 d = dp[j4]; z += d[0] * wu[4 * j4] + d[1] * wu[4 * j4 + 1] + d[2] * wu[4 * j4 + 2] + d[3] * wu[4 * j4 + 3]; }
            const float la = (fminf(z, 0.f) - __logf(1.f + __expf(-fabsf(z)))) * (1.f / 16.f);
            run += la; bl[i] = run; }
        psum[tq * 128 + dk] = run;
        __syncthreads();
        float off = 0.f, tot = 0.f;
#pragma unroll
        for (int p = 0; p < 4; ++p) { const float v = psum[p * 128 + dk]; tot += v; if (p < tq) off += v; }
        if (tq == 0) { dvec[dk] = __expf(tot); if (MODE == 0) ((float*)((unsigned char*)a.out + Y_DEC))[(size_t)(idx * 4 + h) * 128 + dk] = __expf(tot); }
#pragma unroll
        for (int i = 0; i < TPT; ++i) { const int t = tq * TPT + i; const float b = bl[i] + off;
            const float kv = bf2f(kraw[i]);
            if (MODE != 0) { const float qv = bf2f(qraw[i]); qe[t * QE_P + dk] = f2bf(qv * __expf(b)); ke[t * QE_P + dk] = f2bf(kv * __expf(-b)); }
            if (MODE != 1) klT[dk * TT_P + t] = f2bf(kv * __expf(tot - b)); }
    }
    {
        const int t = tid & (C - 1), g0 = tid / C;
#pragma unroll
        for (int gi = 0; gi < C / 16; ++gi) { const int g = g0 * (C / 16) + gi; const bf16x8 vv = vraw[gi];
#pragma unroll
            for (int j = 0; j < 8; ++j) vT[(8 * g + j) * TT_P + t] = (bf16_t)vv[j]; }
    }
    __syncthreads();
    if (MODE != 0) {
        for (int id = wave; id < NTL * NTL; id += 8) { const int ms = id / NTL, nt = id % NTL; f32x4 acc = (f32x4){0.f, 0.f, 0.f, 0.f};
#pragma unroll
            for (int ks = 0; ks < 4; ++ks) acc = MFMA16(*(const LAS bf16x8*)(ke + (16 * ms + fr) * QE_P + 32 * ks + 8 * kq), *(const LAS bf16x8*)(qe + (16 * nt + fr) * QE_P + 32 * ks + 8 * kq), acc);
            const int t = 16 * nt + fr;
#pragma unroll
            for (int i = 0; i < 4; ++i) if (16 * ms + 4 * kq + i > t) acc[i] = 0.f;
            *(LAS u32x2*)(att + t * TT_P + 16 * ms + 4 * kq) = pk4(acc); }
    }
    if (MODE != 1) {
        f32x4 u[8][2];
#pragma unroll
        for (int mt = 0; mt < 8; ++mt)
#pragma unroll
            for (int n = 0; n < 2; ++n) u[mt][n] = (f32x4){0.f, 0.f, 0.f, 0.f};
#pragma unroll
        for (int ks = 0; ks < KS_T; ++ks) { bf16x8 bv[2];
#pragma unroll
            for (int n = 0; n < 2; ++n) bv[n] = *(const LAS bf16x8*)(vT + (32 * wave + 16 * n + fr) * TT_P + 32 * ks + 8 * kq);
#pragma unroll
            for (int mt = 0; mt < 8; ++mt) { const bf16x8 av = *(const LAS bf16x8*)(klT + (16 * mt + fr) * TT_P + 32 * ks + 8 * kq);
#pragma unroll
                for (int n = 0; n < 2; ++n) u[mt][n] = MFMA16(av, bv[n], u[mt][n]); } }
        if (MODE == 0) {
#pragma unroll
            for (int mt = 0; mt < 8; ++mt)
#pragma unroll
                for (int n = 0; n < 2; ++n) *(u32x2*)(US + (size_t)(32 * wave + 16 * n + fr) * 128 + 16 * mt + 4 * kq) = pk4(u[mt][n]);
        } else {
            const float* S0 = a.in[I_ST] + (size_t)(idx * 4 + h) * 32768; float* S1 = a.out + O_SS + (size_t)(idx * 4 + h) * 32768;
#pragma unroll
            for (int mt = 0; mt < 8; ++mt)
#pragma unroll
                for (int n = 0; n < 2; ++n)
#pragma unroll
                    for (int i = 0; i < 4; ++i) { const int dk = 16 * mt + 4 * kq + i, dv = 32 * wave + 16 * n + fr; S1[dk * 256 + dv] = dvec[dk] * S0[dk * 256 + dv] + u[mt][n][i]; }
        }
    }
    if (MODE != 0) {
        __syncthreads();
        f32x4 o[2][NTL];
#pragma unroll
        for (int m = 0; m < 2; ++m)
#pragma unroll
            for (int nt = 0; nt < NTL; ++nt) o[m][nt] = (f32x4){0.f, 0.f, 0.f, 0.f};
#pragma unroll
        for (int ks = 0; ks < KS_T; ++ks) { bf16x8 av[2];
#pragma unroll
            for (int m = 0; m < 2; ++m) av[m] = *(const LAS bf16x8*)(vT + (32 * wave + 16 * m + fr) * TT_P + 32 * ks + 8 * kq);
#pragma unroll
            for (int nt = 0; nt < NTL; ++nt) { const bf16x8 bv = *(const LAS bf16x8*)(att + (16 * nt + fr) * TT_P + 32 * ks + 8 * kq);
#pragma unroll
                for (int m = 0; m < 2; ++m) o[m][nt] = MFMA16(av[m], bv, o[m][nt]); } }
#pragma unroll
        for (int ks = 0; ks < 4; ++ks) { bf16x8 av[2];
#pragma unroll
            for (int m = 0; m < 2; ++m) { const int dv = 32 * wave + 16 * m + fr;
                if (MODE == 1) av[m] = sraw[ks][m];
                else { const float* sp = a.in[I_ST] + (size_t)(idx * 4 + h) * 32768 + (size_t)(32 * ks + 8 * kq) * 256 + dv; f32x4 x0, x1;
#pragma unroll
                    for (int j = 0; j < 4; ++j) { x0[j] = sp[j * 256]; x1[j] = sp[(j + 4) * 256]; }
                    av[m] = pk8(x0, x1); } }
#pragma unroll
            for (int nt = 0; nt < NTL; ++nt) { const bf16x8 bv = *(const LAS bf16x8*)(qe + (16 * nt + fr) * QE_P + 32 * ks + 8 * kq);
#pragma unroll
                for (int m = 0; m < 2; ++m) o[m][nt] = MFMA16(av[m], bv, o[m][nt]); } }
#pragma unroll
        for (int nt = 0; nt < NTL; ++nt) { float ss = 0.f;
#pragma unroll
            for (int m = 0; m < 2; ++m) ss += (o[m][nt][0] * o[m][nt][0] + o[m][nt][1] * o[m][nt][1]) + (o[m][nt][2] * o[m][nt][2] + o[m][nt][3] * o[m][nt][3]);
            ss += __shfl_xor(ss, 16); ss += __shfl_xor(ss, 32);
            if (kq == 0) red[wave * 64 + 16 * nt + fr] = ss; }
        __syncthreads();
#pragma unroll
        for (int nt = 0; nt < NTL; ++nt) { const int t = 16 * nt + fr; float tot = 0.f;
#pragma unroll
            for (int w = 0; w < 8; ++w) tot += red[w * 64 + t];
            const float rstd = rsqrtf(tot * (1.f / 256.f) + EPS);
#pragma unroll
            for (int m = 0; m < 2; ++m) { const int dv = 32 * wave + 16 * m + 4 * kq; const size_t gi = (size_t)(row0 + t) * 1024 + h * 256 + dv;
                const f32x4 gn = *(const f32x4*)(a.in[I_GNORM] + dv); const f32x4 rb = up4(*(const u32x2*)(RB + gi));
                if (!dry) *(u32x2*)(VB + gi) = pk4(o[m][nt] * rstd * gn * rb); } }
    }
    __syncthreads();
}

template <bool DRYS = false>
__device__ __forceinline__ void scan_phase(const Args& a, int tid, int nthr, int blk, int nblk) {
    u32x2* US64 = (u32x2*)((unsigned char*)a.out + Y_US); const f32x4* DEC = (const f32x4*)((const unsigned char*)a.out + Y_DEC);
    const int per = (32768 + nblk - 1) / nblk;
    if (tid >= nthr) return;
    for (int q = tid; q < per; q += nthr) {
    const int p = blk * per + q; if (p >= 32768) break;
    const int hh = p >> 13, dv = (p >> 5) & 255, dq = p & 31; f32x4 st = (f32x4){0.f, 0.f, 0.f, 0.f};
    u32x2* up = US64 + (size_t)hh * 8192 + dv * 32 + dq; const f32x4* dp = DEC + hh * 32 + dq;
    for (int c0 = 0; c0 < 256; c0 += 8) { u32x2 u[8]; f32x4 d[8];
#pragma unroll
        for (int j = 0; j < 8; ++j) { u[j] = up[(size_t)(c0 + j) * 32768]; d[j] = dp[(c0 + j) * 128]; }
#pragma unroll
        for (int j = 0; j < 8; ++j) { if (!DRYS || st[0] == 123.456f) up[(size_t)(c0 + j) * 32768] = pk4(st); st = d[j] * st + up4(u[j]); } }
    float* so = a.out + O_SP + (size_t)(hh * 128 + 4 * dq) * 256 + dv;
    if (!DRYS || st[0] == 123.456f) { so[0] = st[0]; so[256] = st[1]; so[512] = st[2]; so[768] = st[3]; }
    }
}

#define XB_TMO      128
#define XB_XCNT(j)  (256  + 64 * (j))
#define XB_XSUB(j)  (1280 + 64 * (j))
#define XB_XGEN(j)  (2304 + 64 * (j))
#define XB_TOP      3328
#define XB_TOPGEN   3392
#define XCD_BAR_WORDS 3456
#define XB_SPIN_CAP (1u << 18)

__device__ __forceinline__ unsigned xb_ld(unsigned* p)              { return __hip_atomic_load(p, __ATOMIC_RELAXED, __HIP_MEMORY_SCOPE_AGENT); }
__device__ __forceinline__ unsigned xb_add(unsigned* p, unsigned v) { return __hip_atomic_fetch_add(p, v, __ATOMIC_RELAXED, __HIP_MEMORY_SCOPE_AGENT); }
__device__ __forceinline__ unsigned xb_xcc_id() { return (unsigned)__builtin_amdgcn_s_getreg((3 << 11) | 20) & 0xFu; }
#define XB_SPIN(cond, bar) do { unsigned _sp = 0; while (cond) { __builtin_amdgcn_s_sleep(1); \
    if ((++_sp & 255u) == 0u) { if (xb_ld(&(bar)[XB_TMO])) break; if (_sp > XB_SPIN_CAP) { atomicAdd(&(bar)[XB_TMO], 1u); break; } } } } while (0)

struct XcdBarrier {
    unsigned* bar; unsigned x;
    volatile LAS unsigned* st;
};

__device__ __forceinline__ XcdBarrier xcd_barrier_post(unsigned* bar, volatile LAS unsigned* st) {
    XcdBarrier b; b.bar = bar; b.x = xb_xcc_id(); b.st = st;
    if (threadIdx.x == 0) (void)xb_add(&bar[XB_XCNT(b.x)], 1u);
    return b;
}
__device__ __forceinline__ void xcd_barrier_complete(unsigned* bar, unsigned x, unsigned& nloc, unsigned& nx) {
    const unsigned G = gridDim.x * gridDim.y * gridDim.z;
    unsigned sum, cnt, mine, sp = 0u;
    for (;;) {
        sum = 0u; cnt = 0u; mine = 0u;
#pragma unroll
        for (unsigned j = 0; j < 16; ++j) { const unsigned c = xb_ld(&bar[XB_XCNT(j)]); sum += c; cnt += (c > 0u) ? 1u : 0u; mine = (j == x) ? c : mine; }
        if (sum == G) break;
        __builtin_amdgcn_s_sleep(1);
        if ((++sp & 255u) == 0u) { if (xb_ld(&bar[XB_TMO])) break; if (sp > XB_SPIN_CAP) { atomicAdd(&bar[XB_TMO], 1u); break; } }
    }
    nloc = mine > 0u ? mine : 1u; nx = cnt > 0u ? cnt : 1u;
}

__device__ __forceinline__ void xcd_barrier(const XcdBarrier& b) {
    asm volatile("s_waitcnt vmcnt(0)" ::: "memory");
    __syncthreads();
    if (threadIdx.x == 0) {
        unsigned* bar = b.bar;
        __builtin_amdgcn_s_waitcnt(0);
        unsigned nloc = b.st[0], nx = b.st[1];
        if (nloc == 0u) { xcd_barrier_complete(bar, b.x, nloc, nx); b.st[0] = nloc; b.st[1] = nx; }
        const unsigned old = xb_add(&bar[XB_XSUB(b.x)], 1u);
        const unsigned gen = old / nloc;
        if (old + 1u == (gen + 1u) * nloc) {
            __builtin_amdgcn_fence(__ATOMIC_RELEASE, "agent");
            asm volatile("s_waitcnt vmcnt(0)" ::: "memory");
            const unsigned og = xb_add(&bar[XB_TOP], 1u);
            const unsigned tg = og / nx;
            if (og + 1u == (tg + 1u) * nx) xb_add(&bar[XB_TOPGEN], 1u);
            else XB_SPIN(xb_ld(&bar[XB_TOPGEN]) == tg, bar);
            __builtin_amdgcn_fence(__ATOMIC_ACQUIRE, "agent");
            xb_add(&bar[XB_XGEN(b.x)], 1u);
            asm volatile("s_waitcnt vmcnt(0)" ::: "memory");
        } else {
            XB_SPIN(xb_ld(&bar[XB_XGEN(b.x)]) == gen, bar);
            __builtin_amdgcn_fence(__ATOMIC_ACQUIRE, "agent");
            asm volatile("s_waitcnt vmcnt(0)" ::: "memory");
        }
    }
    __syncthreads();
}


constexpr size_t WS_BAR = 36315136;
constexpr int NPH = 14;
__global__ void __launch_bounds__(512) fwd_kernel(Args a) {
    extern __shared__ __attribute__((aligned(16))) unsigned char lds_raw[];
    LAS unsigned char* lds = (LAS unsigned char*)lds_raw;
    const int tid = threadIdx.x, lane = tid & 63, wave = __builtin_amdgcn_readfirstlane(tid >> 6);
    const int G = gridDim.x, gw = blockIdx.x * 8 + wave, NGW = G * 8;
    cg::grid_group grid = cg::this_grid();
    volatile LAS unsigned* xst = (volatile LAS unsigned*)(lds + LDS_BYTES - 16);
    if (tid < 4) xst[tid] = 0u;
    __syncthreads();
    if (a.ph_lo == 0) { if (blockIdx.x == 0) for (int i = tid; i < XCD_BAR_WORDS; i += 512) ((unsigned*)(a.ws + WS_BAR))[i] = 0u;
        grid.sync(); (void)xcd_barrier_post((unsigned*)(a.ws + WS_BAR), xst); }
#define SEAM(k) do { XcdBarrier xb_; xb_.bar = (unsigned*)(a.ws + WS_BAR); xb_.x = xb_xcc_id(); xb_.st = (volatile LAS unsigned*)(lds + LDS_BYTES - 16); xcd_barrier(xb_); } while (0)
#define PH(k) if (a.ph_lo <= (k) && (k) < a.ph_hi) { if ((k) > a.ph_lo && (k) != 6) SEAM(k);
#define PHEND }
#define GEMM_N1024(EPI, Aoff, Woff, Mrows, Kdim, rowbase, Gn, cid, ...) do { pg8::Gemm g{(const bf16_t*)(a.ws + (Aoff)) + (size_t)(rowbase) * (Kdim), (const bf16_t*)(a.ws + (Woff)), (Mrows), 1024, (Kdim)}; \
        pg8::StaticOrder S; S.init((Mrows), 1024, (Gn), (cid)); EPI E{__VA_ARGS__, (rowbase)}; pg8::gemm_phase<EPI, pg8::StaticOrder, false, true>(lds, g, S, E); } while (0)
    const int bx = (int)blockIdx.x;
    PH(0) {
        float* rss = (float*)(a.ws + WS_RSS1);
        for (int i = bx * 512 + tid; i < 2 * MT; i += G * 512) rss[i] = 0.f;
        p0_convert(a, (LAS float*)lds + wave * (64 * 65), gw, NGW, lane);
        __syncthreads();
        p0_rows(a, lds, gw, NGW, wave, lane, tid);
    } PHEND
    PH(1) {
        pg8::Gemm g{(const bf16_t*)((const unsigned char*)a.out + Y_H), (const bf16_t*)(a.ws + WS_WIN), MT, NIN, 1024}; pg8::StaticOrder S; S.init(MT, NIN, G, bx);
        EpiIn E{a.ws, a.out}; pg8::gemm_phase<EpiIn, pg8::StaticOrder, true, true>(lds, g, S, E);
    } PHEND
    PH(2) {
        LAS float* biasL = (LAS float*)(lds + 8 * 64 * VT_PITCH * 2);
        for (int i = tid; i < 8 * 257; i += 512) biasL[i] = a.in[I_RELB][i] * 1.4426950408889634f;
        __syncthreads();
        LAS bf16_t* vT = (LAS bf16_t*)lds + wave * (64 * VT_PITCH);
        for (int u = gw; u < 256; u += NGW) attn_unit<2, true>(a, u >> 3, u & 7, 0, vT, biasL + (u & 7) * 257, lane);
        __syncthreads();
        const bool few = (G == 256) && bx < 32;
        for (int u = (G != 256) ? bx : (few ? bx : 64 + bx - 32); u < (few ? 64 : 1024 + 128); u += (G != 256) ? G : (few ? 32 : 224)) {
            if (u < 1024) gla_unit<0>(a, lds, u >> 2, u & 3, tid);
            else gla_unit<2>(a, lds, (u - 1024) >> 2, u & 3, tid); }
    } PHEND
    PH(3) {
        if (bx < 16) {
            GEMM_N1024(EpiN1024<0>, A_QA, WS_WPA, MS, 512, MP, 16, bx, (bf16_t*)(a.ws + A_GA), nullptr, nullptr);
            GEMM_N1024(EpiN1024<1>, A_VB, WS_WPB, MS, 1024, MP, 16, bx, (bf16_t*)(a.ws + A_GA), (const bf16_t*)(a.ws + A_GB), nullptr);
        } else {
            LAS float* biasL = (LAS float*)(lds + 8 * 64 * VT_PITCH * 2);
            for (int i = tid; i < 8 * 257; i += 512) biasL[i] = a.in[I_RELB][i] * 1.4426950408889634f;
            __syncthreads();
            if (wave >= 3) { LAS bf16_t* vT = (LAS bf16_t*)lds + wave * (64 * VT_PITCH);
                for (int u = (bx - 16) * 5 + (wave - 3); u < 4096; u += (G - 16) * 5) attn_unit<2, false>(a, u >> 4, u & 7, ((u >> 3) & 1) * 32, vT, biasL + (u & 7) * 257, lane); }
            else scan_phase(a, tid, 192, bx - 16, G - 16);
        }
    } PHEND
    PH(4) { for (int u = bx; u < 1024; u += G) gla_unit<1>(a, lds, u >> 2, u & 3, tid); } PHEND
    PH(5) {
        GEMM_N1024(EpiN1024<0>, A_QA, WS_WPA, MP, 512, 0, G, bx, (bf16_t*)(a.ws + A_GA), nullptr, nullptr);
        GEMM_N1024(EpiN1024<1>, A_VB, WS_WPB, MP, 1024, 0, G, bx, (bf16_t*)(a.ws + A_GA), (const bf16_t*)(a.ws + A_GB), nullptr);
    } PHEND
    PH(6) { } PHEND
    PH(7) { GEMM_N1024(EpiN1024<2>, A_GA, WS_WOUT, MP, 1024, 0, G, bx, (bf16_t*)(a.ws + A_GB), nullptr, (float*)(a.ws + WS_RSS1)); } PHEND
    PH(8) {
        if (G >= 32 && bx < 16) GEMM_N1024(EpiN1024<2>, A_GA, WS_WOUT, MS, 1024, MP, 16, bx, (bf16_t*)(a.ws + A_GB), nullptr, (float*)(a.ws + WS_RSS1));
        else if (G >= 32) row_pass1(a, 0, MP, gw - 128, NGW - 128, lane);
        else { row_pass1(a, 0, MP, gw, NGW, lane); GEMM_N1024(EpiN1024<2>, A_GA, WS_WOUT, MS, 1024, MP, G, bx, (bf16_t*)(a.ws + A_GB), nullptr, (float*)(a.ws + WS_RSS1)); }
    } PHEND
    PH(9) { row_pass1(a, MP, MT, gw, NGW, lane); } PHEND
    PH(10) {
        pg8::Gemm g{(const bf16_t*)(a.ws + A_RB), (const bf16_t*)(a.ws + WS_WGU), MT, NGU, 1024}; pg8::StaticOrder S; S.init(MT, NGU, G, bx);
        EpiSwiglu E{(bf16_t*)(a.ws + A_HID)}; pg8::gemm_phase<EpiSwiglu, pg8::StaticOrder, true, true>(lds, g, S, E);
    } PHEND
    PH(11) { GEMM_N1024(EpiN1024<2>, A_HID, WS_WDN, MP, DFF, 0, G, bx, (bf16_t*)(a.ws + A_GA), nullptr, (float*)(a.ws + WS_RSS2)); } PHEND
    PH(12) {
        if (G >= 32 && bx < 16) GEMM_N1024(EpiN1024<2>, A_HID, WS_WDN, MS, DFF, MP, 16, bx, (bf16_t*)(a.ws + A_GA), nullptr, (float*)(a.ws + WS_RSS2));
        else if (G >= 32) row_pass2(a, 0, MP, gw - 128, NGW - 128, lane);
        else { row_pass2(a, 0, MP, gw, NGW, lane); GEMM_N1024(EpiN1024<2>, A_HID, WS_WDN, MS, DFF, MP, G, bx, (bf16_t*)(a.ws + A_GA), nullptr, (float*)(a.ws + WS_RSS2)); }
    } PHEND
    PH(13) { row_pass2(a, MP, MT, gw, NGW, lane); } PHEND
}

extern "C" void kernel_launch(void* const* d_in, const int* in_sizes, int n_in, void* d_out, int out_size, void* d_ws, size_t ws_size, hipStream_t stream) {
    static int grid = 0;
    if (grid == 0) {
        if (n_in != 20 || ws_size < A_END || out_size != 23724032) { fprintf(stderr, "kernel_launch: unexpected sizes n_in %d ws %zu out %d\n", n_in, ws_size, out_size); }
        int dev = 0, cus = 0, per_cu = 0;
        hipGetDevice(&dev); hipDeviceGetAttribute(&cus, hipDeviceAttributeMultiprocessorCount, dev);
        hipFuncSetAttribute((const void*)fwd_kernel, hipFuncAttributeMaxDynamicSharedMemorySize, LDS_BYTES);
        hipOccupancyMaxActiveBlocksPerMultiprocessor(&per_cu, (const void*)fwd_kernel, 512, LDS_BYTES);
        if (per_cu < 1) { fprintf(stderr, "kernel_launch: occupancy query says %d blocks per CU\n", per_cu); per_cu = 1; }
        grid = cus * 1;
        (void)hipGetLastError();
    }
    Args a{};
    for (int i = 0; i < 20; ++i) a.in[i] = (const float*)d_in[i];
    a.out = (float*)d_out; a.ws = (unsigned char*)d_ws;
    a.ph_lo = 0; a.ph_hi = NPH;
    void* args[] = {&a};
    hipError_t e = hipLaunchCooperativeKernel((const void*)fwd_kernel, dim3(grid), dim3(512), args, LDS_BYTES, stream);
    if (e != hipSuccess) fprintf(stderr, "cooperative launch failed: %s (grid %d)\n", hipGetErrorString(e), grid);
}
```

```cpp
#include <hip/hip_runtime.h>
#include <hip/hip_cooperative_groups.h>
#include <cstdio>
namespace cg = cooperative_groups;

#define LAS __attribute__((address_space(3)))
typedef unsigned short bf16_t;
typedef short bf16x8 __attribute__((ext_vector_type(8)));
typedef float f32x4 __attribute__((ext_vector_type(4)));
typedef float f32x2 __attribute__((ext_vector_type(2)));
typedef unsigned u32x4 __attribute__((ext_vector_type(4)));
typedef unsigned u32x2 __attribute__((ext_vector_type(2)));

constexpr int MP = 16384, MS = 1024, MT = MP + MS, DM = 1024, DIN = 6672, NIN = 6656, DFF = 2816, NGU = 2 * DFF;
constexpr float EPS = 1e-6f;
constexpr size_t O_Y = 0, O_KP = 17825792, O_VP = 18087936, O_SP = 18350080, O_KS = 18481152, O_VS = 19005440, O_SS = 19529728;
constexpr size_t WS_WIN = 0, WS_WPA = 13631488, WS_WPB = 14680064, WS_WOUT = 16777216, WS_WGU = 18874368, WS_WDN = 30408704, WS_RSS1 = 36175872, WS_RSS2 = WS_RSS1 + 69632;
constexpr size_t WS_ACT = 36700160;
constexpr size_t A_QA = WS_ACT, A_KA = A_QA + 17825792, A_VA = A_KA + 17825792, A_QB = A_VA + 17825792, A_KB = A_QB + 17825792, A_VB = A_KB + 17825792,
                 A_RB = A_VB + 35651584, A_GA = A_RB + 35651584, A_GB = A_GA + 35651584, A_END = A_GB + 35651584, A_HID = A_QA;
static_assert(A_END == 268435456, "ws map");
constexpr size_t Y_H = 0, Y_US = 0, Y_DLR = 67108864, Y_DEC = Y_DLR + 1114112;
static_assert(Y_DEC + 524288 <= 71303168, "y scratch");

typedef __bf16 bf16x2_t __attribute__((ext_vector_type(2)));
__device__ __forceinline__ unsigned cvt_pk_bf16(float lo, float hi) { f32x2 v = {lo, hi}; bf16x2_t b = __builtin_convertvector(v, bf16x2_t); return __builtin_bit_cast(unsigned, b); }
__device__ __forceinline__ float bf_lo(unsigned u) { return __uint_as_float(u << 16); }
__device__ __forceinline__ float bf_hi(unsigned u) { return __uint_as_float(u & 0xffff0000u); }
__device__ __forceinline__ float bf2f(bf16_t b) { return __uint_as_float(((unsigned)b) << 16); }
__device__ __forceinline__ bf16_t f2bf(float f) { return (bf16_t)(cvt_pk_bf16(f, 0.f) & 0xffffu); }
__device__ __forceinline__ float wave_sum(float v) { for (int o = 32; o >= 1; o >>= 1) v += __shfl_xor(v, o); return v; }
__device__ __forceinline__ void wave_lds_sync() { asm volatile("s_waitcnt lgkmcnt(0)" ::: "memory"); __builtin_amdgcn_wave_barrier(); }
__device__ __forceinline__ float fast_sigmoid(float x) { return __builtin_amdgcn_rcpf(1.0f + __expf(-x)); }
__device__ __forceinline__ bf16x8 mk8(u32x2 a, u32x2 b) { u32x4 w; w.x = a.x; w.y = a.y; w.z = b.x; w.w = b.y; return __builtin_bit_cast(bf16x8, w); }
__device__ __forceinline__ bf16x8 pk8(f32x4 a, f32x4 b) { u32x4 w; w.x = cvt_pk_bf16(a[0], a[1]); w.y = cvt_pk_bf16(a[2], a[3]); w.z = cvt_pk_bf16(b[0], b[1]); w.w = cvt_pk_bf16(b[2], b[3]); return __builtin_bit_cast(bf16x8, w); }
#define MFMA16(a, b, c) __builtin_amdgcn_mfma_f32_16x16x32_bf16((a), (b), (c), 0, 0, 0)

namespace pg8 {
#define PG8_LAS __attribute__((address_space(3)))
constexpr int BM = 256, BK = 64, HALF = 128, HTB = HALF * BK * 2, STAGE_BYTES = 8 * HTB, NXCD = 8, WGM = 8;
__host__ __device__ __forceinline__ int lds_byte(int r, int c) { const int st = (r >> 4) * 2 + (c >> 5), rr = r & 15, cc = c & 31, ob = rr * 64 + cc * 2; return st * 1024 + (ob ^ (((ob >> 9) & 1) << 5)); }
__host__ __device__ __forceinline__ void stage_rc(int b, int& R, int& C) { const int st = b / 1024, sb = b % 1024, swz = sb ^ (((sb >> 9) & 1) << 5); R = (st >> 1) * 16 + swz / 64; C = (st & 1) * 32 + (swz % 64) / 2; }
__host__ __device__ __forceinline__ int perm32(int rho) { const int n = rho >> 4, i = rho & 15; return 8 * (i >> 2) + 4 * n + (i & 3); }
struct Unit { int pm, pn; };
struct Gemm { const bf16_t* A; const bf16_t* Bt; int M, N, K; };
struct StaticOrder {
    int nM, nN, nwg, G, c;
    __host__ __device__ void init(int M, int N, int G_, int c_) { nM = M / BM; nN = N / BM; nwg = nM * nN; G = G_; c = c_; }
    __host__ __device__ bool next(int i, Unit& u) const {
        const long L = (long)i * G + c; if (L >= nwg) return false;
        int wgid = (int)L; { const int q = nwg / NXCD, r = nwg % NXCD, xcd = wgid % NXCD, off = wgid / NXCD; wgid = (xcd < r ? xcd * (q + 1) : r * (q + 1) + (xcd - r) * q) + off; }
        const int nig = WGM * nN, gid = wgid / nig, fm = gid * WGM, gsz = (nM - fm) < WGM ? (nM - fm) : WGM;
        u.pm = fm + ((wgid % nig) % gsz); u.pn = (wgid % nig) / gsz; return true;
    }
    __device__ __forceinline__ void a_ready(const Unit&) const {}
    __device__ __forceinline__ void done(const Unit&) const {}
};
template <class Epi, class Sched, bool ALIGN_EPI = false, bool SP2 = false>
__device__ __forceinline__ void gemm_phase(PG8_LAS unsigned char* lds, const Gemm g, const Sched& S, const Epi& E) {
    const int tid = threadIdx.x, wid = __builtin_amdgcn_readfirstlane(tid >> 6), lane = tid & 63, wr = wid >> 2, wc = wid & 3, fr = lane & 15, fq = lane >> 4;
    const int K = g.K, nt = K / BK;
    unsigned voffA[2], voffB[2];
#pragma unroll
    for (int i = 0; i < 2; ++i) { int R, C; stage_rc(tid * 16 + i * 8192, R, C); const int Rb = Epi::PERM ? ((R & ~31) + perm32(R & 31)) : R;
        voffA[i] = (unsigned)(R * K + C) * 2u; voffB[i] = (unsigned)(Rb * K + C) * 2u; }
    const size_t kstep = (size_t)(BK * 2);
    const size_t hstep = (size_t)HALF * K * 2;
    const size_t tstep = 2 * hstep;
    const unsigned ldsw = (unsigned)wid * 1024u;
    const int aoff = lds_byte(wr * 64 + fr, fq * 8), boff = lds_byte(wc * 32 + fr, fq * 8);
#define PG8_SA(b, h) (((b) * 2 + (h)) * HTB)
#define PG8_SB(b, h) ((4 + (b) * 2 + (h)) * HTB)
#define PG8_STAGE(bufoff, gbase, voff) do { _Pragma("unroll") for (int _i = 0; _i < 2; ++_i) \
        __builtin_amdgcn_global_load_lds((const unsigned*)((const char*)(gbase) + (voff)[_i]), (PG8_LAS unsigned*)(lds + (bufoff) + ldsw + _i * 8192), 16, 0, 0); } while (0)
#define PG8_LDA(dst, b, h) do { _Pragma("unroll") for (int m = 0; m < 4; ++m) _Pragma("unroll") for (int k = 0; k < 2; ++k) dst[m][k] = *(const PG8_LAS bf16x8*)(lds + PG8_SA(b, h) + aoff + m * 2048 + k * 1024); } while (0)
#define PG8_LDB(dst, b, h) do { _Pragma("unroll") for (int n = 0; n < 2; ++n) _Pragma("unroll") for (int k = 0; k < 2; ++k) dst[n][k] = *(const PG8_LAS bf16x8*)(lds + PG8_SB(b, h) + boff + n * 2048 + k * 1024); } while (0)
#define PG8_MMA(ai, bj, At, Bt) do { __builtin_amdgcn_s_setprio(1); _Pragma("unroll") for (int m = 0; m < 4; ++m) _Pragma("unroll") for (int n = 0; n < 2; ++n) _Pragma("unroll") for (int k = 0; k < 2; ++k) \
        acc[ai][bj][m][n] = __builtin_amdgcn_mfma_f32_16x16x32_bf16(Bt[n][k], At[m][k], acc[ai][bj][m][n], 0, 0, 0); __builtin_amdgcn_s_setprio(0); } while (0)
#define PG8_WAIT_V(n) asm volatile("s_waitcnt vmcnt(" #n ")" ::: "memory")
#define PG8_WAIT_L(n) asm volatile("s_waitcnt lgkmcnt(" #n ")" ::: "memory")
#define PG8_BAR __builtin_amdgcn_s_barrier()
#define PG8_SCHED __builtin_amdgcn_sched_barrier(0)
    Unit cur, nxt; int ui = 0;
    if (!S.next(0, cur)) return;
    f32x4 acc[2][2][4][2];
#pragma unroll
    for (int a = 0; a < 2; ++a)
#pragma unroll
        for (int b = 0; b < 2; ++b)
#pragma unroll
            for (int m = 0; m < 4; ++m)
#pragma unroll
                for (int n = 0; n < 2; ++n) acc[a][b][m][n] = (f32x4){0.f, 0.f, 0.f, 0.f};
    bf16x8 At[4][2], B0[2][2], B1[2][2];
    const char* cA = (const char*)g.A + (size_t)cur.pm * tstep; const char* cB = (const char*)g.Bt + (size_t)cur.pn * tstep;
    S.a_ready(cur);
    if constexpr (SP2) {
        PG8_STAGE(PG8_SB(0, 0), cB, voffB); PG8_STAGE(PG8_SB(0, 1), cB + hstep, voffB); PG8_STAGE(PG8_SA(0, 0), cA, voffA); PG8_STAGE(PG8_SA(0, 1), cA + hstep, voffA);
        if (wr == 1) PG8_BAR;
        PG8_WAIT_V(2); PG8_BAR;
        PG8_STAGE(PG8_SB(1, 0), cB + kstep, voffB); PG8_STAGE(PG8_SA(1, 0), cA + kstep, voffA); PG8_STAGE(PG8_SB(1, 1), cB + hstep + kstep, voffB);
        PG8_WAIT_V(6); PG8_BAR;
    } else {
        PG8_STAGE(PG8_SB(0, 0), cB, voffB); PG8_STAGE(PG8_SA(0, 0), cA, voffA); PG8_STAGE(PG8_SB(0, 1), cB + hstep, voffB); PG8_STAGE(PG8_SA(0, 1), cA + hstep, voffA);
        if (wr == 1) PG8_BAR;
        PG8_WAIT_V(4); PG8_BAR;
        PG8_STAGE(PG8_SB(1, 0), cB + kstep, voffB); PG8_STAGE(PG8_SA(1, 0), cA + kstep, voffA); PG8_STAGE(PG8_SB(1, 1), cB + hstep + kstep, voffB);
        PG8_WAIT_V(6); PG8_BAR;
    }
    for (;;) {
        const bool has_next = S.next(ui + 1, nxt);
        const char* nA = has_next ? (const char*)g.A + (size_t)nxt.pm * tstep : cA; const char* nB = has_next ? (const char*)g.Bt + (size_t)nxt.pn * tstep : cB;
        for (int t = 0; t < nt; t += 2) {
            const bool last = (t == nt - 2);
            const char* a1 = cA + (size_t)(t + 1) * kstep;
            const char* a2 = last ? nA : cA + (size_t)(t + 2) * kstep; const char* b2 = last ? nB : cB + (size_t)(t + 2) * kstep;
            const char* a3 = a2 + kstep; const char* b3 = b2 + kstep;
            if (last && has_next) S.a_ready(nxt);
            if constexpr (SP2) {
            PG8_LDB(B0, 0, 0); PG8_LDB(B1, 0, 1); PG8_SCHED; PG8_LDA(At, 0, 0); PG8_STAGE(PG8_SA(1, 1), a1 + hstep, voffA);
            PG8_WAIT_V(8); PG8_WAIT_L(0); PG8_BAR; PG8_MMA(0, 0, At, B0); PG8_MMA(0, 1, At, B1); PG8_BAR; PG8_SCHED;
            PG8_LDA(At, 0, 1); PG8_STAGE(PG8_SB(0, 0), b2, voffB); PG8_STAGE(PG8_SB(0, 1), b2 + hstep, voffB); PG8_STAGE(PG8_SA(0, 0), a2, voffA);
            PG8_WAIT_V(8); PG8_WAIT_L(0); PG8_BAR; PG8_MMA(1, 0, At, B0); PG8_MMA(1, 1, At, B1); PG8_BAR; PG8_SCHED;
            PG8_LDB(B0, 1, 0); PG8_LDB(B1, 1, 1); PG8_SCHED; PG8_LDA(At, 1, 0); PG8_STAGE(PG8_SA(0, 1), a2 + hstep, voffA);
            PG8_WAIT_V(8); PG8_WAIT_L(0); PG8_BAR; PG8_MMA(0, 0, At, B0); PG8_MMA(0, 1, At, B1); PG8_BAR; PG8_SCHED;
            PG8_LDA(At, 1, 1); PG8_STAGE(PG8_SB(1, 0), b3, voffB); PG8_STAGE(PG8_SB(1, 1), b3 + hstep, voffB); PG8_STAGE(PG8_SA(1, 0), a3, voffA);
            PG8_WAIT_V(8); PG8_WAIT_L(0); PG8_BAR; PG8_MMA(1, 0, At, B0); PG8_MMA(1, 1, At, B1); PG8_BAR; PG8_SCHED;
            } else {
            PG8_LDB(B0, 0, 0); PG8_SCHED; PG8_LDA(At, 0, 0); PG8_STAGE(PG8_SA(1, 1), a1 + hstep, voffA);
            PG8_WAIT_L(8); PG8_BAR; PG8_WAIT_L(0); PG8_MMA(0, 0, At, B0); PG8_BAR; PG8_SCHED;
            PG8_LDB(B1, 0, 1); PG8_STAGE(PG8_SB(0, 0), b2, voffB);
            PG8_BAR; PG8_WAIT_L(0); PG8_MMA(0, 1, At, B1); PG8_BAR;
            PG8_LDA(At, 0, 1); PG8_STAGE(PG8_SA(0, 0), a2, voffA);
            PG8_BAR; PG8_WAIT_L(0); PG8_MMA(1, 0, At, B0); PG8_BAR; PG8_SCHED;
            PG8_STAGE(PG8_SB(0, 1), b2 + hstep, voffB);
            PG8_WAIT_V(6); PG8_BAR; PG8_MMA(1, 1, At, B1); PG8_BAR;
            PG8_LDB(B0, 1, 0); PG8_SCHED; PG8_LDA(At, 1, 0); PG8_STAGE(PG8_SA(0, 1), a2 + hstep, voffA);
            PG8_WAIT_L(8); PG8_BAR; PG8_WAIT_L(0); PG8_MMA(0, 0, At, B0); PG8_BAR; PG8_SCHED;
            PG8_LDB(B1, 1, 1); PG8_STAGE(PG8_SB(1, 0), b3, voffB);
            PG8_BAR; PG8_WAIT_L(0); PG8_MMA(0, 1, At, B1); PG8_BAR;
            PG8_LDA(At, 1, 1); PG8_STAGE(PG8_SA(1, 0), a3, voffA);
            PG8_BAR; PG8_WAIT_L(0); PG8_MMA(1, 0, At, B0); PG8_BAR; PG8_SCHED;
            PG8_STAGE(PG8_SB(1, 1), b3 + hstep, voffB);
            PG8_WAIT_V(6); PG8_BAR; PG8_MMA(1, 1, At, B1); PG8_BAR;
            }
        }
        if constexpr (ALIGN_EPI) { if (wr == 0) PG8_BAR; }
        if constexpr (!Epi::AFTER_DRAIN) { E(acc, cur, wr, wc, fr, fq); S.done(cur); }
        if (!has_next) break;
#pragma unroll
        for (int a = 0; a < 2; ++a)
#pragma unroll
            for (int b = 0; b < 2; ++b)
#pragma unroll
                for (int m = 0; m < 4; ++m)
#pragma unroll
                    for (int n = 0; n < 2; ++n) acc[a][b][m][n] = (f32x4){0.f, 0.f, 0.f, 0.f};
        cur = nxt; cA = nA; cB = nB; ++ui;
        if constexpr (ALIGN_EPI) { if (wr == 1) PG8_BAR; }
    }
    PG8_WAIT_V(0);
    if constexpr (!ALIGN_EPI) { if (wr == 0) PG8_BAR; }
    PG8_BAR;
    if constexpr (Epi::AFTER_DRAIN) { E.fused(acc, cur, wr, wc, fr, fq, lds, wid, lane); S.done(cur); }
#undef PG8_SA
#undef PG8_SB
#undef PG8_STAGE
#undef PG8_LDA
#undef PG8_LDB
#undef PG8_MMA
#undef PG8_WAIT_V
#undef PG8_WAIT_L
#undef PG8_BAR
#undef PG8_SCHED
}
}

typedef f32x4 AccT[2][2][4][2];
__device__ __forceinline__ u32x2 pk4(f32x4 v) { u32x2 w; w.x = cvt_pk_bf16(v[0], v[1]); w.y = cvt_pk_bf16(v[2], v[3]); return w; }
__device__ __forceinline__ f32x4 up4(u32x2 w) { return (f32x4){bf_lo(w.x), bf_hi(w.x), bf_lo(w.y), bf_hi(w.y)}; }

struct EpiIn {
    static constexpr bool PERM = true, AFTER_DRAIN = false;
    unsigned char* ws; float* out;
    __device__ __forceinline__ void operator()(const AccT& acc, const pg8::Unit& u, int wr, int wc, int fr, int fq) const {
        const int pn = u.pn; size_t off; int ldc = 512, cb, mode = 0, kv = 0; float scale = 1.f;
        if (pn < 2) { off = A_QA; cb = pn; mode = 1; scale = 0.125f * 1.4426950408889634f; }
        else if (pn < 4) { off = A_KA; cb = pn - 2; kv = 1; }
        else if (pn < 6) { off = A_VA; cb = pn - 4; kv = 2; }
        else if (pn < 8) { off = A_QB; cb = pn - 6; mode = 1; scale = 0.08838834764831845f; }
        else if (pn < 10) { off = A_KB; cb = pn - 8; }
        else if (pn < 14) { off = A_VB; cb = pn - 10; ldc = 1024; }
        else if (pn < 18) { off = A_RB; cb = pn - 14; ldc = 1024; mode = 2; }
        else if (pn < 22) { off = A_GA; cb = pn - 18; ldc = 1024; mode = 3; }
        else { off = A_GB; cb = pn - 22; ldc = 1024; mode = 3; }
        bf16_t* dst = (bf16_t*)(ws + off);
        const int col0 = cb * 256 + wc * 32 + 8 * fq, row0 = u.pm * 256 + wr * 64 + fr;
        const bool f32out = (kv != 0) && (u.pm >= 62);
        float* ob = nullptr;
        if (f32out) ob = (u.pm < 64) ? out + (kv == 1 ? O_KP : O_VP) - (size_t)15872 * 512 : out + (kv == 1 ? O_KS : O_VS) - (size_t)16384 * 512;
#pragma unroll
        for (int ai = 0; ai < 2; ++ai)
#pragma unroll
            for (int m = 0; m < 4; ++m) { const int row = row0 + ai * 128 + m * 16;
#pragma unroll
                for (int bj = 0; bj < 2; ++bj) { f32x4 v0 = acc[ai][bj][m][0], v1 = acc[ai][bj][m][1]; const int col = col0 + bj * 128;
                    if (f32out) { float* o = ob + (size_t)row * 512 + col; *(f32x4*)o = v0; *(f32x4*)(o + 4) = v1; }
                    if (mode == 1) { v0 = v0 * scale; v1 = v1 * scale; }
                    else if (mode == 2) { for (int j = 0; j < 4; ++j) { v0[j] = v0[j] * fast_sigmoid(v0[j]); v1[j] = v1[j] * fast_sigmoid(v1[j]); } }
                    else if (mode == 3) { for (int j = 0; j < 4; ++j) { v0[j] = fast_sigmoid(v0[j]); v1[j] = fast_sigmoid(v1[j]); } }
                    *(bf16x8*)(dst + (size_t)row * ldc + col) = pk8(v0, v1); }
                asm volatile("" ::: "memory"); }
    }
};
template <int MODE, bool DRYE = false> struct EpiN1024 {
    static constexpr bool PERM = false, AFTER_DRAIN = false;
    bf16_t* io; const bf16_t* g2; float* rowss; int row_base;
    __device__ __forceinline__ void operator()(const AccT& acc, const pg8::Unit& u, int wr, int wc, int fr, int fq) const {
        const int col0 = u.pn * 256 + wc * 32 + 4 * fq, row0 = row_base + u.pm * 256 + wr * 64 + fr;
#pragma unroll
        for (int ai = 0; ai < 2; ++ai)
#pragma unroll
            for (int m = 0; m < 4; ++m) { const int row = row0 + ai * 128 + m * 16; float ss = 0.f;
#pragma unroll
                for (int bj = 0; bj < 2; ++bj)
#pragma unroll
                    for (int n = 0; n < 2; ++n) { f32x4 v = acc[ai][bj][m][n]; const size_t idx = (size_t)row * 1024 + col0 + bj * 128 + n * 16;
                        if (MODE == 0) v = v * up4(*(const u32x2*)(io + idx));
                        else if (MODE == 1) v = up4(*(const u32x2*)(io + idx)) + up4(*(const u32x2*)(g2 + idx)) * v;
                        else ss += (v[0] * v[0] + v[1] * v[1]) + (v[2] * v[2] + v[3] * v[3]);
                        if (!DRYE || v[0] == 123.456f) *(u32x2*)(io + idx) = pk4(v); }
                if (MODE == 2 && !DRYE) { ss += __shfl_xor(ss, 16); ss += __shfl_xor(ss, 32); if (fq == 0) atomicAdd(rowss + row, ss); } }
    }
};
template <int MODE> using EpiN1024D = EpiN1024<MODE, true>;
struct EpiSwiglu {
    static constexpr bool PERM = true, AFTER_DRAIN = false;
    bf16_t* hid;
    __device__ __forceinline__ void operator()(const AccT& acc, const pg8::Unit& u, int wr, int wc, int fr, int fq) const {
        const int col0 = u.pn * 128 + wc * 32 + 8 * fq, row0 = u.pm * 256 + wr * 64 + fr;
#pragma unroll
        for (int ai = 0; ai < 2; ++ai)
#pragma unroll
            for (int m = 0; m < 4; ++m) { const int row = row0 + ai * 128 + m * 16; f32x4 v0, v1;
#pragma unroll
                for (int j = 0; j < 4; ++j) { const float g0 = acc[ai][0][m][0][j], g1 = acc[ai][0][m][1][j];
                    v0[j] = g0 * fast_sigmoid(g0) * acc[ai][1][m][0][j]; v1[j] = g1 * fast_sigmoid(g1) * acc[ai][1][m][1][j]; }
                *(bf16x8*)(hid + (size_t)row * DFF + col0) = pk8(v0, v1); }
    }
};

struct Args { const float* in[20]; float* out; unsigned char* ws; int ph_lo, ph_hi; };
enum { I_XP = 0, I_XS, I_CK, I_CV, I_ST, I_NMPRE, I_NMPOST, I_NFPRE, I_NFPOST, I_WIN, I_WUP, I_BDEC, I_RELB, I_GNORM, I_WPA, I_WPB, I_WOUT, I_WG, I_WU, I_WD };
constexpr int LDS_BYTES = 147456;

__device__ __forceinline__ void p0_convert(const Args& a, LAS float* scr, int gw, int NGW, int lane) {
    constexpr int I_IN = 104 * 16, I_PA = 16 * 8, I_PB = 16 * 16, I_OUT = 16 * 16, I_GU = 88 * 16, I_DN = 16 * 44, TOTAL = I_IN + I_PA + I_PB + I_OUT + I_GU + I_DN;
    for (int it = gw; it < TOTAL; it += NGW) {
        int r = it, kind, K; size_t dsto;
        if (r < I_IN) { kind = 0; K = 1024; dsto = WS_WIN; }
        else if ((r -= I_IN) < I_PA) { kind = 1; K = 512; dsto = WS_WPA; }
        else if ((r -= I_PA) < I_PB) { kind = 2; K = 1024; dsto = WS_WPB; }
        else if ((r -= I_PB) < I_OUT) { kind = 3; K = 1024; dsto = WS_WOUT; }
        else if ((r -= I_OUT) < I_GU) { kind = 4; K = 1024; dsto = WS_WGU; }
        else { r -= I_GU; kind = 5; K = 2816; dsto = WS_WDN; }
        const int ktiles = K >> 6, n0 = (r / ktiles) * 64, k0 = (r % ktiles) * 64, n = n0 + lane;
        const float* sp; int srcN;
        if (kind == 0) { sp = a.in[I_WIN] + (n < 4608 ? n : n + 16); srcN = DIN; }
        else if (kind == 1) { sp = a.in[I_WPA] + n; srcN = 1024; }
        else if (kind == 2) { sp = a.in[I_WPB] + n; srcN = 1024; }
        else if (kind == 3) { sp = a.in[I_WOUT] + n; srcN = 1024; }
        else if (kind == 4) { const int pn = n >> 8, rr = n & 255; sp = ((rr < 128) ? a.in[I_WG] : a.in[I_WU]) + 128 * pn + (rr & 127); srcN = DFF; }
        else { sp = a.in[I_WD] + n; srcN = 1024; }
        sp += (size_t)k0 * srcN;
        float tmp[64];
#pragma unroll
        for (int i = 0; i < 64; ++i) tmp[i] = sp[(size_t)i * srcN];
#pragma unroll
        for (int i = 0; i < 64; ++i) scr[lane * 65 + i] = tmp[i];
        wave_lds_sync();
        unsigned* dst = (unsigned*)(a.ws + dsto) + ((size_t)n0 * K + k0) / 2 + (lane & 31);
#pragma unroll 8
        for (int j = 0; j < 32; ++j) { const int row = 2 * j + (lane >> 5), kk = (lane & 31) * 2; dst[(size_t)row * (K / 2)] = cvt_pk_bf16(scr[row * 65 + kk], scr[row * 65 + kk + 1]); }
        wave_lds_sync();
    }
}
__device__ __forceinline__ const float* xrow_ptr(const Args& a, int row) { return row < MP ? a.in[I_XP] + (size_t)row * DM : a.in[I_XS] + (size_t)(row - MP) * DM; }
__device__ __forceinline__ void p0_rows(const Args& a, LAS unsigned char* lds, int gw, int NGW, int wave, int lane, int tid) {
    LAS float* WdL = (LAS float*)lds;
    LAS float* hrow = (LAS float*)(lds + 4 * 4112 * 4) + wave * 1056;
    for (int idx = tid; idx < 1024 * 16; idx += 512) { const int k = idx >> 4, j = idx & 15; WdL[(k >> 8) * 4112 + (k & 255) * 16 + j] = a.in[I_WIN][(size_t)k * DIN + 4608 + j]; }
    __syncthreads();
    bf16_t* H = (bf16_t*)((unsigned char*)a.out + Y_H); float* DLR = (float*)((unsigned char*)a.out + Y_DLR);
    const f32x4* gp = (const f32x4*)a.in[I_NMPRE] + lane; f32x4 g[4];
#pragma unroll
    for (int j = 0; j < 4; ++j) g[j] = gp[64 * j];
    for (int row = gw; row < MT; row += NGW) {
        const f32x4* xr = (const f32x4*)xrow_ptr(a, row) + lane; f32x4 v[4]; float s = 0.f;
#pragma unroll
        for (int j = 0; j < 4; ++j) { v[j] = xr[64 * j]; s += (v[j][0] * v[j][0] + v[j][1] * v[j][1]) + (v[j][2] * v[j][2] + v[j][3] * v[j][3]); }
        const float rstd = rsqrtf(wave_sum(s) * (1.f / DM) + EPS);
        u32x2* ho = (u32x2*)(H + (size_t)row * DM) + lane;
#pragma unroll
        for (int j = 0; j < 4; ++j) { v[j] = v[j] * rstd * g[j]; ho[64 * j] = pk4(v[j]); *(LAS f32x4*)(hrow + j * 264 + 4 * lane) = v[j]; }
        wave_lds_sync();
        const int jj = lane & 15, p = lane >> 4; float acc = 0.f;
        const LAS float* hp = hrow + p * 264; const LAS float* wp = WdL + p * 4112 + jj;
#pragma unroll 8
        for (int kk = 0; kk < 256; ++kk) acc += hp[kk] * wp[kk * 16];
        acc += __shfl_xor(acc, 16); acc += __shfl_xor(acc, 32);
        if (lane < 16) DLR[(size_t)row * 16 + jj] = acc;
        wave_lds_sync();
    }
}

__device__ __forceinline__ void row_pass1(const Args& a, int row_lo, int row_hi, int gw, int NGW, int lane) {
    const bf16_t* Y = (const bf16_t*)(a.ws + A_GB); bf16_t* A2 = (bf16_t*)(a.ws + A_RB); const float* rss = (const float*)(a.ws + WS_RSS1); float* XO = a.out + O_Y;
    f32x4 gp[4], gq[4];
#pragma unroll
    for (int j = 0; j < 4; ++j) { gp[j] = ((const f32x4*)a.in[I_NMPOST])[lane + 64 * j]; gq[j] = ((const f32x4*)a.in[I_NFPRE])[lane + 64 * j]; }
    for (int r0 = row_lo + 2 * gw; r0 < row_hi; r0 += 2 * NGW) {
        f32x4 xv[2][4]; u32x2 yv[2][4]; float rs[2];
#pragma unroll
        for (int r = 0; r < 2; ++r) { const int row = (r0 + r < row_hi) ? r0 + r : r0; rs[r] = rss[row];
            const f32x4* xr = (const f32x4*)xrow_ptr(a, row) + lane; const u32x2* yr = (const u32x2*)(Y + (size_t)row * DM) + lane;
#pragma unroll
            for (int j = 0; j < 4; ++j) { xv[r][j] = xr[64 * j]; yv[r][j] = yr[64 * j]; } }
#pragma unroll
        for (int r = 0; r < 2; ++r) { const int row = r0 + r; if (row >= row_hi) break;
            const float rstd = rsqrtf(rs[r] * (1.f / DM) + EPS); f32x4 v[4]; float s = 0.f;
#pragma unroll
            for (int j = 0; j < 4; ++j) { v[j] = xv[r][j] + up4(yv[r][j]) * rstd * gp[j]; s += (v[j][0] * v[j][0] + v[j][1] * v[j][1]) + (v[j][2] * v[j][2] + v[j][3] * v[j][3]); }
            const float rstd2 = rsqrtf(wave_sum(s) * (1.f / DM) + EPS);
            f32x4* xo = (f32x4*)(XO + (size_t)row * DM) + lane; u32x2* ao = (u32x2*)(A2 + (size_t)row * DM) + lane;
#pragma unroll
            for (int j = 0; j < 4; ++j) { xo[64 * j] = v[j]; ao[64 * j] = pk4(v[j] * rstd2 * gq[j]); } }
    }
}
template <bool DRYR = false>
__device__ __forceinline__ void row_pass2(const Args& a, int row_lo, int row_hi, int gw, int NGW, int lane) {
    const bf16_t* F = (const bf16_t*)(a.ws + A_GA); const float* rss = (const float*)(a.ws + WS_RSS2); float* XO = a.out + O_Y;
    f32x4 gp[4];
#pragma unroll
    for (int j = 0; j < 4; ++j) gp[j] = ((const f32x4*)a.in[I_NFPOST])[lane + 64 * j];
    for (int r0 = row_lo + 2 * gw; r0 < row_hi; r0 += 2 * NGW) {
        f32x4 xv[2][4]; u32x2 fv[2][4]; float rs[2];
#pragma unroll
        for (int r = 0; r < 2; ++r) { const int row = (r0 + r < row_hi) ? r0 + r : r0; rs[r] = rss[row];
            const f32x4* xo = (const f32x4*)(XO + (size_t)row * DM) + lane; const u32x2* fr = (const u32x2*)(F + (size_t)row * DM) + lane;
#pragma unroll
            for (int j = 0; j < 4; ++j) { xv[r][j] = xo[64 * j]; fv[r][j] = fr[64 * j]; } }
#pragma unroll
        for (int r = 0; r < 2; ++r) { const int row = r0 + r; if (row >= row_hi) break;
            const float rstd = rsqrtf(rs[r] * (1.f / DM) + EPS); f32x4* xo = (f32x4*)(XO + (size_t)row * DM) + lane;
#pragma unroll
            for (int j = 0; j < 4; ++j) { const f32x4 o = xv[r][j] + up4(fv[r][j]) * rstd * gp[j]; if (!DRYR || o[0] == 123.456f) xo[64 * j] = o; } }
    }
}

constexpr int VT_PITCH = 72;
__device__ __forceinline__ bf16x8 ld8_f32(const float* p) { const f32x4 a = *(const f32x4*)p, b = *(const f32x4*)(p + 4); return pk8(a, b); }
template <bool SAMPLE>
__device__ __forceinline__ void attn_load(const Args& a, int idx, int h, int kt, int lane, bf16x8 (&ka)[4][2], bf16x8 (&vv)[8]) {
    const int fr = lane & 15, kq = lane >> 4;
    if (SAMPLE && kt < 8) {
        const size_t base = ((size_t)(idx * 512 + 64 * kt)) * 512 + h * 64; const float* ck = a.in[I_CK] + base; const float* cv = a.in[I_CV] + base;
#pragma unroll
        for (int mt = 0; mt < 4; ++mt)
#pragma unroll
            for (int ks = 0; ks < 2; ++ks) ka[mt][ks] = ld8_f32(ck + (size_t)(16 * mt + fr) * 512 + 32 * ks + 8 * kq);
#pragma unroll
        for (int g = 0; g < 8; ++g) vv[g] = ld8_f32(cv + (size_t)(8 * g + (lane >> 3)) * 512 + 8 * (lane & 7));
    } else {
        const bf16_t* KA = (const bf16_t*)(a.ws + A_KA); const bf16_t* VA = (const bf16_t*)(a.ws + A_VA);
        const int krow0 = SAMPLE ? MP + idx * 32 : (idx - 8 + kt) * 64, nvalid = SAMPLE ? 32 : 64;
#pragma unroll
        for (int mt = 0; mt < 4; ++mt) { int key = 16 * mt + fr; if (key >= nvalid) key = nvalid - 1;
#pragma unroll
            for (int ks = 0; ks < 2; ++ks) ka[mt][ks] = *(const bf16x8*)(KA + (size_t)(krow0 + key) * 512 + h * 64 + 32 * ks + 8 * kq); }
#pragma unroll
        for (int g = 0; g < 8; ++g) { int key = 8 * g + (lane >> 3); if (key >= nvalid) key = nvalid - 1;
            vv[g] = *(const bf16x8*)(VA + (size_t)(krow0 + key) * 512 + h * 64 + 8 * (lane & 7)); }
    }
}
__device__ __forceinline__ void attn_load_kraw(const Args& a, int idx, int h, int kt, int half, int lane, f32x4 (&kr)[8]) {
    const int fr = lane & 15, kq = lane >> 4; const float* ck = a.in[I_CK] + ((size_t)(idx * 512 + 64 * kt)) * 512 + h * 64;
#pragma unroll
    for (int m = 0; m < 2; ++m)
#pragma unroll
        for (int ks = 0; ks < 2; ++ks) { const float* p = ck + (size_t)(16 * (2 * half + m) + fr) * 512 + 32 * ks + 8 * kq; kr[(m * 2 + ks) * 2] = *(const f32x4*)p; kr[(m * 2 + ks) * 2 + 1] = *(const f32x4*)(p + 4); }
}
__device__ __forceinline__ void attn_load_vraw(const Args& a, int idx, int h, int kt, int half, int lane, f32x4 (&vr)[8]) {
    const float* cv = a.in[I_CV] + ((size_t)(idx * 512 + 64 * kt)) * 512 + h * 64;
#pragma unroll
    for (int g = 0; g < 4; ++g) { const float* p = cv + (size_t)(8 * (4 * half + g) + (lane >> 3)) * 512 + 8 * (lane & 7); vr[2 * g] = *(const f32x4*)p; vr[2 * g + 1] = *(const f32x4*)(p + 4); }
}
#define PIN8(x) asm volatile("" : "+v"(x[0]), "+v"(x[1]), "+v"(x[2]), "+v"(x[3]), "+v"(x[4]), "+v"(x[5]), "+v"(x[6]), "+v"(x[7]))
typedef short v4i16_t __attribute__((ext_vector_type(4)));
__device__ __forceinline__ void attn_put_v(LAS bf16_t* vR, const bf16x8 (&vv)[8], int lane) {
#pragma unroll
    for (int g = 0; g < 8; ++g) *(LAS bf16x8*)(vR + (8 * g + (lane >> 3)) * VT_PITCH + 8 * (lane & 7)) = vv[g];
}
__device__ __forceinline__ u32x2 tr_read(const LAS bf16_t* p) { return __builtin_bit_cast(u32x2, __builtin_amdgcn_ds_read_tr16_b64_v4i16((LAS v4i16_t*)p)); }
template <int NQ, bool SAMPLE, bool dry = false>
__device__ __forceinline__ void attn_unit(const Args& a, int idx, int h, int qoff, LAS bf16_t* vT, const LAS float* biasL, int lane) {
    const int fr = lane & 15, kq = lane >> 4;
    bf16_t* QA = (bf16_t*)(a.ws + A_QA);
    const int qrow0 = SAMPLE ? MP + idx * 32 : idx * 64 + qoff;
    bf16x8 bq[NQ][2];
#pragma unroll
    for (int nt = 0; nt < NQ; ++nt)
#pragma unroll
        for (int ks = 0; ks < 2; ++ks) bq[nt][ks] = *(const bf16x8*)(QA + (size_t)(qrow0 + 16 * nt + fr) * 512 + h * 64 + 32 * ks + 8 * kq);
    f32x4 o[4][NQ]; float mrun[NQ], lrun[NQ];
#pragma unroll
    for (int nt = 0; nt < NQ; ++nt) { mrun[nt] = -1e30f; lrun[nt] = 0.f;
#pragma unroll
        for (int dt = 0; dt < 4; ++dt) o[dt][nt] = (f32x4){0.f, 0.f, 0.f, 0.f}; }
    const float bias_far = biasL[256];
    int kt = SAMPLE ? 0 : (idx < 8 ? 8 - idx : 0);
    bf16x8 ka[4][2];
    if (!SAMPLE) { bf16x8 vv[8]; attn_load<SAMPLE>(a, idx, h, kt, lane, ka, vv); attn_put_v(vT, vv, lane); }
#pragma unroll 1
    for (; kt < 9; ++kt) {
        bf16x8 vvN[8]; f32x4 vr[8];
        if (SAMPLE) {
            if (kt < 8) {
#pragma unroll
                for (int hf = 0; hf < 2; ++hf) { f32x4 kr[8]; attn_load_kraw(a, idx, h, kt, hf, lane, kr); PIN8(kr);
#pragma unroll
                    for (int j = 0; j < 4; ++j) ka[2 * hf + (j >> 1)][j & 1] = pk8(kr[2 * j], kr[2 * j + 1]); } }
            else attn_load<true>(a, idx, h, 8, lane, ka, vvN);
        }
        f32x4 s[4][NQ];
#pragma unroll
        for (int mt = 0; mt < 4; ++mt)
#pragma unroll
            for (int nt = 0; nt < NQ; ++nt) { f32x4 z = (f32x4){0.f, 0.f, 0.f, 0.f}; z = MFMA16(ka[mt][0], bq[nt][0], z); s[mt][nt] = MFMA16(ka[mt][1], bq[nt][1], z); }
        if (!SAMPLE && kt < 8) attn_load<false>(a, idx, h, kt + 1, lane, ka, vvN);
        if (SAMPLE && kt < 8) attn_load_vraw(a, idx, h, kt, 0, lane, vr);
        const int dbase = 64 * (8 - kt);
        if (kt >= 6) {
#pragma unroll
            for (int mt = 0; mt < 4; ++mt)
#pragma unroll
                for (int nt = 0; nt < NQ; ++nt)
#pragma unroll
                    for (int i = 0; i < 4; ++i) { int d = (qoff + 16 * nt + fr) - (16 * mt + 4 * kq + i) + dbase; d = d < -128 ? -128 : (d > 128 ? 128 : d); s[mt][nt][i] += biasL[d + 128]; }
        } else {
#pragma unroll
            for (int mt = 0; mt < 4; ++mt)
#pragma unroll
                for (int nt = 0; nt < NQ; ++nt) s[mt][nt] = s[mt][nt] + bias_far;
        }
        if (SAMPLE && kt == 8) {
#pragma unroll
            for (int mt = 2; mt < 4; ++mt)
#pragma unroll
                for (int nt = 0; nt < NQ; ++nt) s[mt][nt] = (f32x4){-1e30f, -1e30f, -1e30f, -1e30f};
        }
        bf16x8 pb[NQ][2];
#pragma unroll
        for (int nt = 0; nt < NQ; ++nt) {
            float mx = -1e30f;
#pragma unroll
            for (int mt = 0; mt < 4; ++mt) mx = fmaxf(mx, fmaxf(fmaxf(s[mt][nt][0], s[mt][nt][1]), fmaxf(s[mt][nt][2], s[mt][nt][3])));
            mx = fmaxf(mx, __shfl_xor(mx, 16)); mx = fmaxf(mx, __shfl_xor(mx, 32));
            const float mnew = fmaxf(mrun[nt], mx), sc = __builtin_amdgcn_exp2f(mrun[nt] - mnew); mrun[nt] = mnew; lrun[nt] *= sc;
#pragma unroll
            for (int dt = 0; dt < 4; ++dt) o[dt][nt] = o[dt][nt] * sc;
            const float mcur = mnew; float ls = 0.f;
#pragma unroll
            for (int mt = 0; mt < 4; ++mt)
#pragma unroll
                for (int i = 0; i < 4; ++i) { const float p = __builtin_amdgcn_exp2f(s[mt][nt][i] - mcur); s[mt][nt][i] = p; ls += p; }
            lrun[nt] += ls;
            pb[nt][0] = pk8(s[0][nt], s[1][nt]); pb[nt][1] = pk8(s[2][nt], s[3][nt]);
        }
        if (SAMPLE) {
            if (kt < 8) { PIN8(vr);
#pragma unroll
                for (int g = 0; g < 4; ++g) *(LAS bf16x8*)(vT + (8 * g + (lane >> 3)) * VT_PITCH + 8 * (lane & 7)) = pk8(vr[2 * g], vr[2 * g + 1]);
                attn_load_vraw(a, idx, h, kt, 1, lane, vr); PIN8(vr);
#pragma unroll
                for (int g = 0; g < 4; ++g) *(LAS bf16x8*)(vT + (8 * (4 + g) + (lane >> 3)) * VT_PITCH + 8 * (lane & 7)) = pk8(vr[2 * g], vr[2 * g + 1]); }
            else attn_put_v(vT, vvN, lane); }
        wave_lds_sync();
#pragma unroll
        for (int ks = 0; ks < 2; ++ks)
#pragma unroll
            for (int dt = 0; dt < 4; ++dt) { const LAS bf16_t* vp = vT + (32 * ks + 4 * kq + (fr >> 2)) * VT_PITCH + 16 * dt + 4 * (fr & 3);
                const bf16x8 va = mk8(tr_read(vp), tr_read(vp + 16 * VT_PITCH));
#pragma unroll
                for (int nt = 0; nt < NQ; ++nt) o[dt][nt] = MFMA16(va, pb[nt][ks], o[dt][nt]);
                if (dt & 1) asm volatile("" ::: "memory"); }
        wave_lds_sync();
        if (!SAMPLE && kt < 8) attn_put_v(vT, vvN, lane);
    }
#pragma unroll
    for (int nt = 0; nt < NQ; ++nt) { float l = lrun[nt]; l += __shfl_xor(l, 16); l += __shfl_xor(l, 32); const float inv = 1.f / l;
        bf16_t* op = QA + (size_t)(qrow0 + 16 * nt + fr) * 512 + h * 64 + 4 * kq;
#pragma unroll
        for (int dt = 0; dt < 4; ++dt) if (!dry) *(u32x2*)(op + 16 * dt) = pk4(o[dt][nt] * inv); }
}

constexpr int QE_P = 136, TT_P = 72;
constexpr int G_QE = 0, G_KE = G_QE + 64 * QE_P * 2, G_KLT = G_KE + 64 * QE_P * 2, G_VT = G_KLT + 128 * TT_P * 2, G_ATT = G_VT + 256 * TT_P * 2,
              G_PSUM = G_ATT + 64 * TT_P * 2, G_BLAST = G_PSUM + 2048, G_DVEC = G_BLAST + 512, G_RED = G_DVEC + 512, G_DLR = G_RED + 2048, G_END = G_DLR + 4096;
static_assert(G_END <= 131072, "gla lds");
template <int MODE, bool dry = false>
__device__ __forceinline__ void gla_unit(const Args& a, LAS unsigned char* lds, int idx, int h, int tid, const float (&wu)[16], float bd) {
    constexpr int C = (MODE == 2) ? 32 : 64, TPT = C / 4, NTL = C / 16, KS_T = C / 32;
    const int lane = tid & 63, wave = __builtin_amdgcn_readfirstlane(tid >> 6), fr = lane & 15, kq = lane >> 4;
    LAS bf16_t* qe = (LAS bf16_t*)(lds + G_QE); LAS bf16_t* ke = (LAS bf16_t*)(lds + G_KE); LAS bf16_t* klT = (LAS bf16_t*)(lds + G_KLT);
    LAS bf16_t* vT = (LAS bf16_t*)(lds + G_VT); LAS bf16_t* att = (LAS bf16_t*)(lds + G_ATT);
    LAS float* psum = (LAS float*)(lds + G_PSUM); LAS float* blast = (LAS float*)(lds + G_BLAST); LAS float* dvec = (LAS float*)(lds + G_DVEC); LAS float* red = (LAS float*)(lds + G_RED);
    const int row0 = (MODE == 2) ? MP + idx * 32 : idx * 64;
    const bf16_t* QB = (const bf16_t*)(a.ws + A_QB); const bf16_t* KB = (const bf16_t*)(a.ws + A_KB); bf16_t* VB = (bf16_t*)(a.ws + A_VB); const bf16_t* RB = (const bf16_t*)(a.ws + A_RB);
    const float* DLR = (const float*)((const unsigned char*)a.out + Y_DLR);
    bf16_t* US = (bf16_t*)((unsigned char*)a.out + Y_US) + (size_t)(idx * 4 + h) * 32768;
    bf16x8 vraw[C / 16];
    { const int t = tid & (C - 1), g0 = tid / C;
#pragma unroll
        for (int gi = 0; gi < C / 16; ++gi) vraw[gi] = *(const bf16x8*)(VB + (size_t)(row0 + t) * 1024 + h * 256 + 8 * (g0 * (C / 16) + gi)); }
    bf16x8 sraw[4][2];
    if (MODE == 1) {
#pragma unroll
        for (int ks = 0; ks < 4; ++ks)
#pragma unroll
            for (int m = 0; m < 2; ++m) sraw[ks][m] = *(const bf16x8*)(US + (size_t)(32 * wave + 16 * m + fr) * 128 + 32 * ks + 8 * kq); }
    LAS f32x4* dlrL = (LAS f32x4*)(lds + G_DLR);
    if (tid < C * 4) dlrL[tid] = ((const f32x4*)(DLR + (size_t)row0 * 16))[tid];
    __syncthreads();
    {
        const int dk = tid & 127, tq = wave >> 1, col = h * 128 + dk;
        bf16_t kraw[TPT], qraw[TPT];
#pragma unroll
        for (int i = 0; i < TPT; ++i) { const size_t gi = (size_t)(row0 + tq * TPT + i) * 512 + col; kraw[i] = KB[gi]; qraw[i] = (MODE != 0) ? QB[gi] : (bf16_t)0; }
        float bl[TPT]; float run = 0.f;
#pragma unroll
        for (int i = 0; i < TPT; ++i) { const LAS f32x4* dp = dlrL + (tq * TPT + i) * 4; float z = bd;
#pragma unroll
            for (int j4 = 0; j4 < 4; ++j4) { const f32x4 d = dp[j4]; z += d[0] * wu[4 * j4] + d[1] * wu[4 * j4 + 1] + d[2] * wu[4 * j4 + 2] + d[3] * wu[4 * j4 + 3]; }
            const float la = (fminf(z, 0.f) - __logf(1.f + __expf(-fabsf(z)))) * (1.f / 16.f);
            run += la; bl[i] = run; }
        psum[tq * 128 + dk] = run;
        __syncthreads();
        float off = 0.f, tot = 0.f;
#pragma unroll
        for (int p = 0; p < 4; ++p) { const float v = psum[p * 128 + dk]; tot += v; if (p < tq) off += v; }
        if (tq == 0) { dvec[dk] = __expf(tot); if (MODE == 0) ((float*)((unsigned char*)a.out + Y_DEC))[(size_t)(idx * 4 + h) * 128 + dk] = __expf(tot); }
#pragma unroll
        for (int i = 0; i < TPT; ++i) { const int t = tq * TPT + i; const float b = bl[i] + off;
            const float kv = bf2f(kraw[i]);
            if (MODE != 0) { const float qv = bf2f(qraw[i]); qe[t * QE_P + dk] = f2bf(qv * __expf(b)); ke[t * QE_P + dk] = f2bf(kv * __expf(-b)); }
            if (MODE != 1) klT[dk * TT_P + t] = f2bf(kv * __expf(tot - b)); }
    }
    {
        const int t = tid & (C - 1), g0 = tid / C;
#pragma unroll
        for (int gi = 0; gi < C / 16; ++gi) { const int g = g0 * (C / 16) + gi; const bf16x8 vv = vraw[gi];
#pragma unroll
            for (int j = 0; j < 8; ++j) vT[(8 * g + j) * TT_P + t] = (bf16_t)vv[j]; }
    }
    __syncthreads();
    if (MODE != 0) {
        for (int id = wave; id < NTL * NTL; id += 8) { const int ms = id / NTL, nt = id % NTL; f32x4 acc = (f32x4){0.f, 0.f, 0.f, 0.f};
#pragma unroll
            for (int ks = 0; ks < 4; ++ks) acc = MFMA16(*(const LAS bf16x8*)(ke + (16 * ms + fr) * QE_P + 32 * ks + 8 * kq), *(const LAS bf16x8*)(qe + (16 * nt + fr) * QE_P + 32 * ks + 8 * kq), acc);
            const int t = 16 * nt + fr;
#pragma unroll
            for (int i = 0; i < 4; ++i) if (16 * ms + 4 * kq + i > t) acc[i] = 0.f;
            *(LAS u32x2*)(att + t * TT_P + 16 * ms + 4 * kq) = pk4(acc); }
    }
    if (MODE != 1) {
        f32x4 u[8][2];
#pragma unroll
        for (int mt = 0; mt < 8; ++mt)
#pragma unroll
            for (int n = 0; n < 2; ++n) u[mt][n] = (f32x4){0.f, 0.f, 0.f, 0.f};
#pragma unroll
        for (int ks = 0; ks < KS_T; ++ks) { bf16x8 bv[2];
#pragma unroll
            for (int n = 0; n < 2; ++n) bv[n] = *(const LAS bf16x8*)(vT + (32 * wave + 16 * n + fr) * TT_P + 32 * ks + 8 * kq);
#pragma unroll
            for (int mt = 0; mt < 8; ++mt) { const bf16x8 av = *(const LAS bf16x8*)(klT + (16 * mt + fr) * TT_P + 32 * ks + 8 * kq);
#pragma unroll
                for (int n = 0; n < 2; ++n) u[mt][n] = MFMA16(av, bv[n], u[mt][n]); } }
        if (MODE == 0) {
#pragma unroll
            for (int mt = 0; mt < 8; ++mt)
#pragma unroll
                for (int n = 0; n < 2; ++n) *(u32x2*)(US + (size_t)(32 * wave + 16 * n + fr) * 128 + 16 * mt + 4 * kq) = pk4(u[mt][n]);
        } else {
            const float* S0 = a.in[I_ST] + (size_t)(idx * 4 + h) * 32768; float* S1 = a.out + O_SS + (size_t)(idx * 4 + h) * 32768;
#pragma unroll
            for (int mt = 0; mt < 8; ++mt)
#pragma unroll
                for (int n = 0; n < 2; ++n)
#pragma unroll
                    for (int i = 0; i < 4; ++i) { const int dk = 16 * mt + 4 * kq + i, dv = 32 * wave + 16 * n + fr; S1[dk * 256 + dv] = dvec[dk] * S0[dk * 256 + dv] + u[mt][n][i]; }
        }
    }
    if (MODE != 0) {
        __syncthreads();
        f32x4 o[2][NTL];
#pragma unroll
        for (int m = 0; m < 2; ++m)
#pragma unroll
            for (int nt = 0; nt < NTL; ++nt) o[m][nt] = (f32x4){0.f, 0.f, 0.f, 0.f};
#pragma unroll
        for (int ks = 0; ks < KS_T; ++ks) { bf16x8 av[2];
#pragma unroll
            for (int m = 0; m < 2; ++m) av[m] = *(const LAS bf16x8*)(vT + (32 * wave + 16 * m + fr) * TT_P + 32 * ks + 8 * kq);
#pragma unroll
            for (int nt = 0; nt < NTL; ++nt) { const bf16x8 bv = *(const LAS bf16x8*)(att + (16 * nt + fr) * TT_P + 32 * ks + 8 * kq);
#pragma unroll
                for (int m = 0; m < 2; ++m) o[m][nt] = MFMA16(av[m], bv, o[m][nt]); } }
#pragma unroll
        for (int ks = 0; ks < 4; ++ks) { bf16x8 av[2];
#pragma unroll
            for (int m = 0; m < 2; ++m) { const int dv = 32 * wave + 16 * m + fr;
                if (MODE == 1) av[m] = sraw[ks][m];
                else { const float* sp = a.in[I_ST] + (size_t)(idx * 4 + h) * 32768 + (size_t)(32 * ks + 8 * kq) * 256 + dv; f32x4 x0, x1;
#pragma unroll
                    for (int j = 0; j < 4; ++j) { x0[j] = sp[j * 256]; x1[j] = sp[(j + 4) * 256]; }
                    av[m] = pk8(x0, x1); } }
#pragma unroll
            for (int nt = 0; nt < NTL; ++nt) { const bf16x8 bv = *(const LAS bf16x8*)(qe + (16 * nt + fr) * QE_P + 32 * ks + 8 * kq);
#pragma unroll
                for (int m = 0; m < 2; ++m) o[m][nt] = MFMA16(av[m], bv, o[m][nt]); } }
#pragma unroll
        for (int nt = 0; nt < NTL; ++nt) { float ss = 0.f;
#pragma unroll
            for (int m = 0; m < 2; ++m) ss += (o[m][nt][0] * o[m][nt][0] + o[m][nt][1] * o[m][nt][1]) + (o[m][nt][2] * o[m][nt][2] + o[m][nt][3] * o[m][nt][3]);
            ss += __shfl_xor(ss, 16); ss += __shfl_xor(ss, 32);
            if (kq == 0) red[wave * 64 + 16 * nt + fr] = ss; }
        __syncthreads();
#pragma unroll
        for (int nt = 0; nt < NTL; ++nt) { const int t = 16 * nt + fr; float tot = 0.f;
#pragma unroll
            for (int w = 0; w < 8; ++w) tot += red[w * 64 + t];
            const float rstd = rsqrtf(tot * (1.f / 256.f) + EPS);
#pragma unroll
            for (int m = 0; m < 2; ++m) { const int dv = 32 * wave + 16 * m + 4 * kq; const size_t gi = (size_t)(row0 + t) * 1024 + h * 256 + dv;
                const f32x4 gn = *(const f32x4*)(a.in[I_GNORM] + dv); const f32x4 rb = up4(*(const u32x2*)(RB + gi));
                if (!dry) *(u32x2*)(VB + gi) = pk4(o[m][nt] * rstd * gn * rb); } }
    }
    __syncthreads();
}

template <bool DRYS = false>
__device__ __forceinline__ void scan_phase(const Args& a, int tid, int nthr, int blk, int nblk) {
    u32x2* US64 = (u32x2*)((unsigned char*)a.out + Y_US); const f32x4* DEC = (const f32x4*)((const unsigned char*)a.out + Y_DEC);
    const int per = (32768 + nblk - 1) / nblk;
    if (tid >= nthr) return;
    for (int q = tid; q < per; q += nthr) {
    const int p = blk * per + q; if (p >= 32768) break;
    const int hh = p >> 13, dv = (p >> 5) & 255, dq = p & 31; f32x4 st = (f32x4){0.f, 0.f, 0.f, 0.f};
    u32x2* up = US64 + (size_t)hh * 8192 + dv * 32 + dq; const f32x4* dp = DEC + hh * 32 + dq;
    for (int c0 = 0; c0 < 256; c0 += 8) { u32x2 u[8]; f32x4 d[8];
#pragma unroll
        for (int j = 0; j < 8; ++j) { u[j] = up[(size_t)(c0 + j) * 32768]; d[j] = dp[(c0 + j) * 128]; }
#pragma unroll
        for (int j = 0; j < 8; ++j) { if (!DRYS || st[0] == 123.456f) up[(size_t)(c0 + j) * 32768] = pk4(st); st = d[j] * st + up4(u[j]); } }
    float* so = a.out + O_SP + (size_t)(hh * 128 + 4 * dq) * 256 + dv;
    if (!DRYS || st[0] == 123.456f) { so[0] = st[0]; so[256] = st[1]; so[512] = st[2]; so[768] = st[3]; }
    }
}

#define XB_TMO      128
#define XB_XCNT(j)  (256  + 64 * (j))
#define XB_XSUB(j)  (1280 + 64 * (j))
#define XB_XGEN(j)  (2304 + 64 * (j))
#define XB_TOP      3328
#define XB_TOPGEN   3392
#define XCD_BAR_WORDS 3456
#define XB_SPIN_CAP (1u << 18)

__device__ __forceinline__ unsigned xb_ld(unsigned* p)              { return __hip_atomic_load(p, __ATOMIC_RELAXED, __HIP_MEMORY_SCOPE_AGENT); }
__device__ __forceinline__ unsigned xb_add(unsigned* p, unsigned v) { return __hip_atomic_fetch_add(p, v, __ATOMIC_RELAXED, __HIP_MEMORY_SCOPE_AGENT); }
__device__ __forceinline__ unsigned xb_xcc_id() { return (unsigned)__builtin_amdgcn_s_getreg((3 << 11) | 20) & 0xFu; }
#define XB_SPIN(cond, bar) do { unsigned _sp = 0; while (cond) { __builtin_amdgcn_s_sleep(1); \
    if ((++_sp & 255u) == 0u) { if (xb_ld(&(bar)[XB_TMO])) break; if (_sp > XB_SPIN_CAP) { atomicAdd(&(bar)[XB_TMO], 1u); break; } } } } while (0)

struct XcdBarrier {
    unsigned* bar; unsigned x;
    volatile LAS unsigned* st;
};

__device__ __forceinline__ XcdBarrier xcd_barrier_post(unsigned* bar, volatile LAS unsigned* st) {
    XcdBarrier b; b.bar = bar; b.x = xb_xcc_id(); b.st = st;
    if (threadIdx.x == 0) (void)xb_add(&bar[XB_XCNT(b.x)], 1u);
    return b;
}
__device__ __forceinline__ void xcd_barrier_complete(unsigned* bar, unsigned x, unsigned& nloc, unsigned& nx) {
    const unsigned G = gridDim.x * gridDim.y * gridDim.z;
    unsigned sum, cnt, mine, sp = 0u;
    for (;;) {
        sum = 0u; cnt = 0u; mine = 0u;
#pragma unroll
        for (unsigned j = 0; j < 16; ++j) { const unsigned c = xb_ld(&bar[XB_XCNT(j)]); sum += c; cnt += (c > 0u) ? 1u : 0u; mine = (j == x) ? c : mine; }
        if (sum == G) break;
        __builtin_amdgcn_s_sleep(1);
        if ((++sp & 255u) == 0u) { if (xb_ld(&bar[XB_TMO])) break; if (sp > XB_SPIN_CAP) { atomicAdd(&bar[XB_TMO], 1u); break; } }
    }
    nloc = mine > 0u ? mine : 1u; nx = cnt > 0u ? cnt : 1u;
}

__device__ __forceinline__ void xcd_barrier(const XcdBarrier& b) {
    asm volatile("s_waitcnt vmcnt(0)" ::: "memory");
    __syncthreads();
    if (threadIdx.x == 0) {
        unsigned* bar = b.bar;
        __builtin_amdgcn_s_waitcnt(0);
        unsigned nloc = b.st[0], nx = b.st[1];
        if (nloc == 0u) { xcd_barrier_complete(bar, b.x, nloc, nx); b.st[0] = nloc; b.st[1] = nx; }
        const unsigned old = xb_add(&bar[XB_XSUB(b.x)], 1u);
        const unsigned gen = old / nloc;
        if (old + 1u == (gen + 1u) * nloc) {
            __builtin_amdgcn_fence(__ATOMIC_RELEASE, "agent");
            asm volatile("s_waitcnt vmcnt(0)" ::: "memory");
            const unsigned og = xb_add(&bar[XB_TOP], 1u);
            const unsigned tg = og / nx;
            if (og + 1u == (tg + 1u) * nx) xb_add(&bar[XB_TOPGEN], 1u);
            else XB_SPIN(xb_ld(&bar[XB_TOPGEN]) == tg, bar);
            __builtin_amdgcn_fence(__ATOMIC_ACQUIRE, "agent");
            xb_add(&bar[XB_XGEN(b.x)], 1u);
            asm volatile("s_waitcnt vmcnt(0)" ::: "memory");
        } else {
            XB_SPIN(xb_ld(&bar[XB_XGEN(b.x)]) == gen, bar);
            __builtin_amdgcn_fence(__ATOMIC_ACQUIRE, "agent");
            asm volatile("s_waitcnt vmcnt(0)" ::: "memory");
        }
    }
    __syncthreads();
}


constexpr size_t WS_BAR = 36315136;
constexpr int NPH = 14;
__global__ void __launch_bounds__(512) fwd_kernel(Args a) {
    extern __shared__ __attribute__((aligned(16))) unsigned char lds_raw[];
    LAS unsigned char* lds = (LAS unsigned char*)lds_raw;
    const int tid = threadIdx.x, lane = tid & 63, wave = __builtin_amdgcn_readfirstlane(tid >> 6);
    const int G = gridDim.x, gw = blockIdx.x * 8 + wave, NGW = G * 8;
    cg::grid_group grid = cg::this_grid();
    volatile LAS unsigned* xst = (volatile LAS unsigned*)(lds + LDS_BYTES - 16);
    if (tid < 4) xst[tid] = 0u;
    __syncthreads();
    if (a.ph_lo == 0) { if (blockIdx.x == 0) for (int i = tid; i < XCD_BAR_WORDS; i += 512) ((unsigned*)(a.ws + WS_BAR))[i] = 0u;
        grid.sync(); (void)xcd_barrier_post((unsigned*)(a.ws + WS_BAR), xst); }
#define SEAM(k) do { XcdBarrier xb_; xb_.bar = (unsigned*)(a.ws + WS_BAR); xb_.x = xb_xcc_id(); xb_.st = (volatile LAS unsigned*)(lds + LDS_BYTES - 16); xcd_barrier(xb_); } while (0)
#define GLA_HEAD_CONSTS(hh) float wu_[16]; { const int col_ = (hh) * 128 + (tid & 127); _Pragma("unroll") for (int j = 0; j < 16; ++j) wu_[j] = a.in[I_WUP][j * 512 + col_]; } const float bd_ = a.in[I_BDEC][(hh) * 128 + (tid & 127)]
#define PH(k) if (a.ph_lo <= (k) && (k) < a.ph_hi) { if ((k) > a.ph_lo && (k) != 6) SEAM(k);
#define PHEND }
#define GEMM_N1024(EPI, Aoff, Woff, Mrows, Kdim, rowbase, Gn, cid, ...) do { pg8::Gemm g{(const bf16_t*)(a.ws + (Aoff)) + (size_t)(rowbase) * (Kdim), (const bf16_t*)(a.ws + (Woff)), (Mrows), 1024, (Kdim)}; \
        pg8::StaticOrder S; S.init((Mrows), 1024, (Gn), (cid)); EPI E{__VA_ARGS__, (rowbase)}; pg8::gemm_phase<EPI, pg8::StaticOrder, false, true>(lds, g, S, E); } while (0)
    const int bx = (int)blockIdx.x;
    PH(0) {
        float* rss = (float*)(a.ws + WS_RSS1);
        for (int i = bx * 512 + tid; i < 2 * MT; i += G * 512) rss[i] = 0.f;
        p0_convert(a, (LAS float*)lds + wave * (64 * 65), gw, NGW, lane);
        __syncthreads();
        p0_rows(a, lds, gw, NGW, wave, lane, tid);
    } PHEND
    PH(1) {
        pg8::Gemm g{(const bf16_t*)((const unsigned char*)a.out + Y_H), (const bf16_t*)(a.ws + WS_WIN), MT, NIN, 1024}; pg8::StaticOrder S; S.init(MT, NIN, G, bx);
        EpiIn E{a.ws, a.out}; pg8::gemm_phase<EpiIn, pg8::StaticOrder, true, true>(lds, g, S, E);
    } PHEND
    PH(2) {
        LAS float* biasL = (LAS float*)(lds + 8 * 64 * VT_PITCH * 2);
        for (int i = tid; i < 8 * 257; i += 512) biasL[i] = a.in[I_RELB][i] * 1.4426950408889634f;
        __syncthreads();
        LAS bf16_t* vT = (LAS bf16_t*)lds + wave * (64 * VT_PITCH);
        for (int u = gw; u < 256; u += NGW) attn_unit<2, true>(a, u >> 3, u & 7, 0, vT, biasL + (u & 7) * 257, lane);
        __syncthreads();
        GLA_HEAD_CONSTS(bx & 3);
        const bool few = (G == 256) && bx < 32;
        for (int u = (G != 256) ? bx : (few ? bx : 64 + bx - 32); u < (few ? 64 : 1024 + 128); u += (G != 256) ? G : (few ? 32 : 224)) {
            if ((G & 3) != 0) { const int col_ = (u & 3) * 128 + (tid & 127); for (int j = 0; j < 16; ++j) wu_[j] = a.in[I_WUP][j * 512 + col_]; }
            const float bdu = (G & 3) ? a.in[I_BDEC][(u & 3) * 128 + (tid & 127)] : bd_;
            if (u < 1024) gla_unit<0>(a, lds, u >> 2, u & 3, tid, wu_, bdu);
            else gla_unit<2>(a, lds, (u - 1024) >> 2, u & 3, tid, wu_, bdu); }
    } PHEND
    PH(3) {
        if (bx < 16) {
            GEMM_N1024(EpiN1024<0>, A_QA, WS_WPA, MS, 512, MP, 16, bx, (bf16_t*)(a.ws + A_GA), nullptr, nullptr);
            GEMM_N1024(EpiN1024<1>, A_VB, WS_WPB, MS, 1024, MP, 16, bx, (bf16_t*)(a.ws + A_GA), (const bf16_t*)(a.ws + A_GB), nullptr);
        } else {
            LAS float* biasL = (LAS float*)(lds + 8 * 64 * VT_PITCH * 2);
            for (int i = tid; i < 8 * 257; i += 512) biasL[i] = a.in[I_RELB][i] * 1.4426950408889634f;
            __syncthreads();
            if (wave >= 3) { LAS bf16_t* vT = (LAS bf16_t*)lds + wave * (64 * VT_PITCH);
                for (int u = (bx - 16) * 5 + (wave - 3); u < 4096; u += (G - 16) * 5) attn_unit<2, false>(a, u >> 4, u & 7, ((u >> 3) & 1) * 32, vT, biasL + (u & 7) * 257, lane); }
            else scan_phase(a, tid, 192, bx - 16, G - 16);
        }
    } PHEND
    PH(4) { GLA_HEAD_CONSTS(bx & 3);
        for (int u = bx; u < 1024; u += G) {
            if ((G & 3) != 0) { const int col_ = (u & 3) * 128 + (tid & 127); for (int j = 0; j < 16; ++j) wu_[j] = a.in[I_WUP][j * 512 + col_]; }
            const float bdu = (G & 3) ? a.in[I_BDEC][(u & 3) * 128 + (tid & 127)] : bd_;
            gla_unit<1>(a, lds, u >> 2, u & 3, tid, wu_, bdu); }
    } PHEND
    PH(5) {
        GEMM_N1024(EpiN1024<0>, A_QA, WS_WPA, MP, 512, 0, G, bx, (bf16_t*)(a.ws + A_GA), nullptr, nullptr);
        GEMM_N1024(EpiN1024<1>, A_VB, WS_WPB, MP, 1024, 0, G, bx, (bf16_t*)(a.ws + A_GA), (const bf16_t*)(a.ws + A_GB), nullptr);
    } PHEND
    PH(6) { } PHEND
    PH(7) { GEMM_N1024(EpiN1024<2>, A_GA, WS_WOUT, MP, 1024, 0, G, bx, (bf16_t*)(a.ws + A_GB), nullptr, (float*)(a.ws + WS_RSS1)); } PHEND
    PH(8) {
        if (G >= 32 && bx < 16) GEMM_N1024(EpiN1024<2>, A_GA, WS_WOUT, MS, 1024, MP, 16, bx, (bf16_t*)(a.ws + A_GB), nullptr, (float*)(a.ws + WS_RSS1));
        else if (G >= 32) row_pass1(a, 0, MP, gw - 128, NGW - 128, lane);
        else { row_pass1(a, 0, MP, gw, NGW, lane); GEMM_N1024(EpiN1024<2>, A_GA, WS_WOUT, MS, 1024, MP, G, bx, (bf16_t*)(a.ws + A_GB), nullptr, (float*)(a.ws + WS_RSS1)); }
    } PHEND
    PH(9) { row_pass1(a, MP, MT, gw, NGW, lane); } PHEND
    PH(10) {
        pg8::Gemm g{(const bf16_t*)(a.ws + A_RB), (const bf16_t*)(a.ws + WS_WGU), MT, NGU, 1024}; pg8::StaticOrder S; S.init(MT, NGU, G, bx);
        EpiSwiglu E{(bf16_t*)(a.ws + A_HID)}; pg8::gemm_phase<EpiSwiglu, pg8::StaticOrder, true, true>(lds, g, S, E);
    } PHEND
    PH(11) { GEMM_N1024(EpiN1024<2>, A_HID, WS_WDN, MP, DFF, 0, G, bx, (bf16_t*)(a.ws + A_GA), nullptr, (float*)(a.ws + WS_RSS2)); } PHEND
    PH(12) {
        if (G >= 32 && bx < 16) GEMM_N1024(EpiN1024<2>, A_HID, WS_WDN, MS, DFF, MP, 16, bx, (bf16_t*)(a.ws + A_GA), nullptr, (float*)(a.ws + WS_RSS2));
        else if (G >= 32) row_pass2(a, 0, MP, gw - 128, NGW - 128, lane);
        else { row_pass2(a, 0, MP, gw, NGW, lane); GEMM_N1024(EpiN1024<2>, A_HID, WS_WDN, MS, DFF, MP, G, bx, (bf16_t*)(a.ws + A_GA), nullptr, (float*)(a.ws + WS_RSS2)); }
    } PHEND
    PH(13) { row_pass2(a, MP, MT, gw, NGW, lane); } PHEND
}

extern "C" void kernel_launch(void* const* d_in, const int* in_sizes, int n_in, void* d_out, int out_size, void* d_ws, size_t ws_size, hipStream_t stream) {
    static int grid = 0;
    if (grid == 0) {
        if (n_in != 20 || ws_size < A_END || out_size != 23724032) { fprintf(stderr, "kernel_launch: unexpected sizes n_in %d ws %zu out %d\n", n_in, ws_size, out_size); }
        int dev = 0, cus = 0, per_cu = 0;
        hipGetDevice(&dev); hipDeviceGetAttribute(&cus, hipDeviceAttributeMultiprocessorCount, dev);
        hipFuncSetAttribute((const void*)fwd_kernel, hipFuncAttributeMaxDynamicSharedMemorySize, LDS_BYTES);
        hipOccupancyMaxActiveBlocksPerMultiprocessor(&per_cu, (const void*)fwd_kernel, 512, LDS_BYTES);
        if (per_cu < 1) { fprintf(stderr, "kernel_launch: occupancy query says %d blocks per CU\n", per_cu); per_cu = 1; }
        grid = cus * 1;
        (void)hipGetLastError();
    }
    Args a{};
    for (int i = 0; i < 20; ++i) a.in[i] = (const float*)d_in[i];
    a.out = (float*)d_out; a.ws = (unsigned char*)d_ws;
    a.ph_lo = 0; a.ph_hi = NPH;
    void* args[] = {&a};
    hipError_t e = hipLaunchCooperativeKernel((const void*)fwd_kernel, dim3(grid), dim3(512), args, LDS_BYTES, stream);
    if (e != hipSuccess) fprintf(stderr, "cooperative launch failed: %s (grid %d)\n", hipGetErrorString(e), grid);
}
```
